# Optimizing an MI355X kernel written in HIP

```python
import jax, jax.numpy as jnp
from jax import lax
import numpy as np

D_MODEL = 1024
BATCH = 8
SEQ = 4096
DEPTH = 1

CHUNK = 64
N_MEM = 256
ROPE_THETA = 10000.0
EPS = 1e-6
ATTN_HEADS = 8
HEAD_DIM = 64
ATTN_WIDTH = ATTN_HEADS * HEAD_DIM
IDX_HEADS = 8
IDX_DIM = HEAD_DIM
MAX_TOPK = 256
Q_BLOCK = CHUNK
CONV_CH = D_MODEL // 2
CONV_WIDTH = 31
N_BRANCHES = 2
IN_SPLITS = (ATTN_WIDTH, ATTN_WIDTH, ATTN_WIDTH, IDX_HEADS * IDX_DIM, IDX_DIM, IDX_HEADS,
             2 * CONV_CH, N_BRANCHES * D_MODEL)
IN_WIDTH = sum(IN_SPLITS)
X_HEADS = 4
X_HEAD_DIM = D_MODEL // X_HEADS
N_GROUPS = 4
EXPERTS_PER_GROUP = 8
TOP_K_EXPERTS = 2
EXPERT_FF = D_MODEL // 4

kernel_name = "hybrid_dsa_conformer_hmoe_block"


def rmsnorm(x, g):
    xf = x.astype(jnp.float32)
    y = xf * lax.rsqrt(jnp.mean(xf * xf, axis=-1, keepdims=True) + EPS)
    return (y * g.astype(jnp.float32)).astype(x.dtype)


def layernorm(x, g, b):
    xf = x.astype(jnp.float32)
    mu = jnp.mean(xf, axis=-1, keepdims=True)
    var = jnp.mean(jnp.square(xf - mu), axis=-1, keepdims=True)
    y = (xf - mu) * lax.rsqrt(var + EPS)
    return (y * g.astype(jnp.float32) + b.astype(jnp.float32)).astype(x.dtype)


def rope_tables(positions, dim):
    inv_freq = ROPE_THETA ** (-jnp.arange(0, dim, 2, dtype=jnp.float32) / dim)
    ang = positions.astype(jnp.float32)[..., None] * inv_freq
    return jnp.cos(ang)[:, :, None, :], jnp.sin(ang)[:, :, None, :]


def apply_rope(x, cos, sin):
    xf = x.astype(jnp.float32)
    half = xf.shape[-1] // 2
    x1, x2 = xf[..., :half], xf[..., half:]
    return jnp.concatenate([x1 * cos - x2 * sin, x2 * cos + x1 * sin], axis=-1).astype(x.dtype)


def _split_offsets():
    offs, acc = [], 0
    for w in IN_SPLITS[:-1]:
        acc += w
        offs.append(acc)
    return offs


def dsa_attention(q, k, v, q_idx, k_idx, w_idx):
    B, S = q.shape[0], q.shape[1]
    top_k = min(MAX_TOPK, S // 4)
    n_blk = S // Q_BLOCK
    key_pos = jnp.arange(S, dtype=jnp.int32)
    scale_attn = HEAD_DIM ** -0.5
    scale_idx = (IDX_DIM ** -0.5) * (IDX_HEADS ** -0.5)
    gather = jax.vmap(lambda src, idx: src[idx])

    def to_blocks(a):
        return a.reshape(B, n_blk, Q_BLOCK, *a.shape[2:]).swapaxes(0, 1)

    def block(args):
        qb, qib, wb, start = args
        qpos = start + jnp.arange(Q_BLOCK, dtype=jnp.int32)
        limit = (qpos // CHUNK + 1) * CHUNK
        admissible = key_pos[None, :] < limit[:, None]
        rel = jax.nn.relu(jnp.einsum('bqhd,bsd->bqhs', qib, k_idx).astype(jnp.float32))
        score = jnp.einsum('bqhs,bqh->bqs', rel, wb.astype(jnp.float32)) * scale_idx
        score = jnp.where(admissible[None], score, -jnp.inf)
        _, sel = lax.top_k(score, top_k)
        valid = sel < limit[None, :, None]
        k_sel = gather(k, sel)
        v_sel = gather(v, sel)
        logits = jnp.einsum('bqhd,bqkhd->bqhk', qb, k_sel).astype(jnp.float32) * scale_attn
        logits = jnp.where(valid[:, :, None, :], logits, -jnp.inf)
        p = jax.nn.softmax(logits, axis=-1).astype(v.dtype)
        return jnp.einsum('bqhk,bqkhd->bqhd', p, v_sel)

    starts = jnp.arange(n_blk, dtype=jnp.int32) * Q_BLOCK
    out = lax.map(block, (to_blocks(q), to_blocks(q_idx), to_blocks(w_idx), starts))
    return out.swapaxes(0, 1).reshape(B, S, ATTN_WIDTH)


def conformer_conv(a, b, conv_w, conv_b, ln_g, ln_b, w_pw):
    u = a * jax.nn.sigmoid(b)
    u = lax.conv_general_dilated(u, conv_w[:, None, :], window_strides=(1,),
                                 padding=[(CONV_WIDTH - 1, 0)],
                                 dimension_numbers=('NWC', 'WIO', 'NWC'),
                                 feature_group_count=CONV_CH) + conv_b
    u = jax.nn.silu(layernorm(u, ln_g, ln_b))
    return u @ w_pw


def mixing_sublayer(x, cos, sin, norm_g, w_in, w_o_attn, conv_w, conv_b, conv_ln_g, conv_ln_b,
                    w_conv_out, w_out):
    B, S, _ = x.shape
    h = rmsnorm(x, norm_g)
    q, k, v, qi, ki, wi, glu, gates = jnp.split(h @ w_in, _split_offsets(), axis=-1)
    q = apply_rope(q.reshape(B, S, ATTN_HEADS, HEAD_DIM), cos, sin)
    k = apply_rope(k.reshape(B, S, ATTN_HEADS, HEAD_DIM), cos, sin)
    v = v.reshape(B, S, ATTN_HEADS, HEAD_DIM)
    qi = apply_rope(qi.reshape(B, S, IDX_HEADS, IDX_DIM), cos, sin)
    ki = apply_rope(ki[:, :, None, :], cos, sin)[:, :, 0]
    y_attn = dsa_attention(q, k, v, qi, ki, wi) @ w_o_attn
    y_conv = conformer_conv(glu[..., :CONV_CH], glu[..., CONV_CH:], conv_w, conv_b,
                            conv_ln_g, conv_ln_b, w_conv_out)
    g = jax.nn.sigmoid(gates).reshape(B, S, N_BRANCHES, D_MODEL)
    return x + (g[:, :, 0] * y_attn + g[:, :, 1] * y_conv) @ w_out


def memory_cross_attention(x, mem, norm_g, norm_mem_g, w_q, w_kv, w_o):
    B, S, _ = x.shape
    M = mem.shape[1]
    q = (rmsnorm(x, norm_g) @ w_q).reshape(B, S, X_HEADS, X_HEAD_DIM)
    kv = (rmsnorm(mem, norm_mem_g) @ w_kv).reshape(B, M, 2, X_HEADS, X_HEAD_DIM)
    k, v = kv[:, :, 0], kv[:, :, 1]
    logits = jnp.einsum('bshd,bmhd->bhsm', q, k).astype(jnp.float32) * (X_HEAD_DIM ** -0.5)
    p = jax.nn.softmax(logits, axis=-1).astype(v.dtype)
    o = jnp.einsum('bhsm,bmhd->bshd', p, v).reshape(B, S, D_MODEL)
    return x + o @ w_o


def hier_moe(h, w_rg, b_rg, w_re, b_re, w_gate, w_up, w_down):
    B, S, D = h.shape
    t = h.reshape(-1, D)
    group_logits = (t @ w_rg + b_rg).astype(jnp.float32)
    g_sel = jnp.argmax(group_logits, axis=-1)
    g_gate = jnp.take_along_axis(jax.nn.softmax(group_logits, axis=-1), g_sel[:, None], axis=-1)
    exp_logits = (jnp.einsum('td,gde->tge', t, w_re) + b_re).astype(jnp.float32)
    exp_logits = jnp.take_along_axis(exp_logits, g_sel[:, None, None], axis=1)[:, 0]
    top_val, top_idx = lax.top_k(exp_logits, TOP_K_EXPERTS)
    top_w = jax.nn.softmax(top_val, axis=-1) * g_gate
    w_exp = jnp.einsum('tk,tke->te', top_w,
                       jax.nn.one_hot(top_idx, EXPERTS_PER_GROUP, dtype=jnp.float32))
    combine = (jax.nn.one_hot(g_sel, N_GROUPS, dtype=jnp.float32)[:, :, None]
               * w_exp[:, None, :]).astype(h.dtype)
    y = jnp.zeros_like(t)
    for g in range(N_GROUPS):
        act = (jax.nn.silu(jnp.einsum('td,edf->tef', t, w_gate[g]))
               * jnp.einsum('td,edf->tef', t, w_up[g]))
        y = y + jnp.einsum('tef,efd->td', act * combine[:, g, :, None], w_down[g])
    return y.reshape(B, S, D)


def setup_inputs(seed: int = 0) -> dict:
    key = jax.random.key(seed)
    ks = iter(jax.random.split(key, 40))
    L, D, G, E, F = DEPTH, D_MODEL, N_GROUPS, EXPERTS_PER_GROUP, EXPERT_FF

    def nrm(shape, scale):
        return jax.random.normal(next(ks), shape, jnp.float32) * scale

    def gain(shape):
        return 1.0 + nrm(shape, 0.01)

    x = nrm((BATCH, SEQ, D), 1.0)
    mem = nrm((BATCH, N_MEM, D), 1.0)
    offset = jax.random.randint(next(ks), (BATCH, 1), 0, 64, dtype=jnp.int32) * CHUNK
    positions = (offset + jnp.arange(SEQ, dtype=jnp.int32)[None, :]).astype(jnp.int32)
    return {
        "x": x,
        "mem": mem,
        "positions": positions,
        "norm_mix_g": gain((L, D)),
        "w_in": nrm((L, D, IN_WIDTH), D ** -0.5),
        "w_o_attn": nrm((L, ATTN_WIDTH, D), ATTN_WIDTH ** -0.5),
        "conv_w": nrm((L, CONV_WIDTH, CONV_CH), CONV_WIDTH ** -0.5),
        "conv_b": nrm((L, CONV_CH), 0.01),
        "conv_ln_g": gain((L, CONV_CH)),
        "conv_ln_b": nrm((L, CONV_CH), 0.01),
        "w_conv_out": nrm((L, CONV_CH, D), CONV_CH ** -0.5),
        "w_out": nrm((L, D, D), D ** -0.5),
        "norm_x_g": gain((L, D)),
        "norm_mem_g": gain((L, D)),
        "w_q_x": nrm((L, D, D), D ** -0.5),
        "w_kv_x": nrm((L, D, 2 * D), D ** -0.5),
        "w_o_x": nrm((L, D, D), D ** -0.5),
        "norm_moe_g": gain((L, D)),
        "w_router_group": nrm((L, D, G), D ** -0.5),
        "b_router_group": nrm((L, G), 0.01),
        "w_router_expert": nrm((L, G, D, E), D ** -0.5),
        "b_router_expert": nrm((L, G, E), 0.01),
        "w_exp_gate": nrm((L, G, E, D, F), D ** -0.5),
        "w_exp_up": nrm((L, G, E, D, F), D ** -0.5),
        "w_exp_down": nrm((L, G, E, F, D), F ** -0.5),
        "norm_final_g": gain((D,)),
    }


def reference(x, mem, positions, norm_mix_g, w_in, w_o_attn, conv_w, conv_b, conv_ln_g, conv_ln_b,
              w_conv_out, w_out, norm_x_g, norm_mem_g, w_q_x, w_kv_x, w_o_x, norm_moe_g,
              w_router_group, b_router_group, w_router_expert, b_router_expert,
              w_exp_gate, w_exp_up, w_exp_down, norm_final_g):
    cos, sin = rope_tables(positions, HEAD_DIM)
    for l in range(DEPTH):
        x = mixing_sublayer(x, cos, sin, norm_mix_g[l], w_in[l], w_o_attn[l], conv_w[l], conv_b[l],
                            conv_ln_g[l], conv_ln_b[l], w_conv_out[l], w_out[l])
        x = memory_cross_attention(x, mem, norm_x_g[l], norm_mem_g[l], w_q_x[l], w_kv_x[l], w_o_x[l])
        x = x + hier_moe(rmsnorm(x, norm_moe_g[l]), w_router_group[l], b_router_group[l],
                         w_router_expert[l], b_router_expert[l],
                         w_exp_gate[l], w_exp_up[l], w_exp_down[l])
    return rmsnorm(x, norm_final_g)
```

```cpp
#include <hip/hip_runtime.h>
#include <hip/hip_bf16.h>
#include <cstdio>
#include <cstdint>
#include <cmath>
namespace pg8 {
#define PG8_LAS __attribute__((address_space(3)))
typedef unsigned short bf16_t;
typedef short bf16x8 __attribute__((ext_vector_type(8)));
typedef float f32x4 __attribute__((ext_vector_type(4)));
typedef unsigned u32x4 __attribute__((ext_vector_type(4)));
constexpr int BM = 256, BK = 64, HALF = 128, HTB = HALF * BK * 2  , STAGE_BYTES = 8 * HTB, NXCD = 8, WGM = 8;

__host__ __device__ __forceinline__ int lds_byte(int r, int c) { const int st = (r >> 4) * 2 + (c >> 5), rr = r & 15, cc = c & 31, ob = rr * 64 + cc * 2; return st * 1024 + (ob ^ (((ob >> 9) & 1) << 5)); }
__host__ __device__ __forceinline__ void stage_rc(int b, int& R, int& C) { const int st = b / 1024, sb = b % 1024, swz = sb ^ (((sb >> 9) & 1) << 5); R = (st >> 1) * 16 + swz / 64; C = (st & 1) * 32 + (swz % 64) / 2; }
__host__ __device__ __forceinline__ int perm32(int rho) { const int n = rho >> 4, i = rho & 15; return 8 * (i >> 2) + 4 * n + (i & 3); }

struct Unit { int pm, pn; };
struct Gemm { const bf16_t* A; const bf16_t* Bt; int M, N, K; };

struct StaticOrder {
    int nM, nN, nwg, G, c;
    __host__ __device__ void init(int M, int N, int G_, int c_) { nM = M / BM; nN = N / BM; nwg = nM * nN; G = G_; c = c_; }
    __host__ __device__ bool next(int i, Unit& u) const {
        const long L = (long)i * G + c; if (L >= nwg) return false;
        int wgid = (int)L; { const int q = nwg / NXCD, r = nwg % NXCD, xcd = wgid % NXCD, off = wgid / NXCD; wgid = (xcd < r ? xcd * (q + 1) : r * (q + 1) + (xcd - r) * q) + off; }
        const int nig = WGM * nN, gid = wgid / nig, fm = gid * WGM, gsz = (nM - fm) < WGM ? (nM - fm) : WGM;
        u.pm = fm + ((wgid % nig) % gsz); u.pn = (wgid % nig) / gsz; return true;
    }
    __device__ __forceinline__ void a_ready(const Unit&) const {}
    __device__ __forceinline__ void done(const Unit&) const {}
};

__device__ __forceinline__ unsigned cvt_pk_bf16(float lo, float hi) { unsigned r; asm volatile("v_cvt_pk_bf16_f32 %0, %1, %2" : "=v"(r) : "v"(lo), "v"(hi)); return r; }
typedef float f32x2 __attribute__((ext_vector_type(2)));
__device__ __forceinline__ f32x2 gelu_pk(f32x2 v) {
    const f32x2 av = __builtin_elementwise_abs(v), d = av * 0.2316418882f + 1.0f;
    f32x2 t; t.x = __builtin_amdgcn_rcpf(d.x); t.y = __builtin_amdgcn_rcpf(d.y);
    f32x2 q = t * 0.5307027145f + (-0.7265760135f); q = q * t + 0.7107068705f; q = q * t + (-0.142248368f); q = q * t + 0.127414796f; q = q * t;
    const f32x2 s = (v * v) * (-0.72134752044f);
    f32x2 e; e.x = __builtin_amdgcn_exp2f(s.x); e.y = __builtin_amdgcn_exp2f(s.y);
    const f32x2 m = v * (q * e), r = v - m;
    f32x2 o; o.x = v.x < 0.f ? m.x : r.x; o.y = v.y < 0.f ? m.y : r.y; return o;
}

template <int ACT  > struct EpiBf16 {
    static constexpr bool PERM = true, AFTER_DRAIN = false; static_assert(ACT == 0 || ACT == 1, "EpiBf16: ACT is 0 (none) or 1 (gelu_pk)");
    bf16_t* O; int ldc; const float* bias; int split_cols; size_t split_stride; float scale0;
    __device__ __forceinline__ void operator()(const f32x4 (&acc)[2][2][4][2], const Unit& u, int wr, int wc, int fr, int fq) const {
        const int row0 = u.pm * BM + wr * 64 + fr; int colt = u.pn * BM; bf16_t* base = O;
        float sc = 1.f; if (split_cols) { const int t = colt / split_cols; base += (size_t)t * split_stride; colt -= t * split_cols; if (t == 0) sc = scale0; }
        const int col0 = colt + wc * 32 + 8 * fq, bcol0 = u.pn * BM + wc * 32 + 8 * fq;
        f32x4 bv[2][2];
#pragma unroll
        for (int bj = 0; bj < 2; ++bj)
#pragma unroll
            for (int n = 0; n < 2; ++n) bv[bj][n] = bias ? *(const f32x4*)(bias + bcol0 + bj * HALF + 4 * n) : (f32x4){0.f, 0.f, 0.f, 0.f};
#pragma unroll
        for (int ai = 0; ai < 2; ++ai)
#pragma unroll
            for (int m = 0; m < 4; ++m) { bf16_t* rowp = base + (size_t)(row0 + ai * HALF + m * 16) * ldc + col0;
#pragma unroll
                for (int bj = 0; bj < 2; ++bj) { f32x4 v0 = acc[ai][bj][m][0] + bv[bj][0], v1 = acc[ai][bj][m][1] + bv[bj][1];
                    if (ACT == 1) { f32x2 a = gelu_pk((f32x2){v0[0], v0[1]}), b = gelu_pk((f32x2){v0[2], v0[3]}), c = gelu_pk((f32x2){v1[0], v1[1]}), d = gelu_pk((f32x2){v1[2], v1[3]});
                        v0 = (f32x4){a.x, a.y, b.x, b.y}; v1 = (f32x4){c.x, c.y, d.x, d.y}; }
                    v0 = v0 * sc; v1 = v1 * sc; u32x4 w; w.x = cvt_pk_bf16(v0[0], v0[1]); w.y = cvt_pk_bf16(v0[2], v0[3]); w.z = cvt_pk_bf16(v1[0], v1[1]); w.w = cvt_pk_bf16(v1[2], v1[3]);
                    *(u32x4*)(rowp + bj * HALF) = w; } }
    }
};
__device__ __forceinline__ u32x4 pack8(const f32x4& a, const f32x4& b) { u32x4 w; w.x = cvt_pk_bf16(a[0], a[1]); w.y = cvt_pk_bf16(a[2], a[3]); w.z = cvt_pk_bf16(b[0], b[1]); w.w = cvt_pk_bf16(b[2], b[3]); return w; }
__device__ __forceinline__ unsigned short f2bf_rne(float f) { unsigned u = __builtin_bit_cast(unsigned, f); return (unsigned short)((u + 0x7fffu + ((u >> 16) & 1u)) >> 16); }
__device__ __forceinline__ f32x4 bf_lo4(const u32x4& w) { return (f32x4){__builtin_bit_cast(float, w.x << 16), __builtin_bit_cast(float, w.x & 0xffff0000u), __builtin_bit_cast(float, w.y << 16), __builtin_bit_cast(float, w.y & 0xffff0000u)}; }
__device__ __forceinline__ f32x4 bf_hi4(const u32x4& w) { return (f32x4){__builtin_bit_cast(float, w.z << 16), __builtin_bit_cast(float, w.z & 0xffff0000u), __builtin_bit_cast(float, w.w << 16), __builtin_bit_cast(float, w.w & 0xffff0000u)}; }
__device__ __forceinline__ f32x4 sigmoid4(const f32x4& v) { f32x4 r;
#pragma unroll
    for (int i = 0; i < 4; ++i) r[i] = __builtin_amdgcn_rcpf(1.0f + __builtin_amdgcn_exp2f(-1.4426950408889634f * v[i]));
    return r; }

struct EpiRope {
    static constexpr bool PERM = true, AFTER_DRAIN = false;
    bf16_t* O0; size_t tstride; const float* rstd; const float* rope;
    __device__ __forceinline__ void operator()(const f32x4 (&acc)[2][2][4][2], const Unit& u, int wr, int wc, int fr, int fq) const {
        bf16_t* base = O0 + (size_t)(u.pn >> 1) * tstride + (((u.pn & 1) * 4 + wc) * 64 + 8 * fq);
        const int row0 = u.pm * BM + wr * 64 + fr;
#pragma unroll
        for (int ai = 0; ai < 2; ++ai)
#pragma unroll
            for (int m = 0; m < 4; ++m) {
                const int row = row0 + ai * HALF + m * 16; const float rs = rstd[row];
                const float* rp = rope + (size_t)row * 64 + 8 * fq;
                const f32x4 c0 = *(const f32x4*)rp, c1 = *(const f32x4*)(rp + 4), s0 = *(const f32x4*)(rp + 32), s1 = *(const f32x4*)(rp + 36);
                const f32x4 x1a = acc[ai][0][m][0] * rs, x1b = acc[ai][0][m][1] * rs, x2a = acc[ai][1][m][0] * rs, x2b = acc[ai][1][m][1] * rs;
                bf16_t* op = base + (size_t)row * 512;
                *(u32x4*)op = pack8(x1a * c0 - x2a * s0, x1b * c1 - x2b * s1);
                *(u32x4*)(op + 32) = pack8(x2a * c0 + x1a * s0, x2b * c1 + x1b * s1);
            }
    }
};
struct EpiScale {
    static constexpr bool PERM = true, AFTER_DRAIN = false;
    bf16_t* O; int ldc; const float* rstd; const float* rowsq; float eps;
    __device__ __forceinline__ void operator()(const f32x4 (&acc)[2][2][4][2], const Unit& u, int wr, int wc, int fr, int fq) const {
        const int row0 = u.pm * BM + wr * 64 + fr, col0 = u.pn * BM + wc * 32 + 8 * fq;
#pragma unroll
        for (int ai = 0; ai < 2; ++ai)
#pragma unroll
            for (int m = 0; m < 4; ++m) {
                const int row = row0 + ai * HALF + m * 16;
                const float rs = rstd ? rstd[row] : (rowsq ? __builtin_amdgcn_rsqf(rowsq[row] * (1.0f / 1024.0f) + eps) : 1.0f);
                bf16_t* op = O + (size_t)row * ldc + col0;
#pragma unroll
                for (int bj = 0; bj < 2; ++bj) *(u32x4*)(op + bj * HALF) = pack8(acc[ai][bj][m][0] * rs, acc[ai][bj][m][1] * rs);
            }
    }
};
struct EpiMemKV {
    static constexpr bool PERM = true, AFTER_DRAIN = false;
    bf16_t* KX; bf16_t* VT; const float* rstd;
    __device__ __forceinline__ void operator()(const f32x4 (&acc)[2][2][4][2], const Unit& u, int wr, int wc, int fr, int fq) const {
        const int row0 = u.pm * BM + wr * 64 + fr, col0 = u.pn * BM + wc * 32 + 8 * fq;
#pragma unroll
        for (int ai = 0; ai < 2; ++ai)
#pragma unroll
            for (int m = 0; m < 4; ++m) {
                const int row = row0 + ai * HALF + m * 16; const float rs = rstd[row];
#pragma unroll
                for (int bj = 0; bj < 2; ++bj) {
                    const f32x4 v0 = acc[ai][bj][m][0] * rs, v1 = acc[ai][bj][m][1] * rs; const int col = col0 + bj * HALF;
                    if (u.pn < 4) { *(u32x4*)(KX + (size_t)row * 1024 + col) = pack8(v0, v1); }
                    else { const int c = col - 1024, h = c >> 8, dv = c & 255, b = row >> 8, key = row & 255, kp = (key & ~12) | ((key & 4) << 1) | ((key & 8) >> 1);
                        bf16_t* p = VT + (((size_t)(b * 4 + h) * 256 + dv) * 256 + kp);
#pragma unroll
                        for (int j = 0; j < 4; ++j) { p[(size_t)j * 256] = f2bf_rne(v0[j]); p[(size_t)(j + 4) * 256] = f2bf_rne(v1[j]); } }
                }
            }
    }
};
struct EpiGlu {
    static constexpr bool PERM = true, AFTER_DRAIN = false;
    bf16_t* U; const float* rstd;
    __device__ __forceinline__ void operator()(const f32x4 (&acc)[2][2][4][2], const Unit& u, int wr, int wc, int fr, int fq) const {
        const int row0 = u.pm * BM + wr * 64 + fr, col0 = u.pn * HALF + wc * 32 + 8 * fq;
#pragma unroll
        for (int ai = 0; ai < 2; ++ai)
#pragma unroll
            for (int m = 0; m < 4; ++m) {
                const int row = row0 + ai * HALF + m * 16; const float rs = rstd[row];
                const f32x4 a0 = acc[ai][0][m][0] * rs, a1 = acc[ai][0][m][1] * rs, b0 = acc[ai][1][m][0] * rs, b1 = acc[ai][1][m][1] * rs;
                *(u32x4*)(U + (size_t)row * 512 + col0) = pack8(a0 * sigmoid4(b0), a1 * sigmoid4(b1));
            }
    }
};
struct EpiKiWi {
    static constexpr bool PERM = true, AFTER_DRAIN = false;
    bf16_t* KI; float* WI; const float* rstd; const float* rope;
    __device__ __forceinline__ void operator()(const f32x4 (&acc)[2][2][4][2], const Unit& u, int wr, int wc, int fr, int fq) const {
        const int row0 = u.pm * BM + wr * 64 + fr;
        if (wc == 0) {
#pragma unroll
            for (int ai = 0; ai < 2; ++ai)
#pragma unroll
                for (int m = 0; m < 4; ++m) {
                    const int row = row0 + ai * HALF + m * 16; const float rs = rstd[row];
                    const float* rp = rope + (size_t)row * 64 + 8 * fq;
                    const f32x4 c0 = *(const f32x4*)rp, c1 = *(const f32x4*)(rp + 4), s0 = *(const f32x4*)(rp + 32), s1 = *(const f32x4*)(rp + 36);
                    const f32x4 x1a = acc[ai][0][m][0] * rs, x1b = acc[ai][0][m][1] * rs, x2a = acc[ai][1][m][0] * rs, x2b = acc[ai][1][m][1] * rs;
                    bf16_t* op = KI + (size_t)row * 64 + 8 * fq;
                    *(u32x4*)op = pack8(x1a * c0 - x2a * s0, x1b * c1 - x2b * s1);
                    *(u32x4*)(op + 32) = pack8(x2a * c0 + x1a * s0, x2b * c1 + x1b * s1);
                }
        } else if (wc == 1 && fq == 0) {
#pragma unroll
            for (int ai = 0; ai < 2; ++ai)
#pragma unroll
                for (int m = 0; m < 4; ++m) {
                    const int row = row0 + ai * HALF + m * 16; const float rs = rstd[row];
                    float* op = WI + (size_t)row * 8;
                    *(f32x4*)op = acc[ai][0][m][0] * rs; *(f32x4*)(op + 4) = acc[ai][0][m][1] * rs;
                }
        }
    }
};
struct EpiMerge {
    static constexpr bool PERM = true, AFTER_DRAIN = false;
    const bf16_t* YA; const bf16_t* YC; bf16_t* MG; const float* rstd;
    __device__ __forceinline__ void operator()(const f32x4 (&acc)[2][2][4][2], const Unit& u, int wr, int wc, int fr, int fq) const {
        const int row0 = u.pm * BM + wr * 64 + fr, col0 = u.pn * HALF + wc * 32 + 8 * fq;
#pragma unroll
        for (int ai = 0; ai < 2; ++ai)
#pragma unroll
            for (int m = 0; m < 4; ++m) {
                const int row = row0 + ai * HALF + m * 16; const float rs = rstd[row]; const size_t off = (size_t)row * 1024 + col0;
                const u32x4 ya = *(const u32x4*)(YA + off), yc = *(const u32x4*)(YC + off);
                const f32x4 o0 = sigmoid4(acc[ai][0][m][0] * rs) * bf_lo4(ya) + sigmoid4(acc[ai][1][m][0] * rs) * bf_lo4(yc);
                const f32x4 o1 = sigmoid4(acc[ai][0][m][1] * rs) * bf_hi4(ya) + sigmoid4(acc[ai][1][m][1] * rs) * bf_hi4(yc);
                *(u32x4*)(MG + off) = pack8(o0, o1);
            }
    }
};
struct EpiResid {
    static constexpr bool PERM = true, AFTER_DRAIN = false;
    const float* resid; float* xout; bf16_t* xb; float* rowsq;
    __device__ __forceinline__ void operator()(const f32x4 (&acc)[2][2][4][2], const Unit& u, int wr, int wc, int fr, int fq) const {
        const int row0 = u.pm * BM + wr * 64 + fr, col0 = u.pn * BM + wc * 32 + 8 * fq;
#pragma unroll
        for (int ai = 0; ai < 2; ++ai)
#pragma unroll
            for (int m = 0; m < 4; ++m) {
                const int row = row0 + ai * HALF + m * 16; float ss = 0.f;
#pragma unroll
                for (int bj = 0; bj < 2; ++bj) { const size_t off = (size_t)row * 1024 + col0 + bj * HALF;
                    const f32x4 v0 = *(const f32x4*)(resid + off) + acc[ai][bj][m][0], v1 = *(const f32x4*)(resid + off + 4) + acc[ai][bj][m][1];
                    *(f32x4*)(xout + off) = v0; *(f32x4*)(xout + off + 4) = v1; *(u32x4*)(xb + off) = pack8(v0, v1);
                    ss += (v0[0] * v0[0] + v0[1] * v0[1]) + (v0[2] * v0[2] + v0[3] * v0[3]) + (v1[0] * v1[0] + v1[1] * v1[1]) + (v1[2] * v1[2] + v1[3] * v1[3]); }
                ss += __shfl_xor(ss, 16); ss += __shfl_xor(ss, 32);
                if (fq == 0) atomicAdd(rowsq + row, ss);
            }
    }
};
template <class Epi, class Sched, bool ALIGN_EPI = false, bool SP2 = false>
__device__ __forceinline__ void gemm_phase(PG8_LAS unsigned char* lds, const Gemm g, const Sched& S, const Epi& E) {
    const int tid = threadIdx.x, wid = __builtin_amdgcn_readfirstlane(tid >> 6), lane = tid & 63, wr = wid >> 2, wc = wid & 3, fr = lane & 15, fq = lane >> 4;
    const int K = g.K, nt = K / BK;
    unsigned voffA[2], voffB[2];
#pragma unroll
    for (int i = 0; i < 2; ++i) { int R, C; stage_rc(tid * 16 + i * 8192, R, C); const int Rb = Epi::PERM ? ((R & ~31) + perm32(R & 31)) : R;
        voffA[i] = (unsigned)(R * K + C) * 2u; voffB[i] = (unsigned)(Rb * K + C) * 2u; }
    const size_t kstep = (size_t)(BK * 2);
    const size_t hstep = (size_t)HALF * K * 2;
    const size_t tstep = 2 * hstep;
    const unsigned ldsw = (unsigned)wid * 1024u;
    const int aoff = lds_byte(wr * 64 + fr, fq * 8), boff = lds_byte(wc * 32 + fr, fq * 8);
#define PG8_SA(b, h) (((b) * 2 + (h)) * HTB)
#define PG8_SB(b, h) ((4 + (b) * 2 + (h)) * HTB)
#define PG8_STAGE(bufoff, gbase, voff) do { _Pragma("unroll") for (int _i = 0; _i < 2; ++_i) \
        __builtin_amdgcn_global_load_lds((const unsigned*)((const char*)(gbase) + (voff)[_i]), (PG8_LAS unsigned*)(lds + (bufoff) + ldsw + _i * 8192), 16, 0, 0); } while (0)
#define PG8_LDA(dst, b, h) do { _Pragma("unroll") for (int m = 0; m < 4; ++m) _Pragma("unroll") for (int k = 0; k < 2; ++k) dst[m][k] = *(const PG8_LAS bf16x8*)(lds + PG8_SA(b, h) + aoff + m * 2048 + k * 1024); } while (0)
#define PG8_LDB(dst, b, h) do { _Pragma("unroll") for (int n = 0; n < 2; ++n) _Pragma("unroll") for (int k = 0; k < 2; ++k) dst[n][k] = *(const PG8_LAS bf16x8*)(lds + PG8_SB(b, h) + boff + n * 2048 + k * 1024); } while (0)
#define PG8_MMA(ai, bj, At, Bt) do { __builtin_amdgcn_s_setprio(1); _Pragma("unroll") for (int m = 0; m < 4; ++m) _Pragma("unroll") for (int n = 0; n < 2; ++n) _Pragma("unroll") for (int k = 0; k < 2; ++k) \
        acc[ai][bj][m][n] = __builtin_amdgcn_mfma_f32_16x16x32_bf16(Bt[n][k], At[m][k], acc[ai][bj][m][n], 0, 0, 0); __builtin_amdgcn_s_setprio(0); } while (0)
#define PG8_WAIT_V(n) asm volatile("s_waitcnt vmcnt(" #n ")" ::: "memory")
#define PG8_WAIT_L(n) asm volatile("s_waitcnt lgkmcnt(" #n ")" ::: "memory")
#define PG8_BAR __builtin_amdgcn_s_barrier()
#define PG8_SCHED __builtin_amdgcn_sched_barrier(0)
    Unit cur, nxt; int ui = 0;
    if (!S.next(0, cur)) return;
    f32x4 acc[2][2][4][2];
#pragma unroll
    for (int a = 0; a < 2; ++a)
#pragma unroll
        for (int b = 0; b < 2; ++b)
#pragma unroll
            for (int m = 0; m < 4; ++m)
#pragma unroll
                for (int n = 0; n < 2; ++n) acc[a][b][m][n] = (f32x4){0.f, 0.f, 0.f, 0.f};
    bf16x8 At[4][2], B0[2][2], B1[2][2];
    const char* cA = (const char*)g.A + (size_t)cur.pm * tstep; const char* cB = (const char*)g.Bt + (size_t)cur.pn * tstep;
    S.a_ready(cur);
    if constexpr (SP2) {
        PG8_STAGE(PG8_SB(0, 0), cB, voffB); PG8_STAGE(PG8_SB(0, 1), cB + hstep, voffB); PG8_STAGE(PG8_SA(0, 0), cA, voffA); PG8_STAGE(PG8_SA(0, 1), cA + hstep, voffA);
        if (wr == 1) PG8_BAR;
        PG8_WAIT_V(2); PG8_BAR;
        PG8_STAGE(PG8_SB(1, 0), cB + kstep, voffB); PG8_STAGE(PG8_SA(1, 0), cA + kstep, voffA); PG8_STAGE(PG8_SB(1, 1), cB + hstep + kstep, voffB);
        PG8_WAIT_V(6); PG8_BAR;
    } else {
        PG8_STAGE(PG8_SB(0, 0), cB, voffB); PG8_STAGE(PG8_SA(0, 0), cA, voffA); PG8_STAGE(PG8_SB(0, 1), cB + hstep, voffB); PG8_STAGE(PG8_SA(0, 1), cA + hstep, voffA);
        if (wr == 1) PG8_BAR;
        PG8_WAIT_V(4); PG8_BAR;
        PG8_STAGE(PG8_SB(1, 0), cB + kstep, voffB); PG8_STAGE(PG8_SA(1, 0), cA + kstep, voffA); PG8_STAGE(PG8_SB(1, 1), cB + hstep + kstep, voffB);
        PG8_WAIT_V(6); PG8_BAR;
    }
    for (;;) {
        const bool has_next = S.next(ui + 1, nxt);
        const char* nA = has_next ? (const char*)g.A + (size_t)nxt.pm * tstep : cA; const char* nB = has_next ? (const char*)g.Bt + (size_t)nxt.pn * tstep : cB;
        for (int t = 0; t < nt; t += 2) {
            const bool last = (t == nt - 2);
            const char* a1 = cA + (size_t)(t + 1) * kstep;
            const char* a2 = last ? nA : cA + (size_t)(t + 2) * kstep; const char* b2 = last ? nB : cB + (size_t)(t + 2) * kstep;
            const char* a3 = a2 + kstep; const char* b3 = b2 + kstep;
            if (last && has_next) S.a_ready(nxt);
            if constexpr (SP2) {
            PG8_LDB(B0, 0, 0); PG8_LDB(B1, 0, 1); PG8_SCHED; PG8_LDA(At, 0, 0); PG8_STAGE(PG8_SA(1, 1), a1 + hstep, voffA);
            PG8_WAIT_V(8); PG8_WAIT_L(0); PG8_BAR; PG8_MMA(0, 0, At, B0); PG8_MMA(0, 1, At, B1); PG8_BAR; PG8_SCHED;
            PG8_LDA(At, 0, 1); PG8_STAGE(PG8_SB(0, 0), b2, voffB); PG8_STAGE(PG8_SB(0, 1), b2 + hstep, voffB); PG8_STAGE(PG8_SA(0, 0), a2, voffA);
            PG8_WAIT_V(8); PG8_WAIT_L(0); PG8_BAR; PG8_MMA(1, 0, At, B0); PG8_MMA(1, 1, At, B1); PG8_BAR; PG8_SCHED;
            PG8_LDB(B0, 1, 0); PG8_LDB(B1, 1, 1); PG8_SCHED; PG8_LDA(At, 1, 0); PG8_STAGE(PG8_SA(0, 1), a2 + hstep, voffA);
            PG8_WAIT_V(8); PG8_WAIT_L(0); PG8_BAR; PG8_MMA(0, 0, At, B0); PG8_MMA(0, 1, At, B1); PG8_BAR; PG8_SCHED;
            PG8_LDA(At, 1, 1); PG8_STAGE(PG8_SB(1, 0), b3, voffB); PG8_STAGE(PG8_SB(1, 1), b3 + hstep, voffB); PG8_STAGE(PG8_SA(1, 0), a3, voffA);
            PG8_WAIT_V(8); PG8_WAIT_L(0); PG8_BAR; PG8_MMA(1, 0, At, B0); PG8_MMA(1, 1, At, B1); PG8_BAR; PG8_SCHED;
            } else {
            PG8_LDB(B0, 0, 0); PG8_SCHED; PG8_LDA(At, 0, 0); PG8_STAGE(PG8_SA(1, 1), a1 + hstep, voffA);
            PG8_WAIT_L(8); PG8_BAR; PG8_WAIT_L(0); PG8_MMA(0, 0, At, B0); PG8_BAR; PG8_SCHED;
            PG8_LDB(B1, 0, 1); PG8_STAGE(PG8_SB(0, 0), b2, voffB);
            PG8_BAR; PG8_WAIT_L(0); PG8_MMA(0, 1, At, B1); PG8_BAR;
            PG8_LDA(At, 0, 1); PG8_STAGE(PG8_SA(0, 0), a2, voffA);
            PG8_BAR; PG8_WAIT_L(0); PG8_MMA(1, 0, At, B0); PG8_BAR; PG8_SCHED;
            PG8_STAGE(PG8_SB(0, 1), b2 + hstep, voffB);
            PG8_WAIT_V(6); PG8_BAR; PG8_MMA(1, 1, At, B1); PG8_BAR;
            PG8_LDB(B0, 1, 0); PG8_SCHED; PG8_LDA(At, 1, 0); PG8_STAGE(PG8_SA(0, 1), a2 + hstep, voffA);
            PG8_WAIT_L(8); PG8_BAR; PG8_WAIT_L(0); PG8_MMA(0, 0, At, B0); PG8_BAR; PG8_SCHED;
            PG8_LDB(B1, 1, 1); PG8_STAGE(PG8_SB(1, 0), b3, voffB);
            PG8_BAR; PG8_WAIT_L(0); PG8_MMA(0, 1, At, B1); PG8_BAR;
            PG8_LDA(At, 1, 1); PG8_STAGE(PG8_SA(1, 0), a3, voffA);
            PG8_BAR; PG8_WAIT_L(0); PG8_MMA(1, 0, At, B0); PG8_BAR; PG8_SCHED;
            PG8_STAGE(PG8_SB(1, 1), b3 + hstep, voffB);
            PG8_WAIT_V(6); PG8_BAR; PG8_MMA(1, 1, At, B1); PG8_BAR;
            }
        }
        if constexpr (ALIGN_EPI) { if (wr == 0) PG8_BAR; }
        if constexpr (!Epi::AFTER_DRAIN) { E(acc, cur, wr, wc, fr, fq); S.done(cur); }
        if (!has_next) break;
#pragma unroll
        for (int a = 0; a < 2; ++a)
#pragma unroll
            for (int b = 0; b < 2; ++b)
#pragma unroll
                for (int m = 0; m < 4; ++m)
#pragma unroll
                    for (int n = 0; n < 2; ++n) acc[a][b][m][n] = (f32x4){0.f, 0.f, 0.f, 0.f};
        cur = nxt; cA = nA; cB = nB; ++ui;
        if constexpr (ALIGN_EPI) { if (wr == 1) PG8_BAR; }
    }
    PG8_WAIT_V(0);
    if constexpr (!ALIGN_EPI) { if (wr == 0) PG8_BAR; }
    PG8_BAR;
    if constexpr (Epi::AFTER_DRAIN) { E.fused(acc, cur, wr, wc, fr, fq, lds, wid, lane); S.done(cur); }
#undef PG8_SA
#undef PG8_SB
#undef PG8_STAGE
#undef PG8_LDA
#undef PG8_LDB
#undef PG8_MMA
#undef PG8_WAIT_V
#undef PG8_WAIT_L
#undef PG8_BAR
#undef PG8_SCHED
}
}
#ifndef PG8_SP2
#define PG8_SP2 true
#endif
#ifndef PG8_ALIGN
#define PG8_ALIGN true
#endif
namespace attn_body {
using bf16=__hip_bfloat16;
using bf16x8=__attribute__((ext_vector_type(8)))short;
using s16x4=__attribute__((ext_vector_type(4)))short;
using f32x16=__attribute__((ext_vector_type(16)))float;
using u32x4=__attribute__((ext_vector_type(4)))unsigned;
constexpr int BATCH=8,NHEAD=8,SEQ=4096,D=64,DM=NHEAD*D;
constexpr int NW=8,QBLK=32,QB=QBLK*NW,KVBLK=64,NQB=SEQ/QB;
constexpr int ATTN_PITCH=DM, ATTN_UNIT_ROWS=QB;
__device__ __forceinline__ int crow(int r,int hi){return (r&3)+8*(r>>2)+4*hi;}
#define SBAR() __builtin_amdgcn_sched_barrier(0)
__device__ __forceinline__ void cmask(f32x16&p0,f32x16&p1,int jb,int qrel,int hi){
  const float NEG=-INFINITY; int kb=64*jb+4*hi;
  #pragma unroll
  for(int r=0;r<16;++r){int kv=kb+(r&3)+8*(r>>2); if(kv>qrel)p0[r]=NEG; if(kv+32>qrel)p1[r]=NEG;}
}

constexpr int NSLOT=3, SLOTB=8192;
constexpr int LDS_K=0, LDS_V=NSLOT*SLOTB, LDS_WS=2*NSLOT*SLOTB, LDS_OST=LDS_WS+NW*64*4, LDS_BYTES=LDS_OST+NW*4096;
constexpr float C2=0.125f*1.4426950408889634f;
__device__ __forceinline__ void glds16(const void*gsrc,unsigned lds_dst){unsigned keep;
  asm volatile("s_mov_b32 %0, m0\n\ts_mov_b32 m0, %2\n\ts_nop 0\n\tglobal_load_lds_dwordx4 %1, off\n\ts_mov_b32 m0, %0":"=&s"(keep):"v"(gsrc),"s"(lds_dst):"memory");}
__device__ __forceinline__ float max3f(float a,float b,float c){float r;asm("v_max3_f32 %0, %1, %2, %3":"=v"(r):"v"(a),"v"(b),"v"(c));return r;}
__device__ __forceinline__ float max2f(float a,float b){float r;asm("v_max_f32_e32 %0, %1, %2":"=v"(r):"v"(a),"v"(b));return r;}
__device__ __forceinline__ float fadd_s(float a,float b){float r;asm("v_add_f32_e32 %0, %1, %2":"=v"(r):"v"(a),"v"(b));return r;}
__device__ __forceinline__ float fsub_s(float a,float b){float r;asm("v_sub_f32_e32 %0, %1, %2":"=v"(r):"v"(a),"v"(b));return r;}
typedef float f32x2_t __attribute__((ext_vector_type(2))); typedef __bf16 bf16x2_t __attribute__((ext_vector_type(2)));
__device__ __forceinline__ unsigned cvtpk_s(float lo,float hi){f32x2_t v={lo,hi};bf16x2_t b=__builtin_convertvector(v,bf16x2_t);return __builtin_bit_cast(unsigned,b);}
#define WAIT_BAR(N) asm volatile("s_waitcnt vmcnt(" #N ") lgkmcnt(0)\n\ts_barrier":::"memory")

__device__ __forceinline__ void qkt(f32x16&p0,f32x16&p1,const char*Kslot,const bf16x8*qr,const f32x16&negm,int r32,int hi){
  const char*kb=Kslot+hi*1024+r32*16;
  #pragma unroll
  for(int d0=0;d0<4;++d0){
    const bf16x8 b0=*reinterpret_cast<const bf16x8*>(kb+d0*2048);
    const bf16x8 b1=*reinterpret_cast<const bf16x8*>(kb+d0*2048+512);
    if(d0==0){p0=__builtin_amdgcn_mfma_f32_32x32x16_bf16(b0,qr[0],negm,0,0,0);p1=__builtin_amdgcn_mfma_f32_32x32x16_bf16(b1,qr[0],negm,0,0,0);}
    else{p0=__builtin_amdgcn_mfma_f32_32x32x16_bf16(b0,qr[d0],p0,0,0,0);p1=__builtin_amdgcn_mfma_f32_32x32x16_bf16(b1,qr[d0],p1,0,0,0);}}
}
typedef __attribute__((address_space(3))) const char* lds_cptr;
typedef short v4i16_t __attribute__((ext_vector_type(4)));
__device__ __forceinline__ void kload8(bf16x8*kf,lds_cptr kp){
  kf[0]=*(const __attribute__((address_space(3))) bf16x8*)(kp);      kf[1]=*(const __attribute__((address_space(3))) bf16x8*)(kp+512);
  kf[2]=*(const __attribute__((address_space(3))) bf16x8*)(kp+2048); kf[3]=*(const __attribute__((address_space(3))) bf16x8*)(kp+2560);
  kf[4]=*(const __attribute__((address_space(3))) bf16x8*)(kp+4096); kf[5]=*(const __attribute__((address_space(3))) bf16x8*)(kp+4608);
  kf[6]=*(const __attribute__((address_space(3))) bf16x8*)(kp+6144); kf[7]=*(const __attribute__((address_space(3))) bf16x8*)(kp+6656);
}
__device__ __forceinline__ void kload2(bf16x8*kf,lds_cptr kp,int j){ kf[2*j]=*(const __attribute__((address_space(3))) bf16x8*)(kp+j*2048); kf[2*j+1]=*(const __attribute__((address_space(3))) bf16x8*)(kp+j*2048+512); }
__device__ __forceinline__ s16x4 vtr(lds_cptr p){ return __builtin_bit_cast(s16x4,__builtin_amdgcn_ds_read_tr16_b64_v4i16((__attribute__((address_space(3))) v4i16_t*)p)); }
__device__ __forceinline__ float rowmax(const f32x16&p0,const f32x16&p1){
  float a=max3f(p0[0],p0[1],p1[0]),b=max3f(p0[2],p0[3],p1[1]);a=max3f(a,p1[2],p1[3]);
  #pragma unroll
  for(int r=4;r<16;r+=4){a=max3f(a,p0[r],p0[r+1]);b=max3f(b,p0[r+2],p0[r+3]);a=max3f(a,p1[r],p1[r+1]);b=max3f(b,p1[r+2],p1[r+3]);}
  const float m=max2f(a,b);
  auto rr=__builtin_amdgcn_permlane32_swap(__float_as_uint(m),__float_as_uint(m),false,false);
  return max2f(__uint_as_float(rr[0]),__uint_as_float(rr[1]));
}
__device__ __forceinline__ void pv(f32x16*o,int vb,bf16x8 pa0,bf16x8 pa1,bf16x8 pa2,bf16x8 pa3){
  #pragma unroll
  for(int d0=0;d0<2;++d0){s16x4 lo[4],hi[4];
    #pragma unroll
    for(int ks=0;ks<4;++ks){
      asm volatile("ds_read_b64_tr_b16 %0,%1 offset:%c2":"=&v"(lo[ks]):"v"(vb),"i"(d0*4096+ks*1024):"memory");
      asm volatile("ds_read_b64_tr_b16 %0,%1 offset:%c2":"=&v"(hi[ks]):"v"(vb),"i"(d0*4096+ks*1024+512):"memory");}
    asm volatile("s_waitcnt lgkmcnt(0)":::"memory");SBAR();
    #define PK(k) (bf16x8){lo[k][0],lo[k][1],lo[k][2],lo[k][3],hi[k][0],hi[k][1],hi[k][2],hi[k][3]}
    o[d0]=__builtin_amdgcn_mfma_f32_32x32x16_bf16(pa0,PK(0),o[d0],0,0,0);
    o[d0]=__builtin_amdgcn_mfma_f32_32x32x16_bf16(pa1,PK(1),o[d0],0,0,0);
    o[d0]=__builtin_amdgcn_mfma_f32_32x32x16_bf16(pa2,PK(2),o[d0],0,0,0);
    o[d0]=__builtin_amdgcn_mfma_f32_32x32x16_bf16(pa3,PK(3),o[d0],0,0,0);
    #undef PK
  }
}

#ifndef ATTN_STORE16
#define ATTN_STORE16(p,v) (*(u32x4*)(p)=(v))
#endif
template<int THRL> __device__ __forceinline__ void attn_unit(int b,int h,int qb,const bf16*Q,const bf16*__restrict__ K,const bf16*__restrict__ V,bf16*O,const uint2*MaskBase,char*shm){
  const int tid=threadIdx.x,lane=tid&63,r32=lane&31,hi=lane>>5; const int wid=__builtin_amdgcn_readfirstlane(tid>>6);
  const long rowbase=(long)b*SEQ; const int q0=qb*QB;
  const bf16*Qw=Q+(rowbase+q0+wid*QBLK)*DM+h*D;
  const bf16*Kh=K+rowbase*DM+h*D,*Vh=V+rowbase*DM+h*D;
  const unsigned lds0=(unsigned)(uintptr_t)shm;
  float*wsf=(float*)(shm+LDS_WS)+wid*64;
  const bf16*ksrc=Kh+(long)lane*DM+wid*8;
  const bf16*vsrc=Vh+(long)(16*(wid&3)+(lane>>2))*DM+(wid>>2)*32+(lane&3)*8;
  const unsigned kdst=lds0+LDS_K+wid*1024, vdst=lds0+LDS_V+wid*1024;
  #define DMA_K(t,slot) glds16(ksrc+(long)(t)*KVBLK*DM,(unsigned)__builtin_amdgcn_readfirstlane(kdst+(slot)))
  #define DMA_V(t,slot) glds16(vsrc+(long)(t)*KVBLK*DM,(unsigned)__builtin_amdgcn_readfirstlane(vdst+(slot)))
  const int vb0=(int)(lds0+LDS_V)+((lane>>4)&1)*32+(lane&3)*8+(4*hi+((lane&15)>>2))*64;
  const char*Kbase=shm+LDS_K; bf16x8 kf[8];
  const lds_cptr shm3=(lds_cptr)shm; const lds_cptr kp0=shm3+LDS_K+hi*1024+r32*16; const lds_cptr vp0=shm3+LDS_V+((lane>>4)&1)*32+(lane&3)*8+(4*hi+((lane&15)>>2))*64;
  const int NT=(q0+QB)/KVBLK;
  DMA_K(0,0);DMA_V(0,0);DMA_K(1,SLOTB);
  bf16x8 qr[4];
  #pragma unroll
  for(int d0=0;d0<4;++d0)qr[d0]=*reinterpret_cast<const bf16x8*>(&Qw[(long)r32*DM+d0*16+hi*8]);
  float mhat=0.f,l_reg=0.f;f32x16 o[2];o[0]=f32x16{};o[1]=f32x16{};f32x16 negm=f32x16{};asm volatile("":"+v"(negm));
  const int qrel=wid*QBLK+r32;
  const uint2*mrow=MaskBase+((size_t)(rowbase+q0+qrel))*64;
  const int sh4=4*hi; uint2 mraw=mrow[0]; unsigned mw0=mraw.x>>sh4, mw1=mraw.y>>sh4; mraw=mrow[1]; unsigned mwc0=mraw.x>>sh4, mwc1=mraw.y>>sh4, mwn0=mwc0, mwn1=mwc1;
  #define MSKB(v,mw,bit) __uint_as_float(__float_as_uint(v)&(unsigned)(((int)((mw)<<(31-(bit))))>>31))
  #define MBIT(r) (((r)&3)+8*((r)>>2))
  #define CMASK(P0,P1,t) do{}while(0)
  bool resc=false;
  #define START(P0,P1) do{ const float rm=rowmax(P0,P1); resc=false; \
    { const float dl=rm; mhat=fadd_s(mhat,dl); \
      _Pragma("unroll") for(int r=0;r<16;++r){P0[r]=fsub_s(P0[r],dl);P1[r]=fsub_s(P1[r],dl);} \
      _Pragma("unroll") for(int r=0;r<16;++r)negm[r]=-mhat; asm volatile("":"+v"(negm)); } \
    _Pragma("unroll") for(int r=0;r<16;++r)P0[r]=MSKB(__builtin_amdgcn_exp2f(P0[r]),mw0,MBIT(r)); }while(0)
  #define RESC() do{ if(resc){ asm volatile("s_waitcnt lgkmcnt(0)":::"memory"); \
      _Pragma("unroll") for(int d_=0;d_<2;++d_) _Pragma("unroll") for(int r=0;r<16;++r)o[d_][r]*=wsf[crow(r,hi)]; } }while(0)
  f32x16 pA0,pA1,pB0,pB1;
  int sl_prev=0,sl_cur=0,sl_next=SLOTB;
  #define ROT() do{sl_prev=sl_cur;sl_cur=sl_next;sl_next=(sl_next==(NSLOT-1)*SLOTB)?0:sl_next+SLOTB;}while(0)
  DMA_K(2,2*SLOTB);
  WAIT_BAR(3);
  qkt(pA0,pA1,Kbase,qr,negm,r32,hi);asm volatile("s_nop 15\n\ts_nop 7":"+v"(pA0),"+v"(pA1));CMASK(pA0,pA1,0);
  START(pA0,pA1);
  _Pragma("unroll") for(int r=0;r<16;++r)pA1[r]=MSKB(__builtin_amdgcn_exp2f(pA1[r]),mw1,MBIT(r));
  WAIT_BAR(0);
  DMA_K(3,0);DMA_V(1,SLOTB);
  ROT();
  kload8(kf,kp0+sl_cur);
  WAIT_BAR(2);
  s16x4 vlo[8],vhi[8]; u32x4 pw0,pw1,pw2,pw3;
  #define PKW(P,B) cvtpk_s(P[B],P[B+1])
  #define PAF(k) __builtin_bit_cast(bf16x8,pw##k)
  #define VFR(i) (bf16x8){vlo[i][0],vlo[i][1],vlo[i][2],vlo[i][3],vhi[i][0],vhi[i][1],vhi[i][2],vhi[i][3]}
  #define PIN(x) asm volatile("":"+v"(x))
  #define MX3(a,b,c) __builtin_fmaxf(__builtin_fmaxf((a),(b)),(c))
  #define GAPA(MF,A0,A1,A2,A3,W0,W1,PW) do{ MF; sacc+=A0; sacc+=A1; sacc+=A2; sacc+=A3; PIN(sacc); W0; W1; PIN(PW); SBAR(); }while(0)
  #define EX(v) __builtin_amdgcn_exp2f(v)
  #define GAPB(MF,X,B,MW) do{ MF; X[B]=MSKB(EX(X[B]),MW,2*(B)); X[B+1]=MSKB(EX(X[B+1]),MW,2*(B)+1); X[B+2]=MSKB(EX(X[B+2]),MW,2*(B)+2); X[B+3]=MSKB(EX(X[B+3]),MW,2*(B)+3); PIN(X); SBAR(); }while(0)
  #define VRD(i) do{ vlo[i]=vtr(vp_+(((i)>>2)*4096+((i)&3)*1024)); vhi[i]=vtr(vp_+(((i)>>2)*4096+((i)&3)*1024+512)); }while(0)
  #define KRD(G,j) do{ if(G){ kload2(kf,kp0+sl_next,j); SBAR(); } }while(0)
  #define STEP(C0,C1,P0,P1,t,GK,GV,GL,ML) do{ SBAR(); if(ML){mraw=mrow[(t)+1];} \
    const lds_cptr vp_=vp0+sl_prev; \
    VRD(0); SBAR(); float sacc=(P0[0]+P0[1]); \
    GAPA(C0=__builtin_amdgcn_mfma_f32_32x32x16_bf16(kf[0],qr[0],negm,0,0,0), P0[2],P0[3],P0[4],P0[5],     pw0[0]=PKW(P0,0), pw0[1]=PKW(P0,2), pw0); \
    VRD(4); SBAR(); GAPA(C1=__builtin_amdgcn_mfma_f32_32x32x16_bf16(kf[1],qr[0],negm,0,0,0), P0[6],P0[7],P0[8],P0[9],     pw0[2]=PKW(P0,4), pw0[3]=PKW(P0,6), pw0); \
    VRD(1); SBAR(); GAPA(C0=__builtin_amdgcn_mfma_f32_32x32x16_bf16(kf[2],qr[1],C0,0,0,0),   P0[10],P0[11],P0[12],P0[13], pw1[0]=PKW(P0,8), pw1[1]=PKW(P0,10), pw1); \
    VRD(5); SBAR(); GAPA(C1=__builtin_amdgcn_mfma_f32_32x32x16_bf16(kf[3],qr[1],C1,0,0,0),   P0[14],P0[15],P1[0],P1[1],   pw1[2]=PKW(P0,12),pw1[3]=PKW(P0,14), pw1); \
    VRD(2); SBAR(); GAPA(C0=__builtin_amdgcn_mfma_f32_32x32x16_bf16(kf[4],qr[2],C0,0,0,0),   P1[2],P1[3],P1[4],P1[5],     pw2[0]=PKW(P1,0), pw2[1]=PKW(P1,2), pw2); \
    VRD(6); SBAR(); GAPA(C1=__builtin_amdgcn_mfma_f32_32x32x16_bf16(kf[5],qr[2],C1,0,0,0),   P1[6],P1[7],P1[8],P1[9],     pw2[2]=PKW(P1,4), pw2[3]=PKW(P1,6), pw2); \
    VRD(3); SBAR(); GAPA(C0=__builtin_amdgcn_mfma_f32_32x32x16_bf16(kf[6],qr[3],C0,0,0,0),   P1[10],P1[11],P1[12],P1[13], pw3[0]=PKW(P1,8), pw3[1]=PKW(P1,10), pw3); \
    VRD(7); SBAR(); GAPA(C1=__builtin_amdgcn_mfma_f32_32x32x16_bf16(kf[7],qr[3],C1,0,0,0),   P1[14],P1[15],0.f,0.f,       pw3[2]=PKW(P1,12),pw3[3]=PKW(P1,14), pw3); \
    l_reg+=sacc; \
    if(ML){ mwn0=mraw.x>>sh4; mwn1=mraw.y>>sh4; PIN(mwn0); PIN(mwn1); } \
    if(GK){DMA_K((t)+3,sl_cur);} if(GV){DMA_V((t)+1,sl_next);} \
    CMASK(C0,C1,t); \
    { float a=MX3(C0[0],C0[1],C1[0]),b=MX3(C0[2],C0[3],C1[1]); a=MX3(a,C1[2],C1[3]); \
      _Pragma("unroll") for(int r=4;r<16;r+=4){a=MX3(a,C0[r],C0[r+1]);b=MX3(b,C0[r+2],C0[r+3]);a=MX3(a,C1[r],C1[r+1]);b=MX3(b,C1[r+2],C1[r+3]);} \
      float rm=__builtin_fmaxf(a,b); { auto rr=__builtin_amdgcn_permlane32_swap(__float_as_uint(rm),__float_as_uint(rm),false,false); rm=__builtin_fmaxf(__uint_as_float(rr[0]),__uint_as_float(rr[1])); } \
      resc=false; \
      if(__builtin_expect(__any(rm>(float)THRL),0)){ const float dl=__builtin_fmaxf(rm,0.f); mhat+=dl; \
        _Pragma("unroll") for(int r=0;r<16;++r){C0[r]-=dl;C1[r]-=dl;} \
        _Pragma("unroll") for(int r=0;r<16;++r)negm[r]=-mhat; asm volatile("":"+v"(negm)); \
        const float f=__builtin_amdgcn_exp2f(-dl); l_reg*=f; if(hi==0)wsf[r32]=f; resc=true; } } \
    SBAR(); \
    GAPB(o[0]=__builtin_amdgcn_mfma_f32_32x32x16_bf16(PAF(0),VFR(0),o[0],0,0,0), C0,0,mwc0); \
    GAPB(o[1]=__builtin_amdgcn_mfma_f32_32x32x16_bf16(PAF(0),VFR(4),o[1],0,0,0), C0,4,mwc0); \
    KRD(GL,0); GAPB(o[0]=__builtin_amdgcn_mfma_f32_32x32x16_bf16(PAF(1),VFR(1),o[0],0,0,0), C0,8,mwc0); \
    KRD(GL,1); GAPB(o[1]=__builtin_amdgcn_mfma_f32_32x32x16_bf16(PAF(1),VFR(5),o[1],0,0,0), C0,12,mwc0); \
    KRD(GL,2); GAPB(o[0]=__builtin_amdgcn_mfma_f32_32x32x16_bf16(PAF(2),VFR(2),o[0],0,0,0), C1,0,mwc1); \
    KRD(GL,3); GAPB(o[1]=__builtin_amdgcn_mfma_f32_32x32x16_bf16(PAF(2),VFR(6),o[1],0,0,0), C1,4,mwc1); \
    GAPB(o[0]=__builtin_amdgcn_mfma_f32_32x32x16_bf16(PAF(3),VFR(3),o[0],0,0,0), C1,8,mwc1); \
    GAPB(o[1]=__builtin_amdgcn_mfma_f32_32x32x16_bf16(PAF(3),VFR(7),o[1],0,0,0), C1,12,mwc1); \
    mwc0=mwn0; mwc1=mwn1; \
    }while(0)
  int t=1;
  #undef CMASK
  #define CMASK(P0,P1,t) do{}while(0)
  for(;t+5<NT;t+=2){
    STEP(pB0,pB1,pA0,pA1,t,true,true,true,true);     WAIT_BAR(2); RESC(); ROT();
    STEP(pA0,pA1,pB0,pB1,t+1,true,true,true,true);   WAIT_BAR(2); RESC(); ROT();
  }
  #undef CMASK
  #define CMASK(P0,P1,t) do{}while(0)
  #define ENDW(tt) do{ if((tt)+3<NT){WAIT_BAR(2);} else if((tt)+2<NT){WAIT_BAR(1);} else {WAIT_BAR(0);} }while(0)
  for(;t+1<NT;t+=2){
    STEP(pB0,pB1,pA0,pA1,t,(t+3<NT),(t+1<NT),(t+1<NT),(t+1<NT));       ENDW(t);   RESC(); ROT();
    STEP(pA0,pA1,pB0,pB1,t+1,(t+4<NT),(t+2<NT),(t+2<NT),(t+2<NT));     ENDW(t+1); RESC(); ROT();
  }
  STEP(pB0,pB1,pA0,pA1,NT-1,false,false,false,false); RESC();
  { float sacc=pB0[0]+pB0[1]; _Pragma("unroll") for(int r=2;r<16;++r)sacc+=pB0[r]; _Pragma("unroll") for(int r=0;r<16;++r)sacc+=pB1[r]; l_reg+=sacc;
    pw0=(u32x4){PKW(pB0,0),PKW(pB0,2),PKW(pB0,4),PKW(pB0,6)};pw1=(u32x4){PKW(pB0,8),PKW(pB0,10),PKW(pB0,12),PKW(pB0,14)};pw2=(u32x4){PKW(pB1,0),PKW(pB1,2),PKW(pB1,4),PKW(pB1,6)};pw3=(u32x4){PKW(pB1,8),PKW(pB1,10),PKW(pB1,12),PKW(pB1,14)};
    SBAR(); pv(o,vb0+sl_cur,PAF(0),PAF(1),PAF(2),PAF(3)); }
  #undef PKW
  #undef PAF
  #undef VFR
  #undef PIN
  #undef MX3
  #undef GAPA
  #undef GAPB
  #undef EX
  #undef VRD
  #undef KRD
  #undef STEP
  #undef ENDW
  {auto rr=__builtin_amdgcn_permlane32_swap(__float_as_uint(l_reg),__float_as_uint(l_reg),false,false);l_reg=__uint_as_float(rr[0])+__uint_as_float(rr[1]);}
  if(hi==0)wsf[32+r32]=l_reg;asm volatile("s_waitcnt lgkmcnt(0)":::"memory");
  float rli[16];
  #pragma unroll
  for(int r=0;r<16;++r)rli[r]=__builtin_amdgcn_rcpf(wsf[32+crow(r,hi)]);
  bf16*Ow=O+(rowbase+q0+wid*QBLK)*DM+h*D;
  { bf16*stg=(bf16*)(shm+LDS_OST)+wid*2048;
    #pragma unroll
    for(int r=0;r<16;++r){const int orow=crow(r,hi);
      #pragma unroll
      for(int d0=0;d0<2;++d0)stg[orow*64+d0*32+r32]=__float2bfloat16(o[d0][r]*rli[r]);}
    asm volatile("s_waitcnt lgkmcnt(0)":::"memory");
    #pragma unroll
    for(int i=0;i<4;++i){const int row=i*8+(lane>>3),ch=lane&7; const u32x4 v=*(const u32x4*)(stg+row*64+ch*8); ATTN_STORE16(Ow+(long)row*DM+ch*8,v);} }
  asm volatile("s_waitcnt lgkmcnt(0)\n\ts_barrier":::"memory");
  #undef DMA_K
  #undef DMA_V
  #undef CMASK
  #undef MSKB
  #undef MBIT
  #undef START
  #undef RESC
  #undef ROT
}
constexpr int ATTN_LDS_BYTES=LDS_BYTES;
struct AttnTensors { const bf16* Q; const bf16* K; const bf16* V; bf16* O; const uint2* Mask; };
struct AttnUnit { int bh; int qb; };
struct StaticOrder {
  int vcu;
  __device__ __forceinline__ explicit StaticOrder(int grid,int block):vcu((block%8)*(grid/8)+block/8){}
  __device__ __forceinline__ bool next(int i,AttnUnit&u)const{ if(i>=4)return false; const int s=vcu&3; u.bh=vcu>>2; u.qb=(i==0)?s:(i==1)?7-s:(i==2)?8+s:15-s; return true; }
  __device__ __forceinline__ void a_ready(const AttnUnit&)const{}
  __device__ __forceinline__ void done(const AttnUnit&)const{}
};
template<class Sched,int THRL=8> __device__ __forceinline__ void attn_phase(char*lds,const AttnTensors&T,const Sched&S){
  AttnUnit u;
  for(int i=0;S.next(i,u);++i){ S.a_ready(u); attn_unit<THRL>(u.bh/NHEAD,u.bh%NHEAD,u.qb,T.Q,T.K,T.V,T.O,T.Mask,lds); S.done(u); }
}
#undef SBAR
#undef WAIT_BAR
}
#define GAS __attribute__((address_space(1)))
#define LAS __attribute__((address_space(3)))
typedef unsigned short bf16;
typedef unsigned v4u __attribute__((ext_vector_type(4)));
typedef float f32x4 __attribute__((ext_vector_type(4)));
typedef short bf16x8 __attribute__((ext_vector_type(8)));
typedef GAS unsigned gu32;
typedef GAS unsigned long long gu64;
#define RLX_AGENT __ATOMIC_RELAXED, __HIP_MEMORY_SCOPE_AGENT
#define LDS_WAIT() asm volatile("s_waitcnt lgkmcnt(0)" ::: "memory")
#define VM_WAIT() asm volatile("s_waitcnt vmcnt(0)" ::: "memory")
__device__ __forceinline__ unsigned long long rt() { return __builtin_amdgcn_s_memrealtime(); }
__device__ __forceinline__ unsigned f2bf(float f) { unsigned u = __builtin_bit_cast(unsigned, f); return (u + 0x7fffu + ((u >> 16) & 1u)) >> 16; }
__device__ __forceinline__ unsigned pk2(float lo, float hi) { return f2bf(lo) | (f2bf(hi) << 16); }

#define XB_TMO      128
#define XB_XCNT(j)  (256  + 64 * (j))
#define XB_XSUB(j)  (1280 + 64 * (j))
#define XB_XGEN(j)  (2304 + 64 * (j))
#define XB_TOP      3328
#define XB_TOPGEN   3392
#define XCD_BAR_WORDS 3456
#define XB_SPIN_CAP (1u << 18)

__device__ __forceinline__ unsigned xb_ld(unsigned* p)              { return __hip_atomic_load(p, __ATOMIC_RELAXED, __HIP_MEMORY_SCOPE_AGENT); }
__device__ __forceinline__ unsigned xb_add(unsigned* p, unsigned v) { return __hip_atomic_fetch_add(p, v, __ATOMIC_RELAXED, __HIP_MEMORY_SCOPE_AGENT); }
__device__ __forceinline__ unsigned xb_xcc_id() { return (unsigned)__builtin_amdgcn_s_getreg((3 << 11) | 20) & 0xFu; }
#define XB_SPIN(cond, bar) do { unsigned _sp = 0; while (cond) { __builtin_amdgcn_s_sleep(1); \
    if ((++_sp & 255u) == 0u) { if (xb_ld(&(bar)[XB_TMO])) break; if (_sp > XB_SPIN_CAP) { atomicAdd(&(bar)[XB_TMO], 1u); break; } } } } while (0)

struct XcdBarrier {
    unsigned* bar; unsigned x;
    volatile LAS unsigned* st;
};

__device__ __forceinline__ XcdBarrier xcd_barrier_post(unsigned* bar, volatile LAS unsigned* st) {
    XcdBarrier b; b.bar = bar; b.x = xb_xcc_id(); b.st = st;
    if (threadIdx.x == 0) (void)xb_add(&bar[XB_XCNT(b.x)], 1u);
    return b;
}
__device__ __forceinline__ void xcd_barrier_complete(unsigned* bar, unsigned x, unsigned& nloc, unsigned& nx) {
    const unsigned G = gridDim.x * gridDim.y * gridDim.z;
    unsigned sum, cnt, mine, sp = 0u;
    for (;;) {
        sum = 0u; cnt = 0u; mine = 0u;
#pragma unroll
        for (unsigned j = 0; j < 16; ++j) { const unsigned c = xb_ld(&bar[XB_XCNT(j)]); sum += c; cnt += (c > 0u) ? 1u : 0u; mine = (j == x) ? c : mine; }
        if (sum == G) break;
        __builtin_amdgcn_s_sleep(1);
        if ((++sp & 255u) == 0u) { if (xb_ld(&bar[XB_TMO])) break; if (sp > XB_SPIN_CAP) { atomicAdd(&bar[XB_TMO], 1u); break; } }
    }
    nloc = mine > 0u ? mine : 1u; nx = cnt > 0u ? cnt : 1u;
}

__device__ __forceinline__ void xcd_barrier(const XcdBarrier& b) {
    asm volatile("s_waitcnt vmcnt(0)" ::: "memory");
    __syncthreads();
    if (threadIdx.x == 0) {
        unsigned* bar = b.bar;
        __builtin_amdgcn_s_waitcnt(0);
        unsigned nloc = b.st[0], nx = b.st[1];
        if (nloc == 0u) { xcd_barrier_complete(bar, b.x, nloc, nx); b.st[0] = nloc; b.st[1] = nx; }
        const unsigned old = xb_add(&bar[XB_XSUB(b.x)], 1u);
        const unsigned gen = old / nloc;
        if (old + 1u == (gen + 1u) * nloc) {
            __builtin_amdgcn_fence(__ATOMIC_RELEASE, "agent");
            asm volatile("s_waitcnt vmcnt(0)" ::: "memory");
            const unsigned og = xb_add(&bar[XB_TOP], 1u);
            const unsigned tg = og / nx;
            if (og + 1u == (tg + 1u) * nx) xb_add(&bar[XB_TOPGEN], 1u);
            else XB_SPIN(xb_ld(&bar[XB_TOPGEN]) == tg, bar);
            __builtin_amdgcn_fence(__ATOMIC_ACQUIRE, "agent");
            xb_add(&bar[XB_XGEN(b.x)], 1u);
            asm volatile("s_waitcnt vmcnt(0)" ::: "memory");
        } else {
            XB_SPIN(xb_ld(&bar[XB_XGEN(b.x)]) == gen, bar);
            __builtin_amdgcn_fence(__ATOMIC_ACQUIRE, "agent");
            asm volatile("s_waitcnt vmcnt(0)" ::: "memory");
        }
    }
    __syncthreads();
}

constexpr int NWAVES = 8;
constexpr int T = 32768, DM = 1024, SEQ = 4096, NBATCH = 8, NMEM = 256;
constexpr float EPS = 1e-6f;
constexpr int IN_W = 5192;
constexpr int NCLS = 112;
constexpr size_t MiB = 1u << 20;
constexpr size_t WS_CTL = 0, CTL_ZERO_BYTES = 1 * MiB;
constexpr size_t WS_RSTD0 = 1 * MiB, WS_RSTDM = WS_RSTD0 + 131072, WS_TOKC = WS_RSTD0 + 262144;
constexpr size_t WS_ROPE = 3 * MiB;
constexpr size_t WS_W = 11 * MiB;
constexpr size_t W_R = WS_W, W_V = W_R + 3 * MiB, W_G = W_V + 1 * MiB, W_X = W_G + 2 * MiB, W_GT = W_X + MiB / 2, W_OA = W_GT + 4 * MiB, W_CO = W_OA + 1 * MiB,
                 W_OUT = W_CO + 1 * MiB, W_QX = W_OUT + 2 * MiB, W_KVX = W_QX + 2 * MiB, W_OX = W_KVX + 4 * MiB, W_RT = W_OX + 2 * MiB, W_E1 = W_RT + MiB / 2, W_E2 = W_E1 + 32 * MiB, W_END = W_E2 + 16 * MiB;
static_assert(W_END == 82 * MiB, "weights map");
constexpr size_t WS_XB = 82 * MiB;
constexpr size_t WS_Q = 146 * MiB, WS_CA = 178 * MiB;
constexpr size_t WS_K = 210 * MiB, WS_V = 242 * MiB, WS_QI = 274 * MiB, WS_U = 306 * MiB;
constexpr size_t WS_KI = 338 * MiB, WS_WI = 342 * MiB, WS_MASK = 343 * MiB, WS_KX = 359 * MiB, WS_VT = 363 * MiB, WS_MEMB = 367 * MiB, WS_LIST = 371 * MiB, WS_END = 385 * MiB;
constexpr int CW_TMO = 0, CW_CODE = 1, CW_BAR = 4096, CW_ROWSQ1 = 32768, CW_ROWSQ2 = 65536, CW_CNT = 98304;
static_assert((CW_CNT + 64 * NCLS) * 4 <= (int)CTL_ZERO_BYTES, "CTL words inside the memset region");
constexpr int SCR_BYTES = 135168;
constexpr int LDSCTL_OFF = SCR_BYTES, MISC_OFF = LDSCTL_OFF + 320, LDS_BYTES = SCR_BYTES + 4096;


struct Frame {
    LAS unsigned char* lds;
    volatile LAS unsigned* MISC;
    gu32* ctl;
    unsigned char* ws;
    int tid, lane, wave, vcu, G;
    const float* const* in;
    float* out;
};
template <class TT> __device__ __forceinline__ TT* wsp(const Frame& F, size_t off) { return (TT*)(F.ws + off); }
__device__ __forceinline__ float wave_sum(float v) {
#pragma unroll
    for (int o = 1; o < 64; o <<= 1) v += __shfl_xor(v, o);
    return v;
}
__device__ __forceinline__ float bf2f(unsigned short h) { return __builtin_bit_cast(float, (unsigned)h << 16); }

template <class DstFn>
__device__ __forceinline__ void p0_item(const float* W, int N, int n0, int k0, const float* gain, float scale, DstFn dst, LAS float* scr, int lane) {
#pragma unroll 8
    for (int i = 0; i < 32; ++i) { const int kk = 2 * i + (lane >> 5); const float g = gain ? gain[k0 + kk] * scale : scale;
        scr[kk * 33 + (lane & 31)] = W[(size_t)(k0 + kk) * N + n0 + (lane & 31)] * g; }
    LDS_WAIT(); asm volatile("" ::: "memory");
    const int c = lane & 7;
#pragma unroll
    for (int j = 0; j < 4; ++j) { const int n = (lane >> 3) + 8 * j; const LAS float* s = scr + (8 * c) * 33 + n;
        v4u o; o.x = pk2(s[0 * 33], s[1 * 33]); o.y = pk2(s[2 * 33], s[3 * 33]); o.z = pk2(s[4 * 33], s[5 * 33]); o.w = pk2(s[6 * 33], s[7 * 33]);
        *(GAS v4u*)dst(n, c) = o; }
    LDS_WAIT(); asm volatile("" ::: "memory");
}
#define P0_PLAIN(Wsrc, Nsrc, n0src, Kdim, gainp, scl, WT, row0) do { const int k0_ = 64 * kb; bf16* wt_ = (WT); const int r0_ = (row0); const int Kd_ = (Kdim); \
    p0_item((Wsrc), (Nsrc), (n0src), k0_, (gainp), (scl), [=](int n, int c) { return wt_ + (size_t)(r0_ + n) * Kd_ + k0_ + 8 * c; }, scr, F.lane); } while (0)

__device__ __forceinline__ void p0_prologue(Frame& F) {
    LAS float* scr = (LAS float*)(F.lds + F.wave * 16384);
    const int gw = F.vcu * NWAVES + F.wave, NGW = F.G * NWAVES;
    const float* w_in = F.in[4]; const float* g_mix = F.in[3];
    constexpr int I_QKQ = 16 * 16, I_V = 16 * 16, I_GLU = 16 * 32, I_X = 16 * 3, I_GT = 16 * 64, I_OA = 8 * 32, I_CO = 8 * 32, I_OUT = 16 * 32, I_QX = 16 * 32, I_KVX = 16 * 64, I_OX = 16 * 32,
                  I_EG = 32 * 16 * 8, I_EU = I_EG, I_ED = 32 * 4 * 32;
    constexpr int NITEMS = 3 * I_QKQ + I_V + I_GLU + I_X + I_GT + I_OA + I_CO + I_OUT + I_QX + I_KVX + I_OX + I_EG + I_EU + I_ED;
    constexpr float C2 = 0.125f * 1.4426950408889634f;
    constexpr float CX = 0.0625f * 1.4426950408889634f;
    for (int it = gw; it < NITEMS; it += NGW) {
        int r = it;
        if (r < 3 * I_QKQ) {
            const int t = r / I_QKQ; r -= t * I_QKQ; const int kb = r / 16, nb = r % 16, H = nb >> 1, s = nb & 1;
            const int srcc = (t == 0 ? 0 : (t == 1 ? 512 : 1536)) + nb * 32;
            P0_PLAIN(w_in, IN_W, srcc, 1024, g_mix, (t == 0 ? C2 : 1.0f), wsp<bf16>(F, W_R), t * 512 + 256 * (H >> 2) + 128 * s + 32 * (H & 3)); continue; }
        r -= 3 * I_QKQ;
        if (r < I_V) { const int kb = r / 16, nb = r % 16; P0_PLAIN(w_in, IN_W, 1024 + nb * 32, 1024, g_mix, 1.0f, wsp<bf16>(F, W_V), nb * 32); continue; }
        r -= I_V;
        if (r < I_GLU) { const int kb = r / 32, nb = r % 32, half = nb >> 4, cb = nb & 15;
            P0_PLAIN(w_in, IN_W, 2120 + nb * 32, 1024, g_mix, 1.0f, wsp<bf16>(F, W_G), 256 * (cb >> 2) + 128 * half + 32 * (cb & 3)); continue; }
        r -= I_GLU;
        if (r < I_X) { const int kb = r / 3, nb = r % 3;
            P0_PLAIN(w_in, IN_W, (nb == 0 ? 2048 : (nb == 1 ? 2080 : 2112)), 1024, g_mix, 1.0f, wsp<bf16>(F, W_X), (nb == 0 ? 0 : (nb == 1 ? 128 : 32))); continue; }
        r -= I_X;
        if (r < I_GT) { const int kb = r / 64, nb = r % 64, br = nb >> 5, cb = nb & 31;
            P0_PLAIN(w_in, IN_W, 3144 + nb * 32, 1024, g_mix, 1.0f, wsp<bf16>(F, W_GT), 256 * (cb >> 2) + 128 * br + 32 * (cb & 3)); continue; }
        r -= I_GT;
        if (r < I_OA) { const int kb = r / 32, nb = r % 32; P0_PLAIN(F.in[5], 1024, nb * 32, 512, (const float*)nullptr, 1.0f, wsp<bf16>(F, W_OA), nb * 32); continue; }
        r -= I_OA;
        if (r < I_CO) { const int kb = r / 32, nb = r % 32; P0_PLAIN(F.in[10], 1024, nb * 32, 512, (const float*)nullptr, 1.0f, wsp<bf16>(F, W_CO), nb * 32); continue; }
        r -= I_CO;
        if (r < I_OUT) { const int kb = r / 32, nb = r % 32; P0_PLAIN(F.in[11], 1024, nb * 32, 1024, (const float*)nullptr, 1.0f, wsp<bf16>(F, W_OUT), nb * 32); continue; }
        r -= I_OUT;
        if (r < I_QX) { const int kb = r / 32, nb = r % 32; P0_PLAIN(F.in[14], 1024, nb * 32, 1024, F.in[12], CX, wsp<bf16>(F, W_QX), nb * 32); continue; }
        r -= I_QX;
        if (r < I_KVX) { const int kb = r / 64, nb = r % 64; P0_PLAIN(F.in[15], 2048, nb * 32, 1024, F.in[13], 1.0f, wsp<bf16>(F, W_KVX), nb * 32); continue; }
        r -= I_KVX;
        if (r < I_OX) { const int kb = r / 32, nb = r % 32; P0_PLAIN(F.in[16], 1024, nb * 32, 1024, (const float*)nullptr, 1.0f, wsp<bf16>(F, W_OX), nb * 32); continue; }
        r -= I_OX;
        if (r < I_EG + I_EU) {
            const int ct = r / I_EG; r -= ct * I_EG; const int e = r / 128; r -= e * 128; const int kb = r / 8, nb = r % 8;
            const float* Wsrc = (ct == 0 ? F.in[22] : F.in[23]) + (size_t)e * 1024 * 256; bf16* base = wsp<bf16>(F, W_E1);
            p0_item(Wsrc, 256, nb * 32, 64 * kb, F.in[17], 1.0f, [=](int n, int c) { const int ks = 4 * kb + (c >> 1), hl = c & 1;
                return base + ((((size_t)(e * 8 + nb) * 64 + ks) * 2 + ct) * 64 + hl * 32 + n) * 8; }, scr, F.lane);
            continue; }
        r -= I_EG + I_EU;
        {
            const int e = r / 128; r -= e * 128; const int kb = r / 32, nb = r % 32, w = nb >> 2, ct = nb & 3;
            const float* Wsrc = F.in[24] + (size_t)e * 256 * 1024; bf16* base = wsp<bf16>(F, W_E2);
            p0_item(Wsrc, 1024, nb * 32, 64 * kb, (const float*)nullptr, 1.0f, [=](int n, int c) { const int ks = 4 * kb + (c >> 1), hl = c & 1;
                return base + ((((size_t)(e * 8 + w) * 16 + ks) * 4 + ct) * 64 + hl * 32 + n) * 8; }, scr, F.lane);
        }
    }
    { const float* wrg = F.in[18]; const float* wre = F.in[20]; const float* gm = F.in[17]; bf16* rt_ = wsp<bf16>(F, W_RT);
      for (int i = (F.vcu * NWAVES + F.wave) * 64 + F.lane; i < 36 * 1024; i += NGW * 64) { const int c = i >> 10, k = i & 1023;
          const float v = (c < 4 ? wrg[k * 4 + c] : wre[((size_t)((c - 4) >> 3) * 1024 + k) * 8 + ((c - 4) & 7)]) * gm[k]; rt_[(size_t)c * 1024 + k] = (bf16)f2bf(v); } }
    { const float* x = F.in[0]; bf16* xb = wsp<bf16>(F, WS_XB); float* rstd0 = wsp<float>(F, WS_RSTD0);
      for (int m = gw; m < T + NBATCH * NMEM; m += NGW) {
          const bool ismem = m >= T; const int mm = ismem ? m - T : m;
          const GAS f32x4* xr = (const GAS f32x4*)((ismem ? F.in[1] : x) + (size_t)mm * DM) + F.lane;
          f32x4 v[4]; float s = 0.f;
#pragma unroll
          for (int j = 0; j < 4; ++j) { v[j] = xr[64 * j]; s += (v[j].x * v[j].x + v[j].y * v[j].y) + (v[j].z * v[j].z + v[j].w * v[j].w); }
          const float rs = 1.0f / sqrtf(wave_sum(s) * (1.0f / DM) + EPS);
          GAS unsigned long long* o8 = (GAS unsigned long long*)((ismem ? wsp<bf16>(F, WS_MEMB) : xb) + (size_t)mm * DM) + F.lane;
#pragma unroll
          for (int j = 0; j < 4; ++j) o8[64 * j] = (unsigned long long)pk2(v[j].x, v[j].y) | ((unsigned long long)pk2(v[j].z, v[j].w) << 32);
          if (F.lane == 0) { if (ismem) wsp<float>(F, WS_RSTDM)[mm] = rs; else rstd0[mm] = rs; }
      } }
    { const int* pos = (const int*)F.in[2]; float* rope = wsp<float>(F, WS_ROPE);
      for (int i = (F.vcu * NWAVES + F.wave) * 64 + F.lane; i < T * 32; i += NGW * 64) { const int tok = i >> 5, fi = i & 31;
          double inv = 1.0; const double rr = 0.74989420933245582730;
          for (int q = 0; q < fi; ++q) inv *= rr;
          const float ang = (float)pos[tok] * (float)inv;
          const double a = (double)ang; const double kq = __builtin_rint(a * 0.63661977236758134308);
          const double rd = (a - kq * 1.57079632679489655800) - kq * 6.12323399573676603587e-17;
          const double r2 = rd * rd;
          double sn = rd * (1.0 + r2 * (-1.0 / 6 + r2 * (1.0 / 120 + r2 * (-1.0 / 5040 + r2 * (1.0 / 362880 + r2 * (-1.0 / 39916800 + r2 * (1.0 / 6227020800.0 + r2 * (-1.0 / 1307674368000.0))))))));
          double cs = 1.0 + r2 * (-0.5 + r2 * (1.0 / 24 + r2 * (-1.0 / 720 + r2 * (1.0 / 40320 + r2 * (-1.0 / 3628800 + r2 * (1.0 / 479001600.0 + r2 * (-1.0 / 87178291200.0 + r2 * (1.0 / 20922789888000.0))))))));
          const int qd = ((int)kq) & 3; double c_, s_;
          if (qd == 0) { c_ = cs; s_ = sn; } else if (qd == 1) { c_ = -sn; s_ = cs; } else if (qd == 2) { c_ = -cs; s_ = -sn; } else { c_ = sn; s_ = -cs; }
          rope[(size_t)tok * 64 + fi] = (float)c_; rope[(size_t)tok * 64 + 32 + fi] = (float)s_; } }
}

typedef float f32x16 __attribute__((ext_vector_type(16)));
__device__ __forceinline__ f32x16 mfma32(bf16x8 a, bf16x8 b, f32x16 c) { return __builtin_amdgcn_mfma_f32_32x32x16_bf16(a, b, c, 0, 0, 0); }
__device__ __forceinline__ f32x4 mfma16(bf16x8 a, bf16x8 b, f32x4 c) { return __builtin_amdgcn_mfma_f32_16x16x32_bf16(a, b, c, 0, 0, 0); }
__device__ __forceinline__ int crow32(int r, int hi) { return (r & 3) + 8 * (r >> 2) + 4 * hi; }
#define WG_SYNC() do { asm volatile("s_waitcnt vmcnt(0) lgkmcnt(0)" ::: "memory"); __builtin_amdgcn_s_barrier(); asm volatile("" ::: "memory"); } while (0)

__device__ __forceinline__ void conv_phase(Frame& F) {
    const bf16* U = wsp<bf16>(F, WS_U); bf16* CA = wsp<bf16>(F, WS_CA);
    const float* cw = F.in[6]; const float* cb = F.in[7]; const float* lg = F.in[8]; const float* lb = F.in[9];
    LAS unsigned short* ut = (LAS unsigned short*)F.lds;
    LAS float* yy = (LAS float*)(F.lds + 63488);
    const int c = F.tid;
    float w[31];
#pragma unroll
    for (int j = 0; j < 31; ++j) w[j] = cw[j * 512 + c];
    const float bias = cb[c];
    for (int unit = F.vcu; unit < T / 32; unit += F.G) {
        const int tok0 = unit * 32, s0 = tok0 & (SEQ - 1);
        for (int ch = F.tid; ch < 62 * 64; ch += NWAVES * 64) { const int r = ch >> 6, cc = ch & 63; const int s = s0 - 30 + r;
            v4u v = (v4u){0u, 0u, 0u, 0u};
            if (s >= 0) v = *(const GAS v4u*)(U + (size_t)(tok0 - 30 + r) * 512 + cc * 8);
            *(LAS v4u*)(ut + r * 512 + cc * 8) = v; }
        WG_SYNC();
#pragma unroll 1
        for (int t = 0; t < 32; ++t) { float a = bias;
#pragma unroll
            for (int j = 0; j < 31; ++j) a += w[j] * bf2f(ut[(t + j) * 512 + c]);
            yy[t * 512 + c] = a; }
        WG_SYNC();
        const f32x4 g0 = *(const f32x4*)(lg + 8 * F.lane), g1 = *(const f32x4*)(lg + 8 * F.lane + 4), b0 = *(const f32x4*)(lb + 8 * F.lane), b1 = *(const f32x4*)(lb + 8 * F.lane + 4);
#pragma unroll 1
        for (int q = 0; q < 4; ++q) { const int t = 4 * F.wave + q;
            f32x4 v0 = *(const LAS f32x4*)(yy + t * 512 + 8 * F.lane), v1 = *(const LAS f32x4*)(yy + t * 512 + 8 * F.lane + 4);
            const float mean = wave_sum((v0[0] + v0[1]) + (v0[2] + v0[3]) + (v1[0] + v1[1]) + (v1[2] + v1[3])) * (1.0f / 512.0f);
            v0 = v0 - mean; v1 = v1 - mean;
            const float var = wave_sum((v0[0] * v0[0] + v0[1] * v0[1]) + (v0[2] * v0[2] + v0[3] * v0[3]) + (v1[0] * v1[0] + v1[1] * v1[1]) + (v1[2] * v1[2] + v1[3] * v1[3])) * (1.0f / 512.0f);
            const float rs = 1.0f / sqrtf(var + EPS);
            v0 = v0 * rs * g0 + b0; v1 = v1 * rs * g1 + b1;
            v0 = v0 * pg8::sigmoid4(v0); v1 = v1 * pg8::sigmoid4(v1);
            *(GAS pg8::u32x4*)(CA + (size_t)(tok0 + t) * 512 + 8 * F.lane) = pg8::pack8(v0, v1); }
        WG_SYNC();
    }
}

__device__ __forceinline__ unsigned fkey(float f) { const unsigned u = __builtin_bit_cast(unsigned, f); return (u & 0x80000000u) ? ~u : (u | 0x80000000u); }
__device__ __forceinline__ void indexer_block(Frame& F, int b, int n) {
    const bf16* QI = wsp<bf16>(F, WS_QI); const bf16* KI = wsp<bf16>(F, WS_KI); const float* WI = wsp<float>(F, WS_WI);
    unsigned long long* MASK = wsp<unsigned long long>(F, WS_MASK);
    const int tb = b * SEQ + 64 * n, L = 64 * (n + 1), nw = n + 1, nwtot = 4 * ((n >> 2) + 1);
    const int lane = F.lane, wv = F.wave, c32 = lane & 31, hl = lane >> 5;
    if (n < 4) {
        for (int i = F.tid; i < 64 * 4; i += NWAVES * 64) { const int q = i >> 2, wd = i & 3; if (wd < nwtot) MASK[(size_t)(tb + q) * 64 + wd] = wd < nw ? ~0ull : 0ull; }
        return;
    }
    LAS float* S = (LAS float*)F.lds;
    for (int g = 0; g < 8; ++g) {
        bf16x8 qa[2][4]; float wq[2][16];
#pragma unroll
        for (int rt = 0; rt < 2; ++rt) {
            const int quad = c32 >> 2, qq = ((quad >> 2) << 1) | (quad & 1), head = ((quad >> 1) & 1) * 4 + (c32 & 3);
            const bf16* qp = QI + (size_t)(tb + 8 * g + 4 * rt + qq) * 512 + head * 64 + 8 * hl;
#pragma unroll
            for (int ks = 0; ks < 4; ++ks) qa[rt][ks] = *(const GAS bf16x8*)(qp + 16 * ks);
            const float* w0 = WI + (size_t)(tb + 8 * g + 4 * rt + hl) * 8; const float* w1 = w0 + 16;
#pragma unroll
            for (int h = 0; h < 8; ++h) { wq[rt][h] = w0[h]; wq[rt][8 + h] = w1[h]; }
        }
        for (int kt = wv; kt < L / 32; kt += NWAVES) {
            const bf16* kp = KI + (size_t)(b * SEQ + 32 * kt + c32) * 64 + 8 * hl;
            bf16x8 kb[4];
#pragma unroll
            for (int ks = 0; ks < 4; ++ks) kb[ks] = *(const GAS bf16x8*)(kp + 16 * ks);
#pragma unroll
            for (int rt = 0; rt < 2; ++rt) {
                f32x16 acc = {};
#pragma unroll
                for (int ks = 0; ks < 4; ++ks) acc = mfma32(qa[rt][ks], kb[ks], acc);
                float s0 = 0.f, s1 = 0.f;
#pragma unroll
                for (int h = 0; h < 8; ++h) { s0 += wq[rt][h] * fmaxf(acc[h], 0.f); s1 += wq[rt][8 + h] * fmaxf(acc[8 + h], 0.f); }
                S[(4 * rt + hl) * 4096 + 32 * kt + c32] = __builtin_bit_cast(float, fkey(s0));
                S[(4 * rt + 2 + hl) * 4096 + 32 * kt + c32] = __builtin_bit_cast(float, fkey(s1));
            }
        }
        WG_SYNC();
        {
            const LAS unsigned* row = (const LAS unsigned*)S + wv * 4096; const int nch = L / 64;
            unsigned tau = 0u; bool exact = false;
            for (int bit = 31; bit >= 0; --bit) { const unsigned cand = tau | (1u << bit); int cnt = 0;
                for (int c = 0; c < nch; ++c) cnt += __builtin_popcountll(__ballot(row[64 * c + lane] >= cand));
                if (cnt >= 256) { tau = cand; if (cnt == 256) { exact = true; break; } } }
            int rem = 0;
            if (!exact) { int cgt = 0; for (int c = 0; c < nch; ++c) cgt += __builtin_popcountll(__ballot(row[64 * c + lane] > tau)); rem = 256 - cgt; }
            unsigned long long* mrow = MASK + (size_t)(tb + 8 * g + wv) * 64;
            for (int c = 0; c < nch; ++c) { const unsigned k = row[64 * c + lane]; unsigned long long sel;
                if (exact) sel = __ballot(k >= tau);
                else { sel = __ballot(k > tau); unsigned long long eq = __ballot(k == tau);
                    while (eq != 0ull && rem > 0) { const unsigned long long low = eq & (0ull - eq); sel |= low; eq ^= low; --rem; } }
                if (lane == 0) mrow[c] = sel; }
            if (lane < nwtot - nw) mrow[nw + lane] = 0ull;
        }
        WG_SYNC();
    }
}
__device__ __forceinline__ void indexer_phase(Frame& F) {
    for (int u = F.vcu; u < NBATCH * 32; u += F.G) { const int b = u >> 5, j = u & 31; indexer_block(F, b, 63 - j); indexer_block(F, b, j); }
}

__device__ __forceinline__ void xattn_phase(Frame& F) {
    const bf16* QX = wsp<bf16>(F, WS_K); const bf16* KX = wsp<bf16>(F, WS_KX); const bf16* VT = wsp<bf16>(F, WS_VT); bf16* OX = wsp<bf16>(F, WS_QI);
    const int wv = F.wave;
    LAS unsigned char* Kt = F.lds; LAS unsigned char* Vt = F.lds + 32768; LAS float* wsf = (LAS float*)(F.lds + 65536) + wv * 64;
    for (int ui = 0; ui < 2; ++ui) {
        int lane; asm volatile("v_mbcnt_lo_u32_b32 %0, -1, 0\n\tv_mbcnt_hi_u32_b32 %0, -1, %0" : "=v"(lane)); const int tid = wv * 64 + lane, r32 = lane & 31, hi = lane >> 5;
        const int u = F.vcu * 2 + ui; if (u >= NBATCH * 4 * 16) break;
        const int bh = u >> 4, qb = u & 15, b = bh >> 2, h = bh & 3;
        const int tok = b * SEQ + qb * 256 + wv * 32 + r32;
        const bf16* qp = QX + (size_t)tok * 1024 + h * 256 + 8 * hi;
        f32x16 O[8];
#pragma unroll
        for (int i = 0; i < 8; ++i) O[i] = f32x16{};
        float mrun = -INFINITY, lrun = 0.f;
        for (int t = 0; t < 4; ++t) {
            WG_SYNC();
#pragma unroll
            for (int i = 0; i < 4; ++i) { const int ci = tid + 512 * i;
                { const int r = ci >> 5, c = ci & 31; const v4u v = *(const GAS v4u*)(KX + (size_t)(b * 256 + 64 * t + r) * 1024 + h * 256 + c * 8);
                  *(LAS v4u*)(Kt + r * 512 + ((c ^ (r & 15)) << 4)) = v; }
                { const int dv = ci >> 3, c = ci & 7; const v4u v = *(const GAS v4u*)(VT + ((size_t)(b * 4 + h) * 256 + dv) * 256 + 64 * t + c * 8);
                  *(LAS v4u*)(Vt + dv * 128 + ((c ^ (dv & 7)) << 4)) = v; } }
            WG_SYNC();
            f32x16 p0 = f32x16{}, p1 = f32x16{};
#pragma unroll 4
            for (int ks = 0; ks < 16; ++ks) { const bf16x8 qf = *(const GAS bf16x8*)(qp + 16 * ks);
                const int c = 2 * ks + hi;
                const bf16x8 k0 = *(const LAS bf16x8*)(Kt + r32 * 512 + ((c ^ (r32 & 15)) << 4));
                const bf16x8 k1 = *(const LAS bf16x8*)(Kt + (32 + r32) * 512 + ((c ^ (r32 & 15)) << 4));
                p0 = mfma32(k0, qf, p0); p1 = mfma32(k1, qf, p1); }
            float rm = p0[0];
#pragma unroll
            for (int r = 1; r < 16; ++r) rm = fmaxf(rm, p0[r]);
#pragma unroll
            for (int r = 0; r < 16; ++r) rm = fmaxf(rm, p1[r]);
            rm = fmaxf(rm, __shfl_xor(rm, 32));
            const float mnew = fmaxf(mrun, rm), alpha = __builtin_amdgcn_exp2f(mrun - mnew); mrun = mnew;
            float ps = 0.f;
#pragma unroll
            for (int r = 0; r < 16; ++r) { p0[r] = __builtin_amdgcn_exp2f(p0[r] - mnew); p1[r] = __builtin_amdgcn_exp2f(p1[r] - mnew); ps += p0[r] + p1[r]; }
            lrun = lrun * alpha + ps;
            if (hi == 0) wsf[r32] = alpha;
            asm volatile("s_waitcnt lgkmcnt(0)" ::: "memory");
#pragma unroll
            for (int r = 0; r < 16; ++r) { const float a = wsf[crow32(r, hi)];
#pragma unroll
                for (int i = 0; i < 8; ++i) O[i][r] *= a; }
            pg8::u32x4 pw[4];
            pw[0] = pg8::pack8((f32x4){p0[0], p0[1], p0[2], p0[3]}, (f32x4){p0[4], p0[5], p0[6], p0[7]});
            pw[1] = pg8::pack8((f32x4){p0[8], p0[9], p0[10], p0[11]}, (f32x4){p0[12], p0[13], p0[14], p0[15]});
            pw[2] = pg8::pack8((f32x4){p1[0], p1[1], p1[2], p1[3]}, (f32x4){p1[4], p1[5], p1[6], p1[7]});
            pw[3] = pg8::pack8((f32x4){p1[8], p1[9], p1[10], p1[11]}, (f32x4){p1[12], p1[13], p1[14], p1[15]});
#pragma unroll
            for (int blk = 0; blk < 8; ++blk) { const int dv = 32 * blk + r32;
#pragma unroll
                for (int s = 0; s < 4; ++s) { const int c = 2 * s + hi;
                    const bf16x8 vf = *(const LAS bf16x8*)(Vt + dv * 128 + ((c ^ (dv & 7)) << 4));
                    O[blk] = mfma32(__builtin_bit_cast(bf16x8, pw[s]), vf, O[blk]); } }
        }
        lrun += __shfl_xor(lrun, 32);
        asm volatile("s_waitcnt lgkmcnt(0)" ::: "memory");
        if (hi == 0) wsf[r32] = 1.0f / lrun;
        asm volatile("s_waitcnt lgkmcnt(0)" ::: "memory");
        bf16* ob = OX + (size_t)(b * SEQ + qb * 256 + wv * 32) * 1024 + h * 256 + r32;
#pragma unroll
        for (int r = 0; r < 16; ++r) { const int q = crow32(r, hi); const float a = wsf[q];
#pragma unroll
            for (int i = 0; i < 8; ++i) ob[(size_t)q * 1024 + 32 * i] = (bf16)f2bf(O[i][r] * a);
            if (r & 1) asm volatile("" ::: "memory"); }
    }
    WG_SYNC();
}

__device__ __forceinline__ void router_phase(Frame& F) {
    const bf16* XB = wsp<bf16>(F, WS_Q); const bf16* RT = wsp<bf16>(F, W_RT);
    const float* rowsq = (const float*)(F.ctl + CW_ROWSQ2); const float* brg = F.in[19]; const float* bre = F.in[21];
    gu32* cnt = F.ctl + CW_CNT; int* list = wsp<int>(F, WS_LIST); float* tokc = wsp<float>(F, WS_TOKC);
    const int lane = F.lane, wv = F.wave, fr = lane & 15, fq = lane >> 4;
    LAS float* lg = (LAS float*)F.lds + wv * (16 * 48);
    for (int unit = F.vcu; unit < T / 128; unit += F.G) {
        const int tok0 = unit * 128 + wv * 16;
        f32x4 acc[3] = {f32x4{}, f32x4{}, f32x4{}};
        const bf16* ap = XB + (size_t)(tok0 + fr) * 1024 + 8 * fq; const bf16* bp = RT + (size_t)fr * 1024 + 8 * fq;
#pragma unroll 4
        for (int ks = 0; ks < 32; ++ks) { const bf16x8 a = *(const GAS bf16x8*)(ap + 32 * ks);
#pragma unroll
            for (int ct = 0; ct < 3; ++ct) { const bf16x8 bb = *(const GAS bf16x8*)(bp + (size_t)ct * 16 * 1024 + 32 * ks); acc[ct] = mfma16(a, bb, acc[ct]); } }
#pragma unroll
        for (int ct = 0; ct < 3; ++ct)
#pragma unroll
            for (int r = 0; r < 4; ++r) lg[(4 * fq + r) * 48 + 16 * ct + fr] = acc[ct][r];
        asm volatile("s_waitcnt lgkmcnt(0)" ::: "memory");
        if (lane < 16) { const int tok = tok0 + lane; const LAS float* l = lg + lane * 48;
            const float rs = __builtin_amdgcn_rsqf(rowsq[tok] * (1.0f / 1024.0f) + EPS);
            float gl[4]; int gs = 0; float gm;
#pragma unroll
            for (int g = 0; g < 4; ++g) gl[g] = l[g] * rs + brg[g];
            gm = gl[0];
#pragma unroll
            for (int g = 1; g < 4; ++g) if (gl[g] > gm) { gm = gl[g]; gs = g; }
            float den = 0.f;
#pragma unroll
            for (int g = 0; g < 4; ++g) den += __expf(gl[g] - gm);
            const float ggate = 1.0f / den;
            float v1 = -INFINITY, v2 = -INFINITY; int i1 = 0, i2 = 0;
            for (int e = 0; e < 8; ++e) { const float v = l[4 + 8 * gs + e] * rs + bre[gs * 8 + e];
                if (v > v1) { v2 = v1; i2 = i1; v1 = v; i1 = e; } else if (v > v2) { v2 = v; i2 = e; } }
            const float e21 = __expf(v2 - v1), w1 = ggate / (1.0f + e21), w2 = ggate * e21 / (1.0f + e21);
            const int lo = i1 < i2 ? i1 : i2, hi_ = i1 < i2 ? i2 : i1; const float clo = i1 < i2 ? w1 : w2, chi = i1 < i2 ? w2 : w1;
            const int cls = gs * 28 + (lo * (15 - lo)) / 2 + (hi_ - lo - 1);
            const unsigned slot = __hip_atomic_fetch_add(cnt + 64 * cls, 1u, RLX_AGENT);
            list[(size_t)cls * T + slot] = tok; tokc[2 * tok] = clo; tokc[2 * tok + 1] = chi; }
        asm volatile("s_waitcnt lgkmcnt(0)" ::: "memory");
    }
}

__device__ __forceinline__ void moe_phase(Frame& F) {
    const bf16* XB = wsp<bf16>(F, WS_Q); const bf16* W1 = wsp<bf16>(F, W_E1); const bf16* W2 = wsp<bf16>(F, W_E2);
    const float* rowsq = (const float*)(F.ctl + CW_ROWSQ2); const float* tokc = wsp<float>(F, WS_TOKC); const int* list = wsp<int>(F, WS_LIST);
    const float* gfin = F.in[25]; float* X2 = F.out;
    const int wv = F.wave;
    LAS unsigned char* XP = F.lds;
    LAS int* pre = (LAS int*)(F.lds + 131072);
    LAS int* tk = pre + 128;
    LAS float* rsr = (LAS float*)(tk + 64);
    LAS float* cwr = rsr + 64;
    LAS float* rfin = cwr + 128;
    if (F.tid == 0) { int acc = 0; for (int c = 0; c < NCLS; ++c) { pre[c] = acc; const int n = (int)__hip_atomic_load(F.ctl + CW_CNT + 64 * c, RLX_AGENT); acc += (n + 63) >> 6; } pre[NCLS] = acc; }
    WG_SYNC();
    const int nunits = __builtin_amdgcn_readfirstlane(pre[NCLS]);
    for (int u = F.vcu; u < nunits; u += F.G) {
        int lane; asm volatile("v_mbcnt_lo_u32_b32 %0, -1, 0\n\tv_mbcnt_hi_u32_b32 %0, -1, %0" : "=v"(lane)); const int tid = wv * 64 + lane;
        const int r32 = lane & 31, hl = lane >> 5;
        int cls = 0; while (__builtin_amdgcn_readfirstlane(pre[cls + 1]) <= u) ++cls;
        const int chunk = u - pre[cls], ncls = __builtin_amdgcn_readfirstlane((int)__hip_atomic_load(F.ctl + CW_CNT + 64 * cls, RLX_AGENT)), ntok = (ncls - 64 * chunk) < 64 ? (ncls - 64 * chunk) : 64;
        const int grp = cls / 28; int pidx = cls % 28, lo = 0; while (pidx >= 7 - lo) { pidx -= 7 - lo; ++lo; } const int hi_ = lo + 1 + pidx;
        const int e1 = grp * 8 + lo, e2 = grp * 8 + hi_;
        if (tid < 64) { const int r = tid < ntok ? tid : 0; const int tok = list[(size_t)cls * T + 64 * chunk + r]; tk[tid] = tok;
            rsr[tid] = __builtin_amdgcn_rsqf(rowsq[tok] * (1.0f / 1024.0f) + EPS); cwr[2 * tid] = tokc[2 * tok]; cwr[2 * tid + 1] = tokc[2 * tok + 1]; }
        WG_SYNC();
#pragma unroll 4
        for (int i = 0; i < 16; ++i) { const int ci = tid + 512 * i, r = ci >> 7, c = ci & 127;
            const v4u v = *(const GAS v4u*)(XB + (size_t)tk[r] * 1024 + c * 8);
            *(LAS v4u*)(XP + r * 2048 + ((c ^ (r & 15)) << 4)) = v; }
        WG_SYNC();
        unsigned hp[2][2][8];
#pragma unroll
        for (int ex = 0; ex < 2; ++ex) { const int e = ex ? e2 : e1;
            f32x16 aG[2] = {f32x16{}, f32x16{}}, aU[2] = {f32x16{}, f32x16{}};
            const bf16* wp = W1 + ((size_t)(e * 8 + wv) * 64 * 2 * 64 + lane) * 8;
#pragma unroll 1
            for (int ks = 0; ks < 64; ++ks) {
                const bf16x8 bG = *(const GAS bf16x8*)(wp + (size_t)(ks * 2 + 0) * 512), bU = *(const GAS bf16x8*)(wp + (size_t)(ks * 2 + 1) * 512);
                const int c = 2 * ks + hl;
                const bf16x8 a0 = *(const LAS bf16x8*)(XP + r32 * 2048 + ((c ^ (r32 & 15)) << 4)), a1 = *(const LAS bf16x8*)(XP + (32 + r32) * 2048 + ((c ^ (r32 & 15)) << 4));
                aG[0] = mfma32(a0, bG, aG[0]); aG[1] = mfma32(a1, bG, aG[1]); aU[0] = mfma32(a0, bU, aU[0]); aU[1] = mfma32(a1, bU, aU[1]); }
#pragma unroll
            for (int rt = 0; rt < 2; ++rt)
#pragma unroll
                for (int r = 0; r < 16; r += 2) { float hv[2];
#pragma unroll
                    for (int q = 0; q < 2; ++q) { const int row = 32 * rt + crow32(r + q, hl); const float rs = rsr[row];
                        const float g = aG[rt][r + q] * rs, uu = aU[rt][r + q] * rs;
                        hv[q] = g * __builtin_amdgcn_rcpf(1.0f + __builtin_amdgcn_exp2f(-1.4426950408889634f * g)) * uu * cwr[2 * row + ex]; }
                    hp[ex][rt][r >> 1] = pk2(hv[0], hv[1]); }
        }
        WG_SYNC();
#pragma unroll
        for (int ex = 0; ex < 2; ++ex)
#pragma unroll
            for (int rt = 0; rt < 2; ++rt)
#pragma unroll
                for (int r = 0; r < 16; ++r) { const int row = 32 * rt + crow32(r, hl), kk = ex * 256 + 32 * wv + r32, c = kk >> 3;
                    *(LAS unsigned short*)(XP + row * 1024 + ((c ^ (row & 15)) << 4) + (kk & 7) * 2) = (unsigned short)((r & 1) ? (hp[ex][rt][r >> 1] >> 16) : (hp[ex][rt][r >> 1] & 0xffffu)); if ((r & 3) == 3) asm volatile("" ::: "memory"); }
        WG_SYNC();
        f32x16 Y[2][4];
#pragma unroll
        for (int rt = 0; rt < 2; ++rt)
#pragma unroll
            for (int ct = 0; ct < 4; ++ct) Y[rt][ct] = f32x16{};
#pragma unroll 1
        for (int ks = 0; ks < 32; ++ks) { const int e = (ks >> 4) ? e2 : e1, ksl = ks & 15;
            const bf16* wp = W2 + ((size_t)((e * 8 + wv) * 16 + ksl) * 4 * 64 + lane) * 8;
            const int c = 2 * ks + hl;
            const bf16x8 a0 = *(const LAS bf16x8*)(XP + r32 * 1024 + ((c ^ (r32 & 15)) << 4)), a1 = *(const LAS bf16x8*)(XP + (32 + r32) * 1024 + ((c ^ (r32 & 15)) << 4));
#pragma unroll
            for (int ct = 0; ct < 4; ++ct) { const bf16x8 bb = *(const GAS bf16x8*)(wp + (size_t)ct * 512); Y[0][ct] = mfma32(a0, bb, Y[0][ct]); Y[1][ct] = mfma32(a1, bb, Y[1][ct]); } }
        WG_SYNC();
        LAS float* PS = (LAS float*)XP;
#pragma unroll
        for (int rt = 0; rt < 2; ++rt)
#pragma unroll
            for (int r = 0; r < 16; ++r) { const int row = 32 * rt + crow32(r, hl); const float* xr = X2 + (size_t)tk[row] * 1024 + 128 * wv + r32; float ss = 0.f;
#pragma unroll
                for (int ct = 0; ct < 4; ++ct) { const float v = xr[32 * ct] + Y[rt][ct][r]; Y[rt][ct][r] = v; ss += v * v; }
                PS[row * 256 + 32 * wv + r32] = ss; if (r & 1) asm volatile("" ::: "memory"); }
        WG_SYNC();
        { const int row = tid >> 3, seg = tid & 7; float s = 0.f;
#pragma unroll 8
          for (int i = 0; i < 32; ++i) s += PS[row * 256 + seg * 32 + ((i + lane) & 31)];
          s += __shfl_xor(s, 1); s += __shfl_xor(s, 2); s += __shfl_xor(s, 4);
          if (seg == 0) rfin[row] = __builtin_amdgcn_rsqf(s * (1.0f / 1024.0f) + EPS); }
        WG_SYNC();
        float gf[4];
#pragma unroll
        for (int ct = 0; ct < 4; ++ct) gf[ct] = gfin[128 * wv + 32 * ct + r32];
#pragma unroll
        for (int rt = 0; rt < 2; ++rt)
#pragma unroll
            for (int r = 0; r < 16; ++r) { const int row = 32 * rt + crow32(r, hl);
                if (row < ntok) { float* orow = X2 + (size_t)tk[row] * 1024 + 128 * wv + r32; const float rf = rfin[row];
#pragma unroll
                    for (int ct = 0; ct < 4; ++ct) orow[32 * ct] = Y[rt][ct][r] * rf * gf[ct]; }
                if (r & 1) asm volatile("" ::: "memory"); }
        WG_SYNC();
    }
}

struct Args { const float* in[26]; float* out; unsigned char* ws; int ph_lo, ph_hi; };
__global__ void __launch_bounds__(NWAVES * 64, 2) fwd_kernel(Args args) {
    extern __shared__ __attribute__((aligned(16))) unsigned char lds[];
    Frame F;
    F.lds = (LAS unsigned char*)lds;
    F.MISC = (volatile LAS unsigned*)(F.lds + MISC_OFF);
    F.tid = threadIdx.x; F.lane = F.tid & 63; F.wave = __builtin_amdgcn_readfirstlane(F.tid >> 6);
    F.G = gridDim.x; { const int bx = blockIdx.x; F.vcu = (F.G % 8 == 0) ? (bx % 8) * (F.G / 8) + bx / 8 : bx; }
    F.ws = args.ws; F.ctl = (gu32*)(args.ws + WS_CTL); F.out = args.out;
    F.in = args.in;
    for (int u = F.tid; u < (LDS_BYTES - LDSCTL_OFF) / 4; u += NWAVES * 64) ((LAS unsigned*)(F.lds + LDSCTL_OFF))[u] = 0u;
    __syncthreads();
    const bool one = (args.ph_hi - args.ph_lo) > 1;
    XcdBarrier bar; bar.bar = (unsigned*)(F.ctl + CW_BAR); bar.x = 0; bar.st = nullptr;
    if (one) bar = xcd_barrier_post((unsigned*)(F.ctl + CW_BAR), F.MISC + 8);
    const int lo = args.ph_lo, hi = args.ph_hi;
#define REFRESH() do { int l_; asm volatile("v_mbcnt_lo_u32_b32 %0, -1, 0\n\tv_mbcnt_hi_u32_b32 %0, -1, %0" : "=v"(l_)); F.lane = l_; F.tid = F.wave * 64 + l_; } while (0)
#ifndef MK_PHASE_MASK
#define MK_PHASE_MASK 0xFFF
#endif
#define IN(k) (((MK_PHASE_MASK >> (k)) & 1) && lo <= (k) && (k) < hi)
#define SEAM(k) do { if (IN(k) && IN((k) + 1)) xcd_barrier(bar); } while (0)
    const float* rstd0 = wsp<float>(F, WS_RSTD0);
    const float* rope = wsp<float>(F, WS_ROPE);
    const int bx = (int)blockIdx.x;

    if (IN(0)) { REFRESH(); p0_prologue(F); } SEAM(0);

    if (IN(1)) { REFRESH();
        const pg8::bf16_t* XB = wsp<pg8::bf16_t>(F, WS_XB);
        { pg8::Gemm g{XB, wsp<pg8::bf16_t>(F, W_R), T, 1536, 1024}; pg8::StaticOrder S; S.init(T, 1536, F.G, bx);
          static_assert(WS_K - WS_Q == WS_QI - WS_K, "Q, K, QI equally spaced");
          pg8::EpiRope E{wsp<pg8::bf16_t>(F, WS_Q), (size_t)(WS_K - WS_Q) / 2, rstd0, rope};
          pg8::gemm_phase<pg8::EpiRope, pg8::StaticOrder, PG8_ALIGN, PG8_SP2>(F.lds, g, S, E); }
        { pg8::Gemm g{XB, wsp<pg8::bf16_t>(F, W_V), T, 512, 1024}; pg8::StaticOrder S; S.init(T, 512, F.G, bx);
          pg8::EpiScale E{wsp<pg8::bf16_t>(F, WS_V), 512, rstd0, nullptr, EPS};
          pg8::gemm_phase<pg8::EpiScale, pg8::StaticOrder, PG8_ALIGN, PG8_SP2>(F.lds, g, S, E); }
        { pg8::Gemm g{XB, wsp<pg8::bf16_t>(F, W_G), T, 1024, 1024}; pg8::StaticOrder S; S.init(T, 1024, F.G, bx);
          pg8::EpiGlu E{wsp<pg8::bf16_t>(F, WS_U), rstd0};
          pg8::gemm_phase<pg8::EpiGlu, pg8::StaticOrder, PG8_ALIGN, PG8_SP2>(F.lds, g, S, E); }
        { pg8::Gemm g{XB, wsp<pg8::bf16_t>(F, W_X), T, 256, 1024}; pg8::StaticOrder S; S.init(T, 256, F.G, bx);
          pg8::EpiKiWi E{wsp<pg8::bf16_t>(F, WS_KI), wsp<float>(F, WS_WI), rstd0, rope};
          pg8::gemm_phase<pg8::EpiKiWi, pg8::StaticOrder, PG8_ALIGN, PG8_SP2>(F.lds, g, S, E); }
        { pg8::Gemm g{wsp<pg8::bf16_t>(F, WS_MEMB), wsp<pg8::bf16_t>(F, W_KVX), NBATCH * NMEM, 2048, 1024}; pg8::StaticOrder S; S.init(NBATCH * NMEM, 2048, F.G, (bx + 128) % F.G);
          pg8::EpiMemKV E{wsp<pg8::bf16_t>(F, WS_KX), wsp<pg8::bf16_t>(F, WS_VT), wsp<float>(F, WS_RSTDM)};
          pg8::gemm_phase<pg8::EpiMemKV, pg8::StaticOrder, PG8_ALIGN, PG8_SP2>(F.lds, g, S, E); }
    } SEAM(1);

    if (IN(2)) { REFRESH(); indexer_phase(F); conv_phase(F); } SEAM(2);

    if (IN(3)) { REFRESH();
        const attn_body::AttnTensors AT{(const attn_body::bf16*)wsp<bf16>(F, WS_Q), (const attn_body::bf16*)wsp<bf16>(F, WS_K), (const attn_body::bf16*)wsp<bf16>(F, WS_V), (attn_body::bf16*)wsp<bf16>(F, WS_Q), wsp<uint2>(F, WS_MASK)};
        const attn_body::StaticOrder S((int)F.G, bx);
        attn_body::attn_phase<attn_body::StaticOrder>((char*)lds, AT, S);
    } SEAM(3);

    if (IN(4)) { REFRESH();
        { pg8::Gemm g{wsp<pg8::bf16_t>(F, WS_Q), wsp<pg8::bf16_t>(F, W_OA), T, 1024, 512}; pg8::StaticOrder S; S.init(T, 1024, F.G, bx);
          pg8::EpiScale E{wsp<pg8::bf16_t>(F, WS_K), 1024, nullptr, nullptr, EPS};
          pg8::gemm_phase<pg8::EpiScale, pg8::StaticOrder, PG8_ALIGN, PG8_SP2>(F.lds, g, S, E); }
        { pg8::Gemm g{wsp<pg8::bf16_t>(F, WS_CA), wsp<pg8::bf16_t>(F, W_CO), T, 1024, 512}; pg8::StaticOrder S; S.init(T, 1024, F.G, bx);
          pg8::EpiScale E{wsp<pg8::bf16_t>(F, WS_QI), 1024, nullptr, nullptr, EPS};
          pg8::gemm_phase<pg8::EpiScale, pg8::StaticOrder, PG8_ALIGN, PG8_SP2>(F.lds, g, S, E); }
    } SEAM(4);

    if (IN(5)) { REFRESH();
        pg8::Gemm g{wsp<pg8::bf16_t>(F, WS_XB), wsp<pg8::bf16_t>(F, W_GT), T, 2048, 1024}; pg8::StaticOrder S; S.init(T, 2048, F.G, bx);
        pg8::EpiMerge E{wsp<pg8::bf16_t>(F, WS_K), wsp<pg8::bf16_t>(F, WS_QI), wsp<pg8::bf16_t>(F, WS_Q), rstd0};
        pg8::gemm_phase<pg8::EpiMerge, pg8::StaticOrder, PG8_ALIGN, PG8_SP2>(F.lds, g, S, E);
    } SEAM(5);

    if (IN(6)) { REFRESH();
        pg8::Gemm g{wsp<pg8::bf16_t>(F, WS_Q), wsp<pg8::bf16_t>(F, W_OUT), T, 1024, 1024}; pg8::StaticOrder S; S.init(T, 1024, F.G, bx);
        pg8::EpiResid E{F.in[0], F.out, wsp<pg8::bf16_t>(F, WS_XB), (float*)(F.ctl + CW_ROWSQ1)};
        pg8::gemm_phase<pg8::EpiResid, pg8::StaticOrder, PG8_ALIGN, PG8_SP2>(F.lds, g, S, E);
    } SEAM(6);

    if (IN(7)) { REFRESH();
        pg8::Gemm g{wsp<pg8::bf16_t>(F, WS_XB), wsp<pg8::bf16_t>(F, W_QX), T, 1024, 1024}; pg8::StaticOrder S; S.init(T, 1024, F.G, bx);
        pg8::EpiScale E{wsp<pg8::bf16_t>(F, WS_K), 1024, nullptr, (const float*)(F.ctl + CW_ROWSQ1), EPS};
        pg8::gemm_phase<pg8::EpiScale, pg8::StaticOrder, PG8_ALIGN, PG8_SP2>(F.lds, g, S, E);
    } SEAM(7);

    if (IN(8)) { REFRESH(); xattn_phase(F); } SEAM(8);

    if (IN(9)) { REFRESH();
        pg8::Gemm g{wsp<pg8::bf16_t>(F, WS_QI), wsp<pg8::bf16_t>(F, W_OX), T, 1024, 1024}; pg8::StaticOrder S; S.init(T, 1024, F.G, bx);
        pg8::EpiResid E{F.out, F.out, wsp<pg8::bf16_t>(F, WS_Q), (float*)(F.ctl + CW_ROWSQ2)};
        pg8::gemm_phase<pg8::EpiResid, pg8::StaticOrder, PG8_ALIGN, PG8_SP2>(F.lds, g, S, E);
    } SEAM(9);

    if (IN(10)) { REFRESH(); router_phase(F); } SEAM(10);

    if (IN(11)) { REFRESH(); moe_phase(F); }
#undef IN
#undef SEAM
#undef REFRESH
}

constexpr int N_PHASES = 12;
#ifndef MK_ONE_LAUNCH
#define MK_ONE_LAUNCH 1
#endif
extern "C" void kernel_launch(void* const* d_in, const int* in_sizes, int n_in, void* d_out, int out_size, void* d_ws, size_t ws_size, hipStream_t stream) {
    static int grid = 0;
    if (grid == 0) {
        if (n_in != 26 || in_sizes[0] != T * DM || out_size != T * DM || ws_size < WS_END) { fprintf(stderr, "kernel_launch: unexpected shapes (n_in %d, in0 %d, out %d, ws %zu); nothing launched\n", n_in, n_in > 0 ? in_sizes[0] : -1, out_size, ws_size); grid = -1; return; }
        int dev = 0, cus = 0, per_cu = 0;
        if (hipGetDevice(&dev) != hipSuccess || hipDeviceGetAttribute(&cus, hipDeviceAttributeMultiprocessorCount, dev) != hipSuccess) { grid = -1; return; }
        if (hipFuncSetAttribute((const void*)fwd_kernel, hipFuncAttributeMaxDynamicSharedMemorySize, LDS_BYTES) != hipSuccess) { fprintf(stderr, "kernel_launch: hipFuncSetAttribute failed\n"); grid = -1; return; }
        if (hipOccupancyMaxActiveBlocksPerMultiprocessor(&per_cu, (const void*)fwd_kernel, NWAVES * 64, LDS_BYTES) != hipSuccess || per_cu < 1) { fprintf(stderr, "kernel_launch: occupancy query says %d blocks per CU\n", per_cu); }
        (void)hipGetLastError();
        grid = cus;
    }
    if (grid < 0) return;
    if (hipMemsetAsync((char*)d_ws + WS_CTL, 0, CTL_ZERO_BYTES, stream) != hipSuccess) return;
    Args a{};
    for (int i = 0; i < 26; ++i) a.in[i] = (const float*)d_in[i];
    a.out = (float*)d_out; a.ws = (unsigned char*)d_ws;
#if MK_ONE_LAUNCH
    a.ph_lo = 0; a.ph_hi = N_PHASES;
    hipLaunchKernelGGL(fwd_kernel, dim3(grid), dim3(NWAVES * 64), LDS_BYTES, stream, a);
#else
    for (int p = 0; p < N_PHASES; ++p) { a.ph_lo = p; a.ph_hi = p + 1; hipLaunchKernelGGL(fwd_kernel, dim3(grid), dim3(NWAVES * 64), LDS_BYTES, stream, a); }
#endif
}
```

```cpp
#include <hip/hip_runtime.h>
#include <hip/hip_bf16.h>
#include <cstdio>
#include <cstdint>
#include <cmath>
namespace pg8 {
#define PG8_LAS __attribute__((address_space(3)))
typedef unsigned short bf16_t;
typedef short bf16x8 __attribute__((ext_vector_type(8)));
typedef float f32x4 __attribute__((ext_vector_type(4)));
typedef unsigned u32x4 __attribute__((ext_vector_type(4)));
constexpr int BM = 256, BK = 64, HALF = 128, HTB = HALF * BK * 2  , STAGE_BYTES = 8 * HTB, NXCD = 8, WGM = 8;

__host__ __device__ __forceinline__ int lds_byte(int r, int c) { const int st = (r >> 4) * 2 + (c >> 5), rr = r & 15, cc = c & 31, ob = rr * 64 + cc * 2; return st * 1024 + (ob ^ (((ob >> 9) & 1) << 5)); }
__host__ __device__ __forceinline__ void stage_rc(int b, int& R, int& C) { const int st = b / 1024, sb = b % 1024, swz = sb ^ (((sb >> 9) & 1) << 5); R = (st >> 1) * 16 + swz / 64; C = (st & 1) * 32 + (swz % 64) / 2; }
__host__ __device__ __forceinline__ int perm32(int rho) { const int n = rho >> 4, i = rho & 15; return 8 * (i >> 2) + 4 * n + (i & 3); }

struct Unit { int pm, pn; };
struct Gemm { const bf16_t* A; const bf16_t* Bt; int M, N, K; };

struct StaticOrder {
    int nM, nN, nwg, G, c;
    __host__ __device__ void init(int M, int N, int G_, int c_) { nM = M / BM; nN = N / BM; nwg = nM * nN; G = G_; c = c_; }
    __host__ __device__ bool next(int i, Unit& u) const {
        const long L = (long)i * G + c; if (L >= nwg) return false;
        int wgid = (int)L; { const int q = nwg / NXCD, r = nwg % NXCD, xcd = wgid % NXCD, off = wgid / NXCD; wgid = (xcd < r ? xcd * (q + 1) : r * (q + 1) + (xcd - r) * q) + off; }
        const int nig = WGM * nN, gid = wgid / nig, fm = gid * WGM, gsz = (nM - fm) < WGM ? (nM - fm) : WGM;
        u.pm = fm + ((wgid % nig) % gsz); u.pn = (wgid % nig) / gsz; return true;
    }
    __device__ __forceinline__ void a_ready(const Unit&) const {}
    __device__ __forceinline__ void done(const Unit&) const {}
};

__device__ __forceinline__ unsigned cvt_pk_bf16(float lo, float hi) { unsigned r; asm volatile("v_cvt_pk_bf16_f32 %0, %1, %2" : "=v"(r) : "v"(lo), "v"(hi)); return r; }
typedef float f32x2 __attribute__((ext_vector_type(2)));
__device__ __forceinline__ f32x2 gelu_pk(f32x2 v) {
    const f32x2 av = __builtin_elementwise_abs(v), d = av * 0.2316418882f + 1.0f;
    f32x2 t; t.x = __builtin_amdgcn_rcpf(d.x); t.y = __builtin_amdgcn_rcpf(d.y);
    f32x2 q = t * 0.5307027145f + (-0.7265760135f); q = q * t + 0.7107068705f; q = q * t + (-0.142248368f); q = q * t + 0.127414796f; q = q * t;
    const f32x2 s = (v * v) * (-0.72134752044f);
    f32x2 e; e.x = __builtin_amdgcn_exp2f(s.x); e.y = __builtin_amdgcn_exp2f(s.y);
    const f32x2 m = v * (q * e), r = v - m;
    f32x2 o; o.x = v.x < 0.f ? m.x : r.x; o.y = v.y < 0.f ? m.y : r.y; return o;
}

template <int ACT  > struct EpiBf16 {
    static constexpr bool PERM = true, AFTER_DRAIN = false; static_assert(ACT == 0 || ACT == 1, "EpiBf16: ACT is 0 (none) or 1 (gelu_pk)");
    bf16_t* O; int ldc; const float* bias; int split_cols; size_t split_stride; float scale0;
    __device__ __forceinline__ void operator()(const f32x4 (&acc)[2][2][4][2], const Unit& u, int wr, int wc, int fr, int fq) const {
        const int row0 = u.pm * BM + wr * 64 + fr; int colt = u.pn * BM; bf16_t* base = O;
        float sc = 1.f; if (split_cols) { const int t = colt / split_cols; base += (size_t)t * split_stride; colt -= t * split_cols; if (t == 0) sc = scale0; }
        const int col0 = colt + wc * 32 + 8 * fq, bcol0 = u.pn * BM + wc * 32 + 8 * fq;
        f32x4 bv[2][2];
#pragma unroll
        for (int bj = 0; bj < 2; ++bj)
#pragma unroll
            for (int n = 0; n < 2; ++n) bv[bj][n] = bias ? *(const f32x4*)(bias + bcol0 + bj * HALF + 4 * n) : (f32x4){0.f, 0.f, 0.f, 0.f};
#pragma unroll
        for (int ai = 0; ai < 2; ++ai)
#pragma unroll
            for (int m = 0; m < 4; ++m) { bf16_t* rowp = base + (size_t)(row0 + ai * HALF + m * 16) * ldc + col0;
#pragma unroll
                for (int bj = 0; bj < 2; ++bj) { f32x4 v0 = acc[ai][bj][m][0] + bv[bj][0], v1 = acc[ai][bj][m][1] + bv[bj][1];
                    if (ACT == 1) { f32x2 a = gelu_pk((f32x2){v0[0], v0[1]}), b = gelu_pk((f32x2){v0[2], v0[3]}), c = gelu_pk((f32x2){v1[0], v1[1]}), d = gelu_pk((f32x2){v1[2], v1[3]});
                        v0 = (f32x4){a.x, a.y, b.x, b.y}; v1 = (f32x4){c.x, c.y, d.x, d.y}; }
                    v0 = v0 * sc; v1 = v1 * sc; u32x4 w; w.x = cvt_pk_bf16(v0[0], v0[1]); w.y = cvt_pk_bf16(v0[2], v0[3]); w.z = cvt_pk_bf16(v1[0], v1[1]); w.w = cvt_pk_bf16(v1[2], v1[3]);
                    *(u32x4*)(rowp + bj * HALF) = w; } }
    }
};
__device__ __forceinline__ u32x4 pack8(const f32x4& a, const f32x4& b) { u32x4 w; w.x = cvt_pk_bf16(a[0], a[1]); w.y = cvt_pk_bf16(a[2], a[3]); w.z = cvt_pk_bf16(b[0], b[1]); w.w = cvt_pk_bf16(b[2], b[3]); return w; }
__device__ __forceinline__ unsigned short f2bf_rne(float f) { unsigned u = __builtin_bit_cast(unsigned, f); return (unsigned short)((u + 0x7fffu + ((u >> 16) & 1u)) >> 16); }
__device__ __forceinline__ f32x4 bf_lo4(const u32x4& w) { return (f32x4){__builtin_bit_cast(float, w.x << 16), __builtin_bit_cast(float, w.x & 0xffff0000u), __builtin_bit_cast(float, w.y << 16), __builtin_bit_cast(float, w.y & 0xffff0000u)}; }
__device__ __forceinline__ f32x4 bf_hi4(const u32x4& w) { return (f32x4){__builtin_bit_cast(float, w.z << 16), __builtin_bit_cast(float, w.z & 0xffff0000u), __builtin_bit_cast(float, w.w << 16), __builtin_bit_cast(float, w.w & 0xffff0000u)}; }
__device__ __forceinline__ f32x4 sigmoid4(const f32x4& v) { f32x4 r;
#pragma unroll
    for (int i = 0; i < 4; ++i) r[i] = __builtin_amdgcn_rcpf(1.0f + __builtin_amdgcn_exp2f(-1.4426950408889634f * v[i]));
    return r; }

struct EpiRope {
    static constexpr bool PERM = true, AFTER_DRAIN = false;
    bf16_t* O0; size_t tstride; const float* rstd; const float* rope;
    __device__ __forceinline__ void operator()(const f32x4 (&acc)[2][2][4][2], const Unit& u, int wr, int wc, int fr, int fq) const {
        bf16_t* base = O0 + (size_t)(u.pn >> 1) * tstride + (((u.pn & 1) * 4 + wc) * 64 + 8 * fq);
        const int row0 = u.pm * BM + wr * 64 + fr;
#pragma unroll
        for (int ai = 0; ai < 2; ++ai)
#pragma unroll
            for (int m = 0; m < 4; ++m) {
                const int row = row0 + ai * HALF + m * 16; const float rs = rstd[row];
                const float* rp = rope + (size_t)row * 64 + 8 * fq;
                const f32x4 c0 = *(const f32x4*)rp, c1 = *(const f32x4*)(rp + 4), s0 = *(const f32x4*)(rp + 32), s1 = *(const f32x4*)(rp + 36);
                const f32x4 x1a = acc[ai][0][m][0] * rs, x1b = acc[ai][0][m][1] * rs, x2a = acc[ai][1][m][0] * rs, x2b = acc[ai][1][m][1] * rs;
                bf16_t* op = base + (size_t)row * 512;
                *(u32x4*)op = pack8(x1a * c0 - x2a * s0, x1b * c1 - x2b * s1);
                *(u32x4*)(op + 32) = pack8(x2a * c0 + x1a * s0, x2b * c1 + x1b * s1);
            }
    }
};
struct EpiScale {
    static constexpr bool PERM = true, AFTER_DRAIN = false;
    bf16_t* O; int ldc; const float* rstd; const float* rowsq; float eps;
    __device__ __forceinline__ void operator()(const f32x4 (&acc)[2][2][4][2], const Unit& u, int wr, int wc, int fr, int fq) const {
        const int row0 = u.pm * BM + wr * 64 + fr, col0 = u.pn * BM + wc * 32 + 8 * fq;
#pragma unroll
        for (int ai = 0; ai < 2; ++ai)
#pragma unroll
            for (int m = 0; m < 4; ++m) {
                const int row = row0 + ai * HALF + m * 16;
                const float rs = rstd ? rstd[row] : (rowsq ? __builtin_amdgcn_rsqf(rowsq[row] * (1.0f / 1024.0f) + eps) : 1.0f);
                bf16_t* op = O + (size_t)row * ldc + col0;
#pragma unroll
                for (int bj = 0; bj < 2; ++bj) *(u32x4*)(op + bj * HALF) = pack8(acc[ai][bj][m][0] * rs, acc[ai][bj][m][1] * rs);
            }
    }
};
struct EpiMemKV {
    static constexpr bool PERM = true, AFTER_DRAIN = false;
    bf16_t* KXH; bf16_t* VH; const float* rstd;
    __device__ __forceinline__ void operator()(const f32x4 (&acc)[2][2][4][2], const Unit& u, int wr, int wc, int fr, int fq) const {
        const int row0 = u.pm * BM + wr * 64 + fr, col0 = (u.pn & 3) * BM + wc * 32 + 8 * fq; bf16_t* base = u.pn < 4 ? KXH : VH;
#pragma unroll
        for (int ai = 0; ai < 2; ++ai)
#pragma unroll
            for (int m = 0; m < 4; ++m) {
                const int row = row0 + ai * HALF + m * 16; const float rs = rstd[row]; const int b = row >> 8, key = row & 255;
#pragma unroll
                for (int bj = 0; bj < 2; ++bj) { const int col = col0 + bj * HALF, h = col >> 8, d = col & 255;
                    *(u32x4*)(base + ((size_t)(b * 4 + h) * 256 + key) * 256 + d) = pack8(acc[ai][bj][m][0] * rs, acc[ai][bj][m][1] * rs); }
            }
    }
};
struct EpiGlu {
    static constexpr bool PERM = true, AFTER_DRAIN = false;
    bf16_t* U; const float* rstd;
    __device__ __forceinline__ void operator()(const f32x4 (&acc)[2][2][4][2], const Unit& u, int wr, int wc, int fr, int fq) const {
        const int row0 = u.pm * BM + wr * 64 + fr, col0 = u.pn * HALF + wc * 32 + 8 * fq;
#pragma unroll
        for (int ai = 0; ai < 2; ++ai)
#pragma unroll
            for (int m = 0; m < 4; ++m) {
                const int row = row0 + ai * HALF + m * 16; const float rs = rstd[row];
                const f32x4 a0 = acc[ai][0][m][0] * rs, a1 = acc[ai][0][m][1] * rs, b0 = acc[ai][1][m][0] * rs, b1 = acc[ai][1][m][1] * rs;
                *(u32x4*)(U + (size_t)row * 512 + col0) = pack8(a0 * sigmoid4(b0), a1 * sigmoid4(b1));
            }
    }
};
struct EpiKiWi {
    static constexpr bool PERM = true, AFTER_DRAIN = false;
    bf16_t* KI; float* WI; const float* rstd; const float* rope;
    __device__ __forceinline__ void operator()(const f32x4 (&acc)[2][2][4][2], const Unit& u, int wr, int wc, int fr, int fq) const {
        const int row0 = u.pm * BM + wr * 64 + fr;
        if (wc == 0) {
#pragma unroll
            for (int ai = 0; ai < 2; ++ai)
#pragma unroll
                for (int m = 0; m < 4; ++m) {
                    const int row = row0 + ai * HALF + m * 16; const float rs = rstd[row];
                    const float* rp = rope + (size_t)row * 64 + 8 * fq;
                    const f32x4 c0 = *(const f32x4*)rp, c1 = *(const f32x4*)(rp + 4), s0 = *(const f32x4*)(rp + 32), s1 = *(const f32x4*)(rp + 36);
                    const f32x4 x1a = acc[ai][0][m][0] * rs, x1b = acc[ai][0][m][1] * rs, x2a = acc[ai][1][m][0] * rs, x2b = acc[ai][1][m][1] * rs;
                    bf16_t* op = KI + (((size_t)(row >> 5) * 4 + (fq >> 1)) * 64 + (fq & 1) * 32 + (row & 31)) * 8;
                    *(u32x4*)op = pack8(x1a * c0 - x2a * s0, x1b * c1 - x2b * s1);
                    *(u32x4*)(op + 2 * 64 * 8) = pack8(x2a * c0 + x1a * s0, x2b * c1 + x1b * s1);
                }
        } else if (wc == 1 && fq == 0) {
#pragma unroll
            for (int ai = 0; ai < 2; ++ai)
#pragma unroll
                for (int m = 0; m < 4; ++m) {
                    const int row = row0 + ai * HALF + m * 16; const float rs = rstd[row];
                    float* op = WI + (size_t)row * 8;
                    *(f32x4*)op = acc[ai][0][m][0] * rs; *(f32x4*)(op + 4) = acc[ai][0][m][1] * rs;
                }
        }
    }
};
struct EpiMerge {
    static constexpr bool PERM = true, AFTER_DRAIN = false;
    const bf16_t* YA; const bf16_t* YC; bf16_t* MG; const float* rstd;
    __device__ __forceinline__ void operator()(const f32x4 (&acc)[2][2][4][2], const Unit& u, int wr, int wc, int fr, int fq) const {
        const int row0 = u.pm * BM + wr * 64 + fr, col0 = u.pn * HALF + wc * 32 + 8 * fq;
#pragma unroll
        for (int ai = 0; ai < 2; ++ai)
#pragma unroll
            for (int m = 0; m < 4; ++m) {
                const int row = row0 + ai * HALF + m * 16; const float rs = rstd[row]; const size_t off = (size_t)row * 1024 + col0;
                const u32x4 ya = *(const u32x4*)(YA + off), yc = *(const u32x4*)(YC + off);
                const f32x4 o0 = sigmoid4(acc[ai][0][m][0] * rs) * bf_lo4(ya) + sigmoid4(acc[ai][1][m][0] * rs) * bf_lo4(yc);
                const f32x4 o1 = sigmoid4(acc[ai][0][m][1] * rs) * bf_hi4(ya) + sigmoid4(acc[ai][1][m][1] * rs) * bf_hi4(yc);
                *(u32x4*)(MG + off) = pack8(o0, o1);
            }
    }
};
struct EpiResid {
    static constexpr bool PERM = true, AFTER_DRAIN = false;
    const bf16_t* resid; bf16_t* xb; float* rowsq;
    __device__ __forceinline__ void operator()(const f32x4 (&acc)[2][2][4][2], const Unit& u, int wr, int wc, int fr, int fq) const {
        const int row0 = u.pm * BM + wr * 64 + fr, col0 = (u.pn & 3) * BM + wc * 32 + 8 * fq;
#pragma unroll
        for (int ai = 0; ai < 2; ++ai)
#pragma unroll
            for (int m = 0; m < 4; ++m) {
                const int row = row0 + ai * HALF + m * 16; float ss = 0.f;
#pragma unroll
                for (int bj = 0; bj < 2; ++bj) { const size_t off = (size_t)row * 1024 + col0 + bj * HALF;
                    const u32x4 rw = *(const u32x4*)(resid + off);
                    const f32x4 v0 = bf_lo4(rw) + acc[ai][bj][m][0], v1 = bf_hi4(rw) + acc[ai][bj][m][1];
                    *(u32x4*)(xb + off) = pack8(v0, v1);
                    ss += (v0[0] * v0[0] + v0[1] * v0[1]) + (v0[2] * v0[2] + v0[3] * v0[3]) + (v1[0] * v1[0] + v1[1] * v1[1]) + (v1[2] * v1[2] + v1[3] * v1[3]); }
                ss += __shfl_xor(ss, 16); ss += __shfl_xor(ss, 32);
                if (fq == 0) atomicAdd(rowsq + row, ss);
            }
    }
};
struct EpiInProj {
    static constexpr bool PERM = true, AFTER_DRAIN = false;
    EpiRope rope; EpiScale v; EpiGlu glu; EpiKiWi kw;
    __device__ __forceinline__ void operator()(const f32x4 (&acc)[2][2][4][2], const Unit& u, int wr, int wc, int fr, int fq) const {
        if (u.pn < 6) rope(acc, u, wr, wc, fr, fq);
        else if (u.pn < 8) { Unit u2 = u; u2.pn -= 6; v(acc, u2, wr, wc, fr, fq); }
        else if (u.pn < 12) { Unit u2 = u; u2.pn -= 8; glu(acc, u2, wr, wc, fr, fq); }
        else { Unit u2 = u; u2.pn = 0; kw(acc, u2, wr, wc, fr, fq); }
    }
};
template <int LOGN> struct MoeOrderT {
    const PG8_LAS int* pre; const PG8_LAS int* cnt; const PG8_LAS unsigned char* t2e; const int* list; int G, c, Tcap, r0, r1;
    __device__ __forceinline__ bool next(int i, Unit& u) const {
        if (i + r0 >= r1) return false;
        const long L = (long)(i + r0) * G + c; const int ntiles = pre[32]; if (L >= ((long)ntiles << LOGN)) return false;
        const int t = (int)(L >> LOGN), n = (int)(L & ((1 << LOGN) - 1)); const int e = t2e[t];
        u.pm = t; u.pn = (e << LOGN) + n; return true;
    }
    __device__ __forceinline__ unsigned arow(const Unit& u, int r) const {
        const int e = u.pn >> LOGN, slot = (u.pm - pre[e]) * 256 + r; return (unsigned)list[(size_t)e * Tcap + (slot < cnt[e] ? slot : 0)];
    }
    __device__ __forceinline__ void a_ready(const Unit&) const {}
    __device__ __forceinline__ void done(const Unit&) const {}
};
typedef MoeOrderT<1> MoeOrder;
typedef __attribute__((address_space(1))) unsigned moe_gu32;
struct MoeOrder2 {
    const PG8_LAS int* pre; const PG8_LAS unsigned char* t2e; PG8_LAS unsigned* dflag; moe_gu32* ready; moe_gu32* tot; int gs, ge, j, gstr, wave, late; unsigned fullu, allu;
    __device__ __forceinline__ bool next(int i, Unit& u) const {
        const int L = gs + i * gstr + j; if (L >= ge) return false;
        const int t = L >> 2, n = L & 3, e = t2e[t]; u.pm = t; u.pn = (e << 2) + n; wait_tile(u, (unsigned)i); return true;
    }
    __device__ __forceinline__ unsigned arow(const Unit&, int) const { return 0u; }
    __device__ __forceinline__ void a_ready(const Unit&) const {}
    __device__ __forceinline__ void wait_tile(const Unit& u, unsigned i) const {
        const unsigned df = (unsigned)__builtin_amdgcn_readfirstlane((int)*dflag), st = df >> 16;
        const bool islate = u.pm >= late;
        if ((st == 0xFFFFu || (st == 0xFFFDu && !islate) || st == (unsigned)u.pm) && (df & 0xFFFFu) <= i) return;
        if (wave == 0) {
            unsigned polls = 0;
            if (islate) { while ((unsigned)__builtin_amdgcn_readfirstlane((int)__hip_atomic_load(ready + 64 * u.pm, __ATOMIC_RELAXED, __HIP_MEMORY_SCOPE_AGENT)) < 2u && ++polls < (1u << 21)) __builtin_amdgcn_s_sleep(2); }
            else { while ((unsigned)__builtin_amdgcn_readfirstlane((int)__hip_atomic_load(tot, __ATOMIC_RELAXED, __HIP_MEMORY_SCOPE_AGENT)) < fullu && ++polls < (1u << 21)) __builtin_amdgcn_s_sleep(2); }
            const unsigned tt = (unsigned)__builtin_amdgcn_readfirstlane((int)__hip_atomic_load(tot, __ATOMIC_RELAXED, __HIP_MEMORY_SCOPE_AGENT))
                              + (unsigned)__builtin_amdgcn_readfirstlane((int)__hip_atomic_load(tot + 64, __ATOMIC_RELAXED, __HIP_MEMORY_SCOPE_AGENT));
            __builtin_amdgcn_fence(__ATOMIC_ACQUIRE, "agent");
            asm volatile("s_waitcnt vmcnt(0)" ::: "memory");
            *dflag = ((tt >= allu ? 0xFFFFu : (islate ? (unsigned)u.pm : 0xFFFDu)) << 16) | (i + 1u);
            asm volatile("s_waitcnt lgkmcnt(0)" ::: "memory");
        }
        asm volatile("" ::: "memory"); __builtin_amdgcn_s_barrier(); asm volatile("" ::: "memory");
    }
    __device__ __forceinline__ void done(const Unit&) const {}
};
struct EpiMoeH {
    static constexpr bool PERM = true, AFTER_DRAIN = false;
    bf16_t* HS; const float* rowsq; const float* cE; float eps; MoeOrder S;
    __device__ __forceinline__ void operator()(const f32x4 (&acc)[2][2][4][2], const Unit& u, int wr, int wc, int fr_, int fq_) const {
        int fr = fr_, fq = fq_; asm volatile("" : "+v"(fr), "+v"(fq));
        const int e = u.pn >> 1, nt = u.pn & 1, slot0 = (u.pm - S.pre[e]) * 256, ne = S.cnt[e];
#pragma unroll
        for (int ai = 0; ai < 2; ++ai)
#pragma unroll
            for (int m = 0; m < 4; ++m) {
                const int r = ai * HALF + wr * 64 + m * 16 + fr, slot = slot0 + r; const bool live = slot < ne;
                const int tok = S.list[(size_t)e * S.Tcap + (live ? slot : 0)];
                const float rs = __builtin_amdgcn_rsqf(rowsq[tok] * (1.0f / 1024.0f) + eps), cw = live ? cE[(size_t)e * S.Tcap + slot] : 0.f;
                const f32x4 g0 = acc[ai][0][m][0] * rs, g1 = acc[ai][0][m][1] * rs, u0 = acc[ai][1][m][0] * (rs * cw), u1 = acc[ai][1][m][1] * (rs * cw);
                *(u32x4*)(HS + ((size_t)u.pm * 256 + r) * 256 + nt * HALF + wc * 32 + 8 * fq) = pack8(g0 * sigmoid4(g0) * u0, g1 * sigmoid4(g1) * u1);
            }
    }
};
struct EpiMoeY {
    static constexpr bool PERM = true, AFTER_DRAIN = false;
    bf16_t* YS;
    __device__ __forceinline__ void operator()(const f32x4 (&acc)[2][2][4][2], const Unit& u, int wr, int wc, int fr_, int fq_) const {
        int fr = fr_, fq = fq_; asm volatile("" : "+v"(fr), "+v"(fq));
        const int col0 = (u.pn & 3) * BM + wc * 32 + 8 * fq;
#pragma unroll
        for (int ai = 0; ai < 2; ++ai)
#pragma unroll
            for (int m = 0; m < 4; ++m) { bf16_t* op = YS + ((size_t)u.pm * 256 + ai * HALF + wr * 64 + m * 16 + fr) * 1024 + col0;
#pragma unroll
                for (int bj = 0; bj < 2; ++bj) *(u32x4*)(op + bj * HALF) = pack8(acc[ai][bj][m][0], acc[ai][bj][m][1]); }
    }
};
struct BatchOrder : StaticOrder {
    __device__ __forceinline__ bool next(int i, Unit& u) const { if (!StaticOrder::next(i, u)) return false; u.pn += (u.pm >> 4) * 4; return true; }
};
struct WkOrder { int G, c;
    __device__ __forceinline__ bool next(int i, Unit& u) const { const int L = i * G + c; if (L >= 128) return false; u.pm = L >> 2; u.pn = ((L >> 2) & 3) * 4 + (L & 3); return true; }
    __device__ __forceinline__ void a_ready(const Unit&) const {} __device__ __forceinline__ void done(const Unit&) const {} };
struct VwOrder { int G, c;
    __device__ __forceinline__ bool next(int i, Unit& u) const { const int L = i * G + c; if (L >= 128) return false; const int b = L >> 4, h = (L >> 2) & 3, mt = L & 3; u.pm = h * 4 + mt; u.pn = b * 4 + h; return true; }
    __device__ __forceinline__ void a_ready(const Unit&) const {} __device__ __forceinline__ void done(const Unit&) const {} };
struct EpiWk {
    static constexpr bool PERM = true, AFTER_DRAIN = false;
    bf16_t* O;
    __device__ __forceinline__ void operator()(const f32x4 (&acc)[2][2][4][2], const Unit& u, int wr, int wc, int fr, int fq) const {
        const int col0 = (u.pn & 3) * BM + wc * 32 + 8 * fq;
#pragma unroll
        for (int ai = 0; ai < 2; ++ai)
#pragma unroll
            for (int m = 0; m < 4; ++m) { bf16_t* op = O + ((size_t)u.pm * 256 + ai * HALF + wr * 64 + m * 16 + fr) * 1024 + col0;
#pragma unroll
                for (int bj = 0; bj < 2; ++bj) *(u32x4*)(op + bj * HALF) = pack8(acc[ai][bj][m][0], acc[ai][bj][m][1]); }
    }
};
struct EpiVw {
    static constexpr bool PERM = true, AFTER_DRAIN = false;
    bf16_t* O;
    __device__ __forceinline__ void operator()(const f32x4 (&acc)[2][2][4][2], const Unit& u, int wr, int wc, int fr, int fq) const {
        const int b = u.pn >> 2, h = u.pn & 3, mt = u.pm & 3, col0 = h * BM + wc * 32 + 8 * fq;
#pragma unroll
        for (int ai = 0; ai < 2; ++ai)
#pragma unroll
            for (int m = 0; m < 4; ++m) { bf16_t* op = O + ((size_t)b * 1024 + mt * 256 + ai * HALF + wr * 64 + m * 16 + fr) * 1024 + col0;
#pragma unroll
                for (int bj = 0; bj < 2; ++bj) *(u32x4*)(op + bj * HALF) = pack8(acc[ai][bj][m][0], acc[ai][bj][m][1]); }
    }
};
struct EpiSoftmax {
    static constexpr bool PERM = true, AFTER_DRAIN = false;
    bf16_t* P; const float* rowsq; float eps; PG8_LAS float* X;
    __device__ __forceinline__ void operator()(const f32x4 (&acc)[2][2][4][2], const Unit& u, int wr, int wc, int fr_, int fq_) const {
        int fr = fr_, fq = fq_; asm volatile("" : "+v"(fr), "+v"(fq));
#pragma unroll
        for (int ai = 0; ai < 2; ++ai)
#pragma unroll
            for (int m = 0; m < 4; ++m) { const int rl = ai * HALF + wr * 64 + m * 16 + fr; const float rs = __builtin_amdgcn_rsqf(rowsq[u.pm * BM + rl] * (1.0f / 1024.0f) + eps);
                float mx = -3.0e38f;
#pragma unroll
                for (int bj = 0; bj < 2; ++bj)
#pragma unroll
                    for (int n = 0; n < 2; ++n)
#pragma unroll
                        for (int j = 0; j < 4; ++j) mx = fmaxf(mx, acc[ai][bj][m][n][j] * rs);
                mx = fmaxf(mx, __shfl_xor(mx, 16)); mx = fmaxf(mx, __shfl_xor(mx, 32));
                float s = 0.f;
#pragma unroll
                for (int bj = 0; bj < 2; ++bj)
#pragma unroll
                    for (int n = 0; n < 2; ++n)
#pragma unroll
                        for (int j = 0; j < 4; ++j) s += __builtin_amdgcn_exp2f(acc[ai][bj][m][n][j] * rs - mx);
                s += __shfl_xor(s, 16); s += __shfl_xor(s, 32);
                if (fq == 0) { X[(rl * 4 + wc) * 2] = mx; X[(rl * 4 + wc) * 2 + 1] = s; } }
        asm volatile("s_waitcnt lgkmcnt(0)" ::: "memory"); __builtin_amdgcn_s_barrier(); asm volatile("" ::: "memory");
        const int col0 = (u.pn & 3) * BM + wc * 32 + 8 * fq;
#pragma unroll
        for (int ai = 0; ai < 2; ++ai)
#pragma unroll
            for (int m = 0; m < 4; ++m) { const int rl = ai * HALF + wr * 64 + m * 16 + fr; const float rs = __builtin_amdgcn_rsqf(rowsq[u.pm * BM + rl] * (1.0f / 1024.0f) + eps);
                const f32x4 xa = *(const PG8_LAS f32x4*)(X + rl * 8), xb = *(const PG8_LAS f32x4*)(X + rl * 8 + 4);
                const float M = fmaxf(fmaxf(xa[0], xa[2]), fmaxf(xb[0], xb[2]));
                const float S = xa[1] * __builtin_amdgcn_exp2f(xa[0] - M) + xa[3] * __builtin_amdgcn_exp2f(xa[2] - M) + xb[1] * __builtin_amdgcn_exp2f(xb[0] - M) + xb[3] * __builtin_amdgcn_exp2f(xb[2] - M);
                const float inv = __builtin_amdgcn_rcpf(S); bf16_t* op = P + (size_t)(u.pm * BM + rl) * 1024 + col0;
#pragma unroll
                for (int bj = 0; bj < 2; ++bj) { f32x4 p0, p1;
#pragma unroll
                    for (int j = 0; j < 4; ++j) { p0[j] = __builtin_amdgcn_exp2f(acc[ai][bj][m][0][j] * rs - M) * inv; p1[j] = __builtin_amdgcn_exp2f(acc[ai][bj][m][1][j] * rs - M) * inv; }
                    *(u32x4*)(op + bj * HALF) = pack8(p0, p1); } }
        asm volatile("s_waitcnt lgkmcnt(0)" ::: "memory"); __builtin_amdgcn_s_barrier(); asm volatile("" ::: "memory");
    }
};
template <class Epi, class Sched, bool ALIGN_EPI = false, bool SP2 = false, bool GATHER = false>
__device__ __forceinline__ void gemm_phase(PG8_LAS unsigned char* lds, const Gemm g, const Sched& S, const Epi& E, int wave_) {
    int lane; asm volatile("v_mbcnt_lo_u32_b32 %0, -1, 0\n\tv_mbcnt_hi_u32_b32 %0, -1, %0" : "=v"(lane));
    const int wid = __builtin_amdgcn_readfirstlane(wave_), tid = wid * 64 + lane, wr = wid >> 2, wc = wid & 3, fr = lane & 15, fq = lane >> 4;
    const int K = g.K, nt = K / BK;
    unsigned voffA[2], voffB[2];
#pragma unroll
    for (int i = 0; i < 2; ++i) { int R, C; stage_rc(tid * 16 + i * 8192, R, C); const int Rb = Epi::PERM ? ((R & ~31) + perm32(R & 31)) : R;
        voffA[i] = (unsigned)(R * K + C) * 2u; voffB[i] = (unsigned)(Rb * K + C) * 2u; }
    unsigned cvo[2][2];
    PG8_LAS unsigned* gsl = (PG8_LAS unsigned*)(lds + STAGE_BYTES + 1024) + tid * 4;
#define PG8_GOFF(dst, un) do { _Pragma("unroll") for (int _h = 0; _h < 2; ++_h) _Pragma("unroll") for (int _i = 0; _i < 2; ++_i) { int R_, C_; stage_rc(tid * 16 + _i * 8192, R_, C_); \
        dst[_h][_i] = (unsigned)(S.arow(un, 128 * _h + R_) * K + C_) * 2u; } } while (0)
#define PG8_STAGE_A(bufoff, base, h, nsel) do { if constexpr (GATHER) { PG8_STAGE(bufoff, base, cvo[h]); } else { PG8_STAGE(bufoff, (base) + (h) * hstep, voffA); } } while (0)
    const size_t kstep = (size_t)(BK * 2);
    const size_t hstep = (size_t)HALF * K * 2;
    const size_t tstep = 2 * hstep;
    const unsigned ldsw = (unsigned)wid * 1024u;
    const int aoff = lds_byte(wr * 64 + fr, fq * 8), boff = lds_byte(wc * 32 + fr, fq * 8);
#define PG8_SA(b, h) (((b) * 2 + (h)) * HTB)
#define PG8_SB(b, h) ((4 + (b) * 2 + (h)) * HTB)
#define PG8_STAGE(bufoff, gbase, voff) do { _Pragma("unroll") for (int _i = 0; _i < 2; ++_i) \
        __builtin_amdgcn_global_load_lds((const unsigned*)((const char*)(gbase) + (voff)[_i]), (PG8_LAS unsigned*)(lds + (bufoff) + ldsw + _i * 8192), 16, 0, 0); } while (0)
#define PG8_LDA(dst, b, h) do { _Pragma("unroll") for (int m = 0; m < 4; ++m) _Pragma("unroll") for (int k = 0; k < 2; ++k) dst[m][k] = *(const PG8_LAS bf16x8*)(lds + PG8_SA(b, h) + aoff + m * 2048 + k * 1024); } while (0)
#define PG8_LDB(dst, b, h) do { _Pragma("unroll") for (int n = 0; n < 2; ++n) _Pragma("unroll") for (int k = 0; k < 2; ++k) dst[n][k] = *(const PG8_LAS bf16x8*)(lds + PG8_SB(b, h) + boff + n * 2048 + k * 1024); } while (0)
#define PG8_MMA(ai, bj, At, Bt) do { __builtin_amdgcn_s_setprio(1); _Pragma("unroll") for (int m = 0; m < 4; ++m) _Pragma("unroll") for (int n = 0; n < 2; ++n) _Pragma("unroll") for (int k = 0; k < 2; ++k) \
        acc[ai][bj][m][n] = __builtin_amdgcn_mfma_f32_16x16x32_bf16(Bt[n][k], At[m][k], acc[ai][bj][m][n], 0, 0, 0); __builtin_amdgcn_s_setprio(0); } while (0)
#define PG8_WAIT_V(n) asm volatile("s_waitcnt vmcnt(" #n ")" ::: "memory")
#define PG8_WAIT_L(n) asm volatile("s_waitcnt lgkmcnt(" #n ")" ::: "memory")
#define PG8_BAR __builtin_amdgcn_s_barrier()
#define PG8_SCHED __builtin_amdgcn_sched_barrier(0)
    Unit cur, nxt; int ui = 0;
    if (!S.next(0, cur)) return;
    f32x4 acc[2][2][4][2];
#pragma unroll
    for (int a = 0; a < 2; ++a)
#pragma unroll
        for (int b = 0; b < 2; ++b)
#pragma unroll
            for (int m = 0; m < 4; ++m)
#pragma unroll
                for (int n = 0; n < 2; ++n) acc[a][b][m][n] = (f32x4){0.f, 0.f, 0.f, 0.f};
    bf16x8 At[4][2], B0[2][2], B1[2][2];
    const char* cA = (const char*)g.A + (GATHER ? (size_t)0 : (size_t)cur.pm * tstep); const char* cB = (const char*)g.Bt + (size_t)cur.pn * tstep;
    if constexpr (GATHER) { PG8_GOFF(cvo, cur); }
    S.a_ready(cur);
    if constexpr (SP2) {
        PG8_STAGE(PG8_SB(0, 0), cB, voffB); PG8_STAGE(PG8_SB(0, 1), cB + hstep, voffB); PG8_STAGE_A(PG8_SA(0, 0), cA, 0, false); PG8_STAGE_A(PG8_SA(0, 1), cA, 1, false);
        if (wr == 1) PG8_BAR;
        PG8_WAIT_V(2); PG8_BAR;
        PG8_STAGE(PG8_SB(1, 0), cB + kstep, voffB); PG8_STAGE_A(PG8_SA(1, 0), cA + kstep, 0, false); PG8_STAGE(PG8_SB(1, 1), cB + hstep + kstep, voffB);
        PG8_WAIT_V(6); PG8_BAR;
    } else {
        PG8_STAGE(PG8_SB(0, 0), cB, voffB); PG8_STAGE(PG8_SA(0, 0), cA, voffA); PG8_STAGE(PG8_SB(0, 1), cB + hstep, voffB); PG8_STAGE(PG8_SA(0, 1), cA + hstep, voffA);
        if (wr == 1) PG8_BAR;
        PG8_WAIT_V(4); PG8_BAR;
        PG8_STAGE(PG8_SB(1, 0), cB + kstep, voffB); PG8_STAGE(PG8_SA(1, 0), cA + kstep, voffA); PG8_STAGE(PG8_SB(1, 1), cB + hstep + kstep, voffB);
        PG8_WAIT_V(6); PG8_BAR;
    }
    for (;;) {
        const bool has_next = S.next(ui + 1, nxt);
        if constexpr (GATHER) { unsigned nvo_[2][2]; if (has_next) { PG8_GOFF(nvo_, nxt); } else { _Pragma("unroll") for (int _h = 0; _h < 2; ++_h) _Pragma("unroll") for (int _i = 0; _i < 2; ++_i) nvo_[_h][_i] = cvo[_h][_i]; }
            *(PG8_LAS u32x4*)gsl = (u32x4){nvo_[0][0], nvo_[0][1], nvo_[1][0], nvo_[1][1]}; }
        const char* nA = GATHER ? cA : (has_next ? (const char*)g.A + (size_t)nxt.pm * tstep : cA); const char* nB = has_next ? (const char*)g.Bt + (size_t)nxt.pn * tstep : cB;
        for (int t = 0; t < nt; t += 2) {
            const bool last = (t == nt - 2);
            const char* a1 = cA + (size_t)(t + 1) * kstep;
            const char* a2 = last ? nA : cA + (size_t)(t + 2) * kstep; const char* b2 = last ? nB : cB + (size_t)(t + 2) * kstep;
            const char* a3 = a2 + kstep; const char* b3 = b2 + kstep;
            if (last && has_next) S.a_ready(nxt);
            if constexpr (SP2) {
            PG8_LDB(B0, 0, 0); PG8_LDB(B1, 0, 1); PG8_SCHED; PG8_LDA(At, 0, 0); PG8_STAGE_A(PG8_SA(1, 1), a1, 1, false);
            if constexpr (GATHER) { if (last) { const u32x4 nv_ = *(const PG8_LAS u32x4*)gsl; cvo[0][0] = nv_.x; cvo[0][1] = nv_.y; cvo[1][0] = nv_.z; cvo[1][1] = nv_.w; } }
            PG8_WAIT_V(8); PG8_WAIT_L(0); PG8_BAR; PG8_MMA(0, 0, At, B0); PG8_MMA(0, 1, At, B1); PG8_BAR; PG8_SCHED;
            PG8_LDA(At, 0, 1); PG8_STAGE(PG8_SB(0, 0), b2, voffB); PG8_STAGE(PG8_SB(0, 1), b2 + hstep, voffB); PG8_STAGE_A(PG8_SA(0, 0), a2, 0, last);
            PG8_WAIT_V(8); PG8_WAIT_L(0); PG8_BAR; PG8_MMA(1, 0, At, B0); PG8_MMA(1, 1, At, B1); PG8_BAR; PG8_SCHED;
            PG8_LDB(B0, 1, 0); PG8_LDB(B1, 1, 1); PG8_SCHED; PG8_LDA(At, 1, 0); PG8_STAGE_A(PG8_SA(0, 1), a2, 1, last);
            PG8_WAIT_V(8); PG8_WAIT_L(0); PG8_BAR; PG8_MMA(0, 0, At, B0); PG8_MMA(0, 1, At, B1); PG8_BAR; PG8_SCHED;
            PG8_LDA(At, 1, 1); PG8_STAGE(PG8_SB(1, 0), b3, voffB); PG8_STAGE(PG8_SB(1, 1), b3 + hstep, voffB); PG8_STAGE_A(PG8_SA(1, 0), a3, 0, last);
            PG8_WAIT_V(8); PG8_WAIT_L(0); PG8_BAR; PG8_MMA(1, 0, At, B0); PG8_MMA(1, 1, At, B1); PG8_BAR; PG8_SCHED;
            } else {
            PG8_LDB(B0, 0, 0); PG8_SCHED; PG8_LDA(At, 0, 0); PG8_STAGE(PG8_SA(1, 1), a1 + hstep, voffA);
            PG8_WAIT_L(8); PG8_BAR; PG8_WAIT_L(0); PG8_MMA(0, 0, At, B0); PG8_BAR; PG8_SCHED;
            PG8_LDB(B1, 0, 1); PG8_STAGE(PG8_SB(0, 0), b2, voffB);
            PG8_BAR; PG8_WAIT_L(0); PG8_MMA(0, 1, At, B1); PG8_BAR;
            PG8_LDA(At, 0, 1); PG8_STAGE(PG8_SA(0, 0), a2, voffA);
            PG8_BAR; PG8_WAIT_L(0); PG8_MMA(1, 0, At, B0); PG8_BAR; PG8_SCHED;
            PG8_STAGE(PG8_SB(0, 1), b2 + hstep, voffB);
            PG8_WAIT_V(6); PG8_BAR; PG8_MMA(1, 1, At, B1); PG8_BAR;
            PG8_LDB(B0, 1, 0); PG8_SCHED; PG8_LDA(At, 1, 0); PG8_STAGE(PG8_SA(0, 1), a2 + hstep, voffA);
            PG8_WAIT_L(8); PG8_BAR; PG8_WAIT_L(0); PG8_MMA(0, 0, At, B0); PG8_BAR; PG8_SCHED;
            PG8_LDB(B1, 1, 1); PG8_STAGE(PG8_SB(1, 0), b3, voffB);
            PG8_BAR; PG8_WAIT_L(0); PG8_MMA(0, 1, At, B1); PG8_BAR;
            PG8_LDA(At, 1, 1); PG8_STAGE(PG8_SA(1, 0), a3, voffA);
            PG8_BAR; PG8_WAIT_L(0); PG8_MMA(1, 0, At, B0); PG8_BAR; PG8_SCHED;
            PG8_STAGE(PG8_SB(1, 1), b3 + hstep, voffB);
            PG8_WAIT_V(6); PG8_BAR; PG8_MMA(1, 1, At, B1); PG8_BAR;
            }
        }
        if constexpr (ALIGN_EPI) { if (wr == 0) PG8_BAR; }
        if constexpr (!Epi::AFTER_DRAIN) { int ln_; asm volatile("v_mbcnt_lo_u32_b32 %0, -1, 0\n\tv_mbcnt_hi_u32_b32 %0, -1, %0" : "=v"(ln_)); E(acc, cur, wr, wc, ln_ & 15, ln_ >> 4); S.done(cur); }
        if (!has_next) break;
#pragma unroll
        for (int a = 0; a < 2; ++a)
#pragma unroll
            for (int b = 0; b < 2; ++b)
#pragma unroll
                for (int m = 0; m < 4; ++m)
#pragma unroll
                    for (int n = 0; n < 2; ++n) acc[a][b][m][n] = (f32x4){0.f, 0.f, 0.f, 0.f};
        cur = nxt; cA = nA; cB = nB; ++ui;

        if constexpr (ALIGN_EPI) { if (wr == 1) PG8_BAR; }
    }
    PG8_WAIT_V(0);
    if constexpr (!ALIGN_EPI) { if (wr == 0) PG8_BAR; }
    PG8_BAR;
    if constexpr (Epi::AFTER_DRAIN) { E.fused(acc, cur, wr, wc, fr, fq, lds, wid, lane); S.done(cur); }
#undef PG8_SA
#undef PG8_SB
#undef PG8_STAGE
#undef PG8_STAGE_A
#undef PG8_GOFF
#undef PG8_LDA
#undef PG8_LDB
#undef PG8_MMA
#undef PG8_WAIT_V
#undef PG8_WAIT_L
#undef PG8_BAR
#undef PG8_SCHED
}
}
#ifndef PG8_SP2
#define PG8_SP2 true
#endif
#ifndef PG8_ALIGN
#define PG8_ALIGN true
#endif
template <int BIT> __device__ __forceinline__ unsigned mbfe(unsigned mw) { unsigned m; asm("v_bfe_i32 %0, %1, %2, 1" : "=v"(m) : "v"(mw), "n"(BIT)); return m; }
namespace attn_body {
using bf16=__hip_bfloat16;
using bf16x8=__attribute__((ext_vector_type(8)))short;
using s16x4=__attribute__((ext_vector_type(4)))short;
using f32x16=__attribute__((ext_vector_type(16)))float;
using u32x4=__attribute__((ext_vector_type(4)))unsigned;
constexpr int BATCH=8,NHEAD=8,SEQ=4096,D=64,DM=NHEAD*D;
constexpr int NW=8,QBLK=32,QB=QBLK*NW,KVBLK=64,NQB=SEQ/QB;
constexpr int ATTN_PITCH=DM, ATTN_UNIT_ROWS=QB;
__device__ __forceinline__ int crow(int r,int hi){return (r&3)+8*(r>>2)+4*hi;}
#define SBAR() __builtin_amdgcn_sched_barrier(0)
__device__ __forceinline__ void cmask(f32x16&p0,f32x16&p1,int jb,int qrel,int hi){
  const float NEG=-INFINITY; int kb=64*jb+4*hi;
  #pragma unroll
  for(int r=0;r<16;++r){int kv=kb+(r&3)+8*(r>>2); if(kv>qrel)p0[r]=NEG; if(kv+32>qrel)p1[r]=NEG;}
}

constexpr int NSLOT=3, SLOTB=8192;
constexpr int LDS_K=0, LDS_V=NSLOT*SLOTB, LDS_WS=2*NSLOT*SLOTB, LDS_OST=LDS_WS+NW*64*4, LDS_BYTES=LDS_OST+NW*4096;
constexpr float C2=0.125f*1.4426950408889634f;
__device__ __forceinline__ void glds16(const void*gsrc,unsigned lds_dst){unsigned keep;
  asm volatile("s_mov_b32 %0, m0\n\ts_mov_b32 m0, %2\n\ts_nop 0\n\tglobal_load_lds_dwordx4 %1, off\n\ts_mov_b32 m0, %0":"=&s"(keep):"v"(gsrc),"s"(lds_dst):"memory");}
__device__ __forceinline__ float max3f(float a,float b,float c){float r;asm("v_max3_f32 %0, %1, %2, %3":"=v"(r):"v"(a),"v"(b),"v"(c));return r;}
__device__ __forceinline__ float max2f(float a,float b){float r;asm("v_max_f32_e32 %0, %1, %2":"=v"(r):"v"(a),"v"(b));return r;}
__device__ __forceinline__ float fadd_s(float a,float b){float r;asm("v_add_f32_e32 %0, %1, %2":"=v"(r):"v"(a),"v"(b));return r;}
__device__ __forceinline__ float fsub_s(float a,float b){float r;asm("v_sub_f32_e32 %0, %1, %2":"=v"(r):"v"(a),"v"(b));return r;}
typedef float f32x2_t __attribute__((ext_vector_type(2))); typedef __bf16 bf16x2_t __attribute__((ext_vector_type(2)));
__device__ __forceinline__ unsigned cvtpk_s(float lo,float hi){f32x2_t v={lo,hi};bf16x2_t b=__builtin_convertvector(v,bf16x2_t);return __builtin_bit_cast(unsigned,b);}
#define WAIT_BAR(N) asm volatile("s_waitcnt vmcnt(" #N ") lgkmcnt(0)\n\ts_barrier":::"memory")

__device__ __forceinline__ void qkt(f32x16&p0,f32x16&p1,const char*Kslot,const bf16x8*qr,const f32x16&negm,int r32,int hi){
  const char*kb=Kslot+hi*1024+r32*16;
  #pragma unroll
  for(int d0=0;d0<4;++d0){
    const bf16x8 b0=*reinterpret_cast<const bf16x8*>(kb+d0*2048);
    const bf16x8 b1=*reinterpret_cast<const bf16x8*>(kb+d0*2048+512);
    if(d0==0){p0=__builtin_amdgcn_mfma_f32_32x32x16_bf16(b0,qr[0],negm,0,0,0);p1=__builtin_amdgcn_mfma_f32_32x32x16_bf16(b1,qr[0],negm,0,0,0);}
    else{p0=__builtin_amdgcn_mfma_f32_32x32x16_bf16(b0,qr[d0],p0,0,0,0);p1=__builtin_amdgcn_mfma_f32_32x32x16_bf16(b1,qr[d0],p1,0,0,0);}}
}
typedef __attribute__((address_space(3))) const char* lds_cptr;
typedef short v4i16_t __attribute__((ext_vector_type(4)));
__device__ __forceinline__ void kload8(bf16x8*kf,lds_cptr kp){
  kf[0]=*(const __attribute__((address_space(3))) bf16x8*)(kp);      kf[1]=*(const __attribute__((address_space(3))) bf16x8*)(kp+512);
  kf[2]=*(const __attribute__((address_space(3))) bf16x8*)(kp+2048); kf[3]=*(const __attribute__((address_space(3))) bf16x8*)(kp+2560);
  kf[4]=*(const __attribute__((address_space(3))) bf16x8*)(kp+4096); kf[5]=*(const __attribute__((address_space(3))) bf16x8*)(kp+4608);
  kf[6]=*(const __attribute__((address_space(3))) bf16x8*)(kp+6144); kf[7]=*(const __attribute__((address_space(3))) bf16x8*)(kp+6656);
}
__device__ __forceinline__ void kload2(bf16x8*kf,lds_cptr kp,int j){ kf[2*j]=*(const __attribute__((address_space(3))) bf16x8*)(kp+j*2048); kf[2*j+1]=*(const __attribute__((address_space(3))) bf16x8*)(kp+j*2048+512); }
__device__ __forceinline__ s16x4 vtr(lds_cptr p){ return __builtin_bit_cast(s16x4,__builtin_amdgcn_ds_read_tr16_b64_v4i16((__attribute__((address_space(3))) v4i16_t*)p)); }
__device__ __forceinline__ float rowmax(const f32x16&p0,const f32x16&p1){
  float a=max3f(p0[0],p0[1],p1[0]),b=max3f(p0[2],p0[3],p1[1]);a=max3f(a,p1[2],p1[3]);
  #pragma unroll
  for(int r=4;r<16;r+=4){a=max3f(a,p0[r],p0[r+1]);b=max3f(b,p0[r+2],p0[r+3]);a=max3f(a,p1[r],p1[r+1]);b=max3f(b,p1[r+2],p1[r+3]);}
  const float m=max2f(a,b);
  auto rr=__builtin_amdgcn_permlane32_swap(__float_as_uint(m),__float_as_uint(m),false,false);
  return max2f(__uint_as_float(rr[0]),__uint_as_float(rr[1]));
}
__device__ __forceinline__ void pv(f32x16*o,int vb,bf16x8 pa0,bf16x8 pa1,bf16x8 pa2,bf16x8 pa3){
  #pragma unroll
  for(int d0=0;d0<2;++d0){s16x4 lo[4],hi[4];
    #pragma unroll
    for(int ks=0;ks<4;++ks){
      asm volatile("ds_read_b64_tr_b16 %0,%1 offset:%c2":"=&v"(lo[ks]):"v"(vb),"i"(d0*4096+ks*1024):"memory");
      asm volatile("ds_read_b64_tr_b16 %0,%1 offset:%c2":"=&v"(hi[ks]):"v"(vb),"i"(d0*4096+ks*1024+512):"memory");}
    asm volatile("s_waitcnt lgkmcnt(0)":::"memory");SBAR();
    #define PK(k) (bf16x8){lo[k][0],lo[k][1],lo[k][2],lo[k][3],hi[k][0],hi[k][1],hi[k][2],hi[k][3]}
    o[d0]=__builtin_amdgcn_mfma_f32_32x32x16_bf16(pa0,PK(0),o[d0],0,0,0);
    o[d0]=__builtin_amdgcn_mfma_f32_32x32x16_bf16(pa1,PK(1),o[d0],0,0,0);
    o[d0]=__builtin_amdgcn_mfma_f32_32x32x16_bf16(pa2,PK(2),o[d0],0,0,0);
    o[d0]=__builtin_amdgcn_mfma_f32_32x32x16_bf16(pa3,PK(3),o[d0],0,0,0);
    #undef PK
  }
}

#ifndef ATTN_STORE16
#define ATTN_STORE16(p,v) do{ if(!dry) *(u32x4*)(p)=(v); }while(0)
#endif
template<int THRL> __device__ __forceinline__ void attn_unit(int b,int h,int qb,const bf16*Q,const bf16*__restrict__ K,const bf16*__restrict__ V,bf16*O,const uint2*MaskBase,char*shm,bool dry,int wave_){
  int lane; asm volatile("v_mbcnt_lo_u32_b32 %0, -1, 0\n\tv_mbcnt_hi_u32_b32 %0, -1, %0" : "=v"(lane)); const int wid=__builtin_amdgcn_readfirstlane(wave_),tid=wid*64+lane,r32=lane&31,hi=lane>>5;
  const long rowbase=(long)b*SEQ; const int q0=qb*QB;
  const bf16*Qw=Q+(rowbase+q0+wid*QBLK)*DM+h*D;
  const bf16*Kh=K+rowbase*DM+h*D,*Vh=V+rowbase*DM+h*D;
  const unsigned lds0=(unsigned)(uintptr_t)shm;
  float*wsf=(float*)(shm+LDS_WS)+wid*64;
  const bf16*ksrc=Kh+(long)lane*DM+wid*8;
  const bf16*vsrc=Vh+(long)(16*(wid&3)+(lane>>2))*DM+(wid>>2)*32+(lane&3)*8;
  const unsigned kdst=lds0+LDS_K+wid*1024, vdst=lds0+LDS_V+wid*1024;
  #define DMA_K(t,slot) glds16(ksrc+(long)(t)*KVBLK*DM,(unsigned)__builtin_amdgcn_readfirstlane(kdst+(slot)))
  #define DMA_V(t,slot) glds16(vsrc+(long)(t)*KVBLK*DM,(unsigned)__builtin_amdgcn_readfirstlane(vdst+(slot)))
  const int vb0=(int)(lds0+LDS_V)+((lane>>4)&1)*32+(lane&3)*8+(4*hi+((lane&15)>>2))*64;
  const char*Kbase=shm+LDS_K; bf16x8 kf[8];
  const lds_cptr shm3=(lds_cptr)shm; const lds_cptr kp0=shm3+LDS_K+hi*1024+r32*16; const lds_cptr vp0=shm3+LDS_V+((lane>>4)&1)*32+(lane&3)*8+(4*hi+((lane&15)>>2))*64;
  const int NT=(q0+QB)/KVBLK;
  DMA_K(0,0);DMA_V(0,0);DMA_K(1,SLOTB);
  bf16x8 qr[4];
  #pragma unroll
  for(int d0=0;d0<4;++d0)qr[d0]=*reinterpret_cast<const bf16x8*>(&Qw[(long)r32*DM+d0*16+hi*8]);
  float mhat=0.f,l_reg=0.f;f32x16 o[2];o[0]=f32x16{};o[1]=f32x16{};f32x16 negm=f32x16{};asm volatile("":"+v"(negm));
  const int qrel=wid*QBLK+r32;
  const uint2*mrow=MaskBase+((size_t)(rowbase+q0+qrel))*64;
  const int sh4=4*hi; uint2 mraw=mrow[0]; unsigned mw0=mraw.x>>sh4, mw1=mraw.y>>sh4; mraw=mrow[1]; unsigned mwc0=mraw.x>>sh4, mwc1=mraw.y>>sh4, mwn0=mwc0, mwn1=mwc1;
  #define MSKB(v,mw,bit) __uint_as_float(__float_as_uint(v)&mbfe<(bit)>(mw))
  #define MSKV(v,mw,bit) __uint_as_float(__float_as_uint(v)&(unsigned)(((int)((mw)<<(31-(bit))))>>31))
  #define MBIT(r) (((r)&3)+8*((r)>>2))
  #define MCONV() do{ asm volatile("" : "+v"(mraw)); mwc0=mraw.x>>sh4; mwc1=mraw.y>>sh4; }while(0)
  #define CMASK(P0,P1,t) do{}while(0)
  bool resc=false;
  #define START(P0,P1) do{ const float rm=rowmax(P0,P1); resc=false; \
    { const float dl=rm; mhat=fadd_s(mhat,dl); \
      _Pragma("unroll") for(int r=0;r<16;++r){P0[r]=fsub_s(P0[r],dl);P1[r]=fsub_s(P1[r],dl);} \
      _Pragma("unroll") for(int r=0;r<16;++r)negm[r]=-mhat; asm volatile("":"+v"(negm)); } \
    _Pragma("unroll") for(int r=0;r<16;++r)P0[r]=MSKV(__builtin_amdgcn_exp2f(P0[r]),mw0,MBIT(r)); }while(0)
  #define RESC() do{ if(resc){ asm volatile("s_waitcnt lgkmcnt(0)":::"memory"); \
      _Pragma("unroll") for(int d_=0;d_<2;++d_) _Pragma("unroll") for(int r=0;r<16;++r)o[d_][r]*=wsf[crow(r,hi)]; } }while(0)
  f32x16 pA0,pA1,pB0,pB1;
  int sl_prev=0,sl_cur=0,sl_next=SLOTB;
  #define ROT() do{sl_prev=sl_cur;sl_cur=sl_next;sl_next=(sl_next==(NSLOT-1)*SLOTB)?0:sl_next+SLOTB;}while(0)
  DMA_K(2,2*SLOTB);
  WAIT_BAR(3);
  qkt(pA0,pA1,Kbase,qr,negm,r32,hi);asm volatile("s_nop 15\n\ts_nop 7":"+v"(pA0),"+v"(pA1));CMASK(pA0,pA1,0);
  START(pA0,pA1);
  _Pragma("unroll") for(int r=0;r<16;++r)pA1[r]=MSKV(__builtin_amdgcn_exp2f(pA1[r]),mw1,MBIT(r));
  WAIT_BAR(0);
  DMA_K(3,0);DMA_V(1,SLOTB);
  ROT();
  kload8(kf,kp0+sl_cur);
  WAIT_BAR(2);
  s16x4 vlo[8],vhi[8]; u32x4 pw0,pw1,pw2,pw3;
  #define PKW(P,B) cvtpk_s(P[B],P[B+1])
  #define PAF(k) __builtin_bit_cast(bf16x8,pw##k)
  #define VFR(i) (bf16x8){vlo[i][0],vlo[i][1],vlo[i][2],vlo[i][3],vhi[i][0],vhi[i][1],vhi[i][2],vhi[i][3]}
  #define PIN(x) asm volatile("":"+v"(x))
  #define MX3(a,b,c) __builtin_fmaxf(__builtin_fmaxf((a),(b)),(c))
  #define GAPA(MF,A0,A1,A2,A3,W0,W1,PW) do{ MF; sacc+=A0; sacc+=A1; sacc+=A2; sacc+=A3; PIN(sacc); W0; W1; PIN(PW); SBAR(); }while(0)
  #define EX(v) __builtin_amdgcn_exp2f(v)
  #define GAPB(MF,X,B,MW) do{ MF; X[B]=MSKB(EX(X[B]),MW,2*(B)); X[B+1]=MSKB(EX(X[B+1]),MW,2*(B)+1); X[B+2]=MSKB(EX(X[B+2]),MW,2*(B)+2); X[B+3]=MSKB(EX(X[B+3]),MW,2*(B)+3); PIN(X); SBAR(); }while(0)
  #define VRD(i) do{ vlo[i]=vtr(vp_+(((i)>>2)*4096+((i)&3)*1024)); vhi[i]=vtr(vp_+(((i)>>2)*4096+((i)&3)*1024+512)); }while(0)
  #define KRD(G,j) do{ if(G){ kload2(kf,kp0+sl_next,j); SBAR(); } }while(0)
  #define STEP(C0,C1,P0,P1,t,GK,GV,GL,ML) do{ SBAR(); if(ML){ asm volatile("global_load_dwordx2 %0, %1, off" : "=v"(mraw) : "v"(mrow+(t)+1) : "memory"); } \
    const lds_cptr vp_=vp0+sl_prev; \
    VRD(0); SBAR(); float sacc=(P0[0]+P0[1]); \
    GAPA(C0=__builtin_amdgcn_mfma_f32_32x32x16_bf16(kf[0],qr[0],negm,0,0,0), P0[2],P0[3],P0[4],P0[5],     pw0[0]=PKW(P0,0), pw0[1]=PKW(P0,2), pw0); \
    VRD(4); SBAR(); GAPA(C1=__builtin_amdgcn_mfma_f32_32x32x16_bf16(kf[1],qr[0],negm,0,0,0), P0[6],P0[7],P0[8],P0[9],     pw0[2]=PKW(P0,4), pw0[3]=PKW(P0,6), pw0); \
    VRD(1); SBAR(); GAPA(C0=__builtin_amdgcn_mfma_f32_32x32x16_bf16(kf[2],qr[1],C0,0,0,0),   P0[10],P0[11],P0[12],P0[13], pw1[0]=PKW(P0,8), pw1[1]=PKW(P0,10), pw1); \
    VRD(5); SBAR(); GAPA(C1=__builtin_amdgcn_mfma_f32_32x32x16_bf16(kf[3],qr[1],C1,0,0,0),   P0[14],P0[15],P1[0],P1[1],   pw1[2]=PKW(P0,12),pw1[3]=PKW(P0,14), pw1); \
    VRD(2); SBAR(); GAPA(C0=__builtin_amdgcn_mfma_f32_32x32x16_bf16(kf[4],qr[2],C0,0,0,0),   P1[2],P1[3],P1[4],P1[5],     pw2[0]=PKW(P1,0), pw2[1]=PKW(P1,2), pw2); \
    VRD(6); SBAR(); GAPA(C1=__builtin_amdgcn_mfma_f32_32x32x16_bf16(kf[5],qr[2],C1,0,0,0),   P1[6],P1[7],P1[8],P1[9],     pw2[2]=PKW(P1,4), pw2[3]=PKW(P1,6), pw2); \
    VRD(3); SBAR(); GAPA(C0=__builtin_amdgcn_mfma_f32_32x32x16_bf16(kf[6],qr[3],C0,0,0,0),   P1[10],P1[11],P1[12],P1[13], pw3[0]=PKW(P1,8), pw3[1]=PKW(P1,10), pw3); \
    VRD(7); SBAR(); GAPA(C1=__builtin_amdgcn_mfma_f32_32x32x16_bf16(kf[7],qr[3],C1,0,0,0),   P1[14],P1[15],0.f,0.f,       pw3[2]=PKW(P1,12),pw3[3]=PKW(P1,14), pw3); \
    l_reg+=sacc; \
    if(GK){DMA_K((t)+3,sl_cur);} if(GV){DMA_V((t)+1,sl_next);} \
    CMASK(C0,C1,t); \
    { float a=MX3(C0[0],C0[1],C1[0]),b=MX3(C0[2],C0[3],C1[1]); a=MX3(a,C1[2],C1[3]); \
      _Pragma("unroll") for(int r=4;r<16;r+=4){a=MX3(a,C0[r],C0[r+1]);b=MX3(b,C0[r+2],C0[r+3]);a=MX3(a,C1[r],C1[r+1]);b=MX3(b,C1[r+2],C1[r+3]);} \
      float rm=__builtin_fmaxf(a,b); { auto rr=__builtin_amdgcn_permlane32_swap(__float_as_uint(rm),__float_as_uint(rm),false,false); rm=__builtin_fmaxf(__uint_as_float(rr[0]),__uint_as_float(rr[1])); } \
      resc=false; \
      if(__builtin_expect(__any(rm>(float)THRL),0)){ const float dl=__builtin_fmaxf(rm,0.f); mhat+=dl; \
        _Pragma("unroll") for(int r=0;r<16;++r){C0[r]-=dl;C1[r]-=dl;} \
        _Pragma("unroll") for(int r=0;r<16;++r)negm[r]=-mhat; asm volatile("":"+v"(negm)); \
        const float f=__builtin_amdgcn_exp2f(-dl); l_reg*=f; if(hi==0)wsf[r32]=f; resc=true; } } \
    SBAR(); \
    GAPB(o[0]=__builtin_amdgcn_mfma_f32_32x32x16_bf16(PAF(0),VFR(0),o[0],0,0,0), C0,0,mwc0); \
    GAPB(o[1]=__builtin_amdgcn_mfma_f32_32x32x16_bf16(PAF(0),VFR(4),o[1],0,0,0), C0,4,mwc0); \
    KRD(GL,0); GAPB(o[0]=__builtin_amdgcn_mfma_f32_32x32x16_bf16(PAF(1),VFR(1),o[0],0,0,0), C0,8,mwc0); \
    KRD(GL,1); GAPB(o[1]=__builtin_amdgcn_mfma_f32_32x32x16_bf16(PAF(1),VFR(5),o[1],0,0,0), C0,12,mwc0); \
    KRD(GL,2); GAPB(o[0]=__builtin_amdgcn_mfma_f32_32x32x16_bf16(PAF(2),VFR(2),o[0],0,0,0), C1,0,mwc1); \
    KRD(GL,3); GAPB(o[1]=__builtin_amdgcn_mfma_f32_32x32x16_bf16(PAF(2),VFR(6),o[1],0,0,0), C1,4,mwc1); \
    GAPB(o[0]=__builtin_amdgcn_mfma_f32_32x32x16_bf16(PAF(3),VFR(3),o[0],0,0,0), C1,8,mwc1); \
    GAPB(o[1]=__builtin_amdgcn_mfma_f32_32x32x16_bf16(PAF(3),VFR(7),o[1],0,0,0), C1,12,mwc1); \
    }while(0)
  int t=1;
  #undef CMASK
  #define CMASK(P0,P1,t) do{}while(0)
  for(;t+5<NT;t+=2){
    STEP(pB0,pB1,pA0,pA1,t,true,true,true,true);     WAIT_BAR(2); MCONV(); RESC(); ROT();
    STEP(pA0,pA1,pB0,pB1,t+1,true,true,true,true);   WAIT_BAR(2); MCONV(); RESC(); ROT();
  }
  #undef CMASK
  #define CMASK(P0,P1,t) do{}while(0)
  #define ENDW(tt) do{ if((tt)+3<NT){WAIT_BAR(2);} else if((tt)+2<NT){WAIT_BAR(1);} else {WAIT_BAR(0);} }while(0)
  for(;t+1<NT;t+=2){
    STEP(pB0,pB1,pA0,pA1,t,(t+3<NT),(t+1<NT),(t+1<NT),(t+1<NT));       ENDW(t); if(t+1<NT){MCONV();}   RESC(); ROT();
    STEP(pA0,pA1,pB0,pB1,t+1,(t+4<NT),(t+2<NT),(t+2<NT),(t+2<NT));     ENDW(t+1); if(t+2<NT){MCONV();} RESC(); ROT();
  }
  STEP(pB0,pB1,pA0,pA1,NT-1,false,false,false,false); RESC();
  { float sacc=pB0[0]+pB0[1]; _Pragma("unroll") for(int r=2;r<16;++r)sacc+=pB0[r]; _Pragma("unroll") for(int r=0;r<16;++r)sacc+=pB1[r]; l_reg+=sacc;
    pw0=(u32x4){PKW(pB0,0),PKW(pB0,2),PKW(pB0,4),PKW(pB0,6)};pw1=(u32x4){PKW(pB0,8),PKW(pB0,10),PKW(pB0,12),PKW(pB0,14)};pw2=(u32x4){PKW(pB1,0),PKW(pB1,2),PKW(pB1,4),PKW(pB1,6)};pw3=(u32x4){PKW(pB1,8),PKW(pB1,10),PKW(pB1,12),PKW(pB1,14)};
    SBAR(); pv(o,vb0+sl_cur,PAF(0),PAF(1),PAF(2),PAF(3)); }
  #undef PKW
  #undef PAF
  #undef VFR
  #undef PIN
  #undef MX3
  #undef GAPA
  #undef GAPB
  #undef EX
  #undef VRD
  #undef KRD
  #undef STEP
  #undef ENDW
  {auto rr=__builtin_amdgcn_permlane32_swap(__float_as_uint(l_reg),__float_as_uint(l_reg),false,false);l_reg=__uint_as_float(rr[0])+__uint_as_float(rr[1]);}
  if(hi==0)wsf[32+r32]=l_reg;asm volatile("s_waitcnt lgkmcnt(0)":::"memory");
  float rli[16];
  #pragma unroll
  for(int r=0;r<16;++r)rli[r]=__builtin_amdgcn_rcpf(wsf[32+crow(r,hi)]);
  bf16*Ow=O+(rowbase+q0+wid*QBLK)*DM+h*D;
  { bf16*stg=(bf16*)(shm+LDS_OST)+wid*2048;
    #pragma unroll
    for(int r=0;r<16;++r){const int orow=crow(r,hi);
      #pragma unroll
      for(int d0=0;d0<2;++d0)stg[orow*64+d0*32+r32]=__float2bfloat16(o[d0][r]*rli[r]);}
    asm volatile("s_waitcnt lgkmcnt(0)":::"memory");
    #pragma unroll
    for(int i=0;i<4;++i){const int row=i*8+(lane>>3),ch=lane&7; const u32x4 v=*(const u32x4*)(stg+row*64+ch*8); ATTN_STORE16(Ow+(long)row*DM+ch*8,v);} }
  asm volatile("s_waitcnt lgkmcnt(0)\n\ts_barrier":::"memory");
  #undef DMA_K
  #undef DMA_V
  #undef CMASK
  #undef MSKB
  #undef MSKV
  #undef MBIT
  #undef MCONV
  #undef START
  #undef RESC
  #undef ROT
}
constexpr int ATTN_LDS_BYTES=LDS_BYTES;
struct AttnTensors { const bf16* Q; const bf16* K; const bf16* V; bf16* O; const uint2* Mask; };
struct AttnUnit { int bh; int qb; };
struct StaticOrder {
  int vcu;
  __device__ __forceinline__ explicit StaticOrder(int grid,int block):vcu((block%8)*(grid/8)+block/8){}
  __device__ __forceinline__ bool next(int i,AttnUnit&u)const{ if(i>=4)return false; const int s=vcu&3; u.bh=vcu>>2; u.qb=(i==0)?s:(i==1)?7-s:(i==2)?8+s:15-s; return true; }
  __device__ __forceinline__ void a_ready(const AttnUnit&)const{}
  __device__ __forceinline__ void done(const AttnUnit&)const{}
};
template<class Sched,int THRL=8> __device__ __forceinline__ void attn_phase(char*lds,const AttnTensors&T,const Sched&S,int wave_,bool dry=false){
  AttnUnit u;
  for(int i=0;S.next(i,u);++i){ S.a_ready(u); attn_unit<THRL>(u.bh/NHEAD,u.bh%NHEAD,u.qb,T.Q,T.K,T.V,T.O,T.Mask,lds,dry,wave_); S.done(u); }
}
#undef SBAR
#undef WAIT_BAR
}
#define GAS __attribute__((address_space(1)))
#define LAS __attribute__((address_space(3)))
typedef unsigned short bf16;
typedef unsigned v4u __attribute__((ext_vector_type(4)));
typedef float f32x4 __attribute__((ext_vector_type(4)));
typedef short bf16x8 __attribute__((ext_vector_type(8)));
typedef GAS unsigned gu32;
typedef GAS unsigned long long gu64;
#define RLX_AGENT __ATOMIC_RELAXED, __HIP_MEMORY_SCOPE_AGENT
#define LDS_WAIT() asm volatile("s_waitcnt lgkmcnt(0)" ::: "memory")
#define VM_WAIT() asm volatile("s_waitcnt vmcnt(0)" ::: "memory")
__device__ __forceinline__ unsigned long long rt() { return __builtin_amdgcn_s_memrealtime(); }
__device__ __forceinline__ unsigned f2bf(float f) { unsigned u = __builtin_bit_cast(unsigned, f); return (u + 0x7fffu + ((u >> 16) & 1u)) >> 16; }
__device__ __forceinline__ unsigned pk2(float lo, float hi) { return f2bf(lo) | (f2bf(hi) << 16); }

#define XB_TMO      128
#define XB_XCNT(j)  (256  + 64 * (j))
#define XB_XSUB(j)  (1280 + 64 * (j))
#define XB_XGEN(j)  (2304 + 64 * (j))
#define XB_TOP      3328
#define XB_TOPGEN   3392
#define XCD_BAR_WORDS 3456
#define XB_SPIN_CAP (1u << 18)

__device__ __forceinline__ unsigned xb_ld(unsigned* p)              { return __hip_atomic_load(p, __ATOMIC_RELAXED, __HIP_MEMORY_SCOPE_AGENT); }
__device__ __forceinline__ unsigned xb_add(unsigned* p, unsigned v) { return __hip_atomic_fetch_add(p, v, __ATOMIC_RELAXED, __HIP_MEMORY_SCOPE_AGENT); }
__device__ __forceinline__ unsigned xb_xcc_id() { return (unsigned)__builtin_amdgcn_s_getreg((3 << 11) | 20) & 0xFu; }
#define XB_SPIN(cond, bar) do { unsigned _sp = 0; while (cond) { __builtin_amdgcn_s_sleep(1); \
    if ((++_sp & 255u) == 0u) { if (xb_ld(&(bar)[XB_TMO])) break; if (_sp > XB_SPIN_CAP) { atomicAdd(&(bar)[XB_TMO], 1u); break; } } } } while (0)

struct XcdBarrier {
    unsigned* bar; unsigned x; int wave;
    volatile LAS unsigned* st;
};

__device__ __forceinline__ XcdBarrier xcd_barrier_post(unsigned* bar, volatile LAS unsigned* st, int wave) {
    XcdBarrier b; b.bar = bar; b.x = xb_xcc_id(); b.st = st; b.wave = wave;
    if (threadIdx.x == 0) (void)xb_add(&bar[XB_XCNT(b.x)], 1u);
    return b;
}
__device__ __forceinline__ void xcd_barrier_complete(unsigned* bar, unsigned x, unsigned& nloc, unsigned& nx) {
    const unsigned G = gridDim.x * gridDim.y * gridDim.z;
    unsigned sum, cnt, mine, sp = 0u;
    for (;;) {
        sum = 0u; cnt = 0u; mine = 0u;
#pragma unroll
        for (unsigned j = 0; j < 16; ++j) { const unsigned c = xb_ld(&bar[XB_XCNT(j)]); sum += c; cnt += (c > 0u) ? 1u : 0u; mine = (j == x) ? c : mine; }
        if (sum == G) break;
        __builtin_amdgcn_s_sleep(1);
        if ((++sp & 255u) == 0u) { if (xb_ld(&bar[XB_TMO])) break; if (sp > XB_SPIN_CAP) { atomicAdd(&bar[XB_TMO], 1u); break; } }
    }
    nloc = mine > 0u ? mine : 1u; nx = cnt > 0u ? cnt : 1u;
}

__device__ __forceinline__ void xcd_barrier(const XcdBarrier& b) {
    asm volatile("s_waitcnt vmcnt(0)" ::: "memory");
    __syncthreads();
    int xl_; asm volatile("v_mbcnt_lo_u32_b32 %0, -1, 0\n\tv_mbcnt_hi_u32_b32 %0, -1, %0" : "=v"(xl_));
    if (b.wave == 0 && xl_ == 0) {
        unsigned* bar = b.bar;
        __builtin_amdgcn_s_waitcnt(0);
        unsigned nloc = b.st[0], nx = b.st[1];
        if (nloc == 0u) { xcd_barrier_complete(bar, b.x, nloc, nx); b.st[0] = nloc; b.st[1] = nx; }
        const unsigned old = xb_add(&bar[XB_XSUB(b.x)], 1u);
        const unsigned gen = old / nloc;
        if (old + 1u == (gen + 1u) * nloc) {
            __builtin_amdgcn_fence(__ATOMIC_RELEASE, "agent");
            asm volatile("s_waitcnt vmcnt(0)" ::: "memory");
            const unsigned og = xb_add(&bar[XB_TOP], 1u);
            const unsigned tg = og / nx;
            if (og + 1u == (tg + 1u) * nx) xb_add(&bar[XB_TOPGEN], 1u);
            else XB_SPIN(xb_ld(&bar[XB_TOPGEN]) == tg, bar);
            __builtin_amdgcn_fence(__ATOMIC_ACQUIRE, "agent");
            xb_add(&bar[XB_XGEN(b.x)], 1u);
            asm volatile("s_waitcnt vmcnt(0)" ::: "memory");
        } else {
            XB_SPIN(xb_ld(&bar[XB_XGEN(b.x)]) == gen, bar);
            __builtin_amdgcn_fence(__ATOMIC_ACQUIRE, "agent");
            asm volatile("s_waitcnt vmcnt(0)" ::: "memory");
        }
    }
    __syncthreads();
}

constexpr int NWAVES = 8;
constexpr int T = 32768, DM = 1024, SEQ = 4096, NBATCH = 8, NMEM = 256;
constexpr float EPS = 1e-6f;
constexpr int IN_W = 5192;
constexpr int NCLS = 112;
constexpr size_t MiB = 1u << 20;
constexpr size_t WS_CTL = 0, CTL_ZERO_BYTES = 1 * MiB;
constexpr size_t WS_RSTD0 = 1 * MiB, WS_RSTDM = WS_RSTD0 + 131072, WS_TOKC = WS_RSTD0 + 262144;
constexpr size_t WS_ROPE = 3 * MiB;
constexpr size_t WS_W = 11 * MiB;
constexpr size_t W_R = WS_W, W_V = W_R + 3 * MiB, W_G = W_V + 1 * MiB, W_X = W_G + 2 * MiB, W_GT = W_X + MiB / 2, W_OA = W_GT + 4 * MiB, W_CO = W_OA + 1 * MiB,
                 W_OUT = W_CO + 1 * MiB, W_QX = W_OUT + 2 * MiB, W_KVX = W_QX + 2 * MiB, W_OX = W_KVX + 4 * MiB, W_RT = W_OX + 2 * MiB, W_E1 = W_RT + MiB / 2, W_E2 = W_E1 + 32 * MiB, W_END = W_E2 + 16 * MiB;
static_assert(W_END == 82 * MiB, "weights map");
constexpr size_t WS_XB = 82 * MiB;
constexpr size_t WS_Q = 146 * MiB, WS_CA = 178 * MiB;
constexpr size_t WS_K = 210 * MiB, WS_V = 242 * MiB, WS_QI = 274 * MiB, WS_U = 306 * MiB;
constexpr size_t WS_KI = 338 * MiB, WS_WI = 342 * MiB, WS_MASK = 343 * MiB, WS_KX = 359 * MiB, WS_VT = 363 * MiB, WS_MEMB = 367 * MiB, WS_LIST = 371 * MiB, WS_CE = 375 * MiB;
constexpr size_t W_QH = 385 * MiB, W_OH = 387 * MiB;
constexpr size_t WS_KXH = 389 * MiB, WS_VH = 393 * MiB;
constexpr size_t WS_WK = 397 * MiB, WS_VWT = 413 * MiB, WS_END = 429 * MiB;
constexpr size_t WS_HS = 82 * MiB;
constexpr size_t WS_YS = 210 * MiB;
constexpr int CW_TMO = 0, CW_CODE = 1, CW_BAR = 4096, CW_ROWSQ1 = 32768, CW_ROWSQ2 = 65536, CW_CNT = 98304;
constexpr int CW_RDY = 131072, CW_RDYTOT = 196608;
static_assert((CW_CNT + 64 * NCLS) <= CW_RDY && CW_RDY + 64 * 288 <= CW_RDYTOT && (CW_RDYTOT + 128) * 4 <= (int)CTL_ZERO_BYTES, "CTL words inside the memset region");
constexpr int SCR_BYTES = 147456;
constexpr int LDSCTL_OFF = SCR_BYTES, MISC_OFF = LDSCTL_OFF + 320, LDS_BYTES = SCR_BYTES + 4096;


struct Frame {
    LAS unsigned char* lds;
    volatile LAS unsigned* MISC;
    gu32* ctl;
    unsigned char* ws;
    int tid, lane, wave, vcu, G;
    const float* const* in;
    float* out;
};
template <class TT> __device__ __forceinline__ TT* wsp(const Frame& F, size_t off) { return (TT*)(F.ws + off); }
__device__ __forceinline__ float wave_sum(float v) {
#pragma unroll
    for (int o = 1; o < 64; o <<= 1) v += __shfl_xor(v, o);
    return v;
}
__device__ __forceinline__ float bf2f(unsigned short h) { return __builtin_bit_cast(float, (unsigned)h << 16); }

template <class DstFn>
__device__ __forceinline__ void p0_item(const float* W, int N, int n0, int k0, const float* gain, float scale, DstFn dst, LAS float* scr, int lane) {
    f32x4 v[8];
#pragma unroll
    for (int i = 0; i < 8; ++i) v[i] = *(const GAS f32x4*)(W + (size_t)(k0 + 8 * i + (lane >> 3)) * N + n0 + 4 * (lane & 7));
#pragma unroll
    for (int i = 0; i < 8; ++i) { const int kk = 8 * i + (lane >> 3); const float g = gain ? gain[k0 + kk] * scale : scale; LAS float* sp = scr + kk * 33 + 4 * (lane & 7);
        sp[0] = v[i][0] * g; sp[1] = v[i][1] * g; sp[2] = v[i][2] * g; sp[3] = v[i][3] * g; }
    LDS_WAIT(); asm volatile("" ::: "memory");
    const int c = lane & 7;
#pragma unroll
    for (int j = 0; j < 4; ++j) { const int n = (lane >> 3) + 8 * j; const LAS float* s = scr + (8 * c) * 33 + n;
        v4u o; o.x = pk2(s[0 * 33], s[1 * 33]); o.y = pk2(s[2 * 33], s[3 * 33]); o.z = pk2(s[4 * 33], s[5 * 33]); o.w = pk2(s[6 * 33], s[7 * 33]);
        *(GAS v4u*)dst(n, c) = o; }
    LDS_WAIT(); asm volatile("" ::: "memory");
}
#define P0_PLAIN(Wsrc, Nsrc, n0src, Kdim, gainp, scl, WT, row0) do { const int k0_ = 64 * kb; bf16* wt_ = (WT); const int r0_ = (row0); const int Kd_ = (Kdim); \
    p0_item((Wsrc), (Nsrc), (n0src), k0_, (gainp), (scl), [=](int n, int c) { return wt_ + (size_t)(r0_ + n) * Kd_ + k0_ + 8 * c; }, scr, F.lane); } while (0)

__device__ __forceinline__ void p0_prologue(Frame& F) {
    LAS float* scr = (LAS float*)(F.lds + F.wave * 16384);
    const int gw = F.vcu * NWAVES + F.wave, NGW = F.G * NWAVES;
    const float* w_in = F.in[4]; const float* g_mix = F.in[3];
    constexpr int I_QKQ = 16 * 16, I_V = 16 * 16, I_GLU = 16 * 32, I_X = 16 * 3, I_GT = 16 * 64, I_OA = 8 * 32, I_CO = 8 * 32, I_OUT = 16 * 32, I_QX = 16 * 32, I_KVX = 16 * 64, I_OX = 16 * 32,
                  I_EG = 32 * 16 * 8, I_EU = I_EG, I_ED = 32 * 4 * 32;
    constexpr int NITEMS = 3 * I_QKQ + I_V + I_GLU + I_X + I_GT + I_OA + I_CO + I_OUT + I_QX + I_KVX + I_OX + I_EG + I_EU + I_ED;
    constexpr float C2 = 0.125f * 1.4426950408889634f;
    constexpr float CX = 0.0625f * 1.4426950408889634f;
    for (int it = gw; it < NITEMS; it += NGW) {
        int r = it;
        if (r < 3 * I_QKQ) {
            const int t = r / I_QKQ; r -= t * I_QKQ; const int kb = r / 16, nb = r % 16, H = nb >> 1, s = nb & 1;
            const int srcc = (t == 0 ? 0 : (t == 1 ? 512 : 1536)) + nb * 32;
            P0_PLAIN(w_in, IN_W, srcc, 1024, g_mix, (t == 0 ? C2 : 1.0f), wsp<bf16>(F, W_R), t * 512 + 256 * (H >> 2) + 128 * s + 32 * (H & 3)); continue; }
        r -= 3 * I_QKQ;
        if (r < I_V) { const int kb = r / 16, nb = r % 16; P0_PLAIN(w_in, IN_W, 1024 + nb * 32, 1024, g_mix, 1.0f, wsp<bf16>(F, W_V), nb * 32); continue; }
        r -= I_V;
        if (r < I_GLU) { const int kb = r / 32, nb = r % 32, half = nb >> 4, cb = nb & 15;
            P0_PLAIN(w_in, IN_W, 2120 + nb * 32, 1024, g_mix, 1.0f, wsp<bf16>(F, W_G), 256 * (cb >> 2) + 128 * half + 32 * (cb & 3)); continue; }
        r -= I_GLU;
        if (r < I_X) { const int kb = r / 3, nb = r % 3;
            P0_PLAIN(w_in, IN_W, (nb == 0 ? 2048 : (nb == 1 ? 2080 : 2112)), 1024, g_mix, 1.0f, wsp<bf16>(F, W_X), (nb == 0 ? 0 : (nb == 1 ? 128 : 32))); continue; }
        r -= I_X;
        if (r < I_GT) { const int kb = r / 64, nb = r % 64, br = nb >> 5, cb = nb & 31;
            P0_PLAIN(w_in, IN_W, 3144 + nb * 32, 1024, g_mix, 1.0f, wsp<bf16>(F, W_GT), 256 * (cb >> 2) + 128 * br + 32 * (cb & 3)); continue; }
        r -= I_GT;
        if (r < I_OA) { const int kb = r / 32, nb = r % 32; P0_PLAIN(F.in[5], 1024, nb * 32, 512, (const float*)nullptr, 1.0f, wsp<bf16>(F, W_OA), nb * 32); continue; }
        r -= I_OA;
        if (r < I_CO) { const int kb = r / 32, nb = r % 32; P0_PLAIN(F.in[10], 1024, nb * 32, 512, (const float*)nullptr, 1.0f, wsp<bf16>(F, W_CO), nb * 32); continue; }
        r -= I_CO;
        if (r < I_OUT) { const int kb = r / 32, nb = r % 32; P0_PLAIN(F.in[11], 1024, nb * 32, 1024, (const float*)nullptr, 1.0f, wsp<bf16>(F, W_OUT), nb * 32); continue; }
        r -= I_OUT;
        if (r < I_QX) {
            const int kb = r / 32, nb = r % 32, hh = nb >> 3, d0 = (nb & 7) * 32; const float* src = F.in[14]; const float* gx = F.in[12]; bf16* dst = wsp<bf16>(F, W_QH);
            for (int q = 0; q < 4; ++q) { const int k = 64 * kb + 16 * q + (F.lane >> 2), dd = d0 + 8 * (F.lane & 3); const float gsc = gx[k] * CX;
                const f32x4 v0 = *(const GAS f32x4*)(src + (size_t)k * 1024 + hh * 256 + dd), v1 = *(const GAS f32x4*)(src + (size_t)k * 1024 + hh * 256 + dd + 4);
                v4u o; o.x = pk2(v0.x * gsc, v0.y * gsc); o.y = pk2(v0.z * gsc, v0.w * gsc); o.z = pk2(v1.x * gsc, v1.y * gsc); o.w = pk2(v1.z * gsc, v1.w * gsc);
                *(GAS v4u*)(dst + ((size_t)hh * 1024 + k) * 256 + dd) = o; }
            continue; }
        r -= I_QX;
        if (r < I_KVX) { const int kb = r / 64, nb = r % 64; P0_PLAIN(F.in[15], 2048, nb * 32, 1024, F.in[13], 1.0f, wsp<bf16>(F, W_KVX), nb * 32); continue; }
        r -= I_KVX;
        if (r < I_OX) {
            const int hh = r / 128, r2 = r % 128, kb = r2 / 32, nb = r2 % 32;
            P0_PLAIN(F.in[16] + (size_t)hh * 256 * 1024, 1024, nb * 32, 256, (const float*)nullptr, 1.0f, wsp<bf16>(F, W_OH) + (size_t)hh * 1024 * 256, nb * 32); continue; }
        r -= I_OX;
        if (r < I_EG + I_EU) {
            const int ct = r / I_EG; r -= ct * I_EG; const int e = r / 128; r -= e * 128; const int kb = r / 8, nb = r % 8;
            P0_PLAIN((ct == 0 ? F.in[22] : F.in[23]) + (size_t)e * 1024 * 256, 256, nb * 32, 1024, F.in[17], 1.0f, wsp<bf16>(F, W_E1), e * 512 + 256 * (nb >> 2) + 128 * ct + 32 * (nb & 3));
            continue; }
        r -= I_EG + I_EU;
        {
            const int e = r / 128; r -= e * 128; const int kb = r / 32, nb = r % 32;
            P0_PLAIN(F.in[24] + (size_t)e * 256 * 1024, 1024, nb * 32, 256, (const float*)nullptr, 1.0f, wsp<bf16>(F, W_E2), e * 1024 + nb * 32);
        }
    }
    { const float* wrg = F.in[18]; const float* wre = F.in[20]; const float* gm = F.in[17]; bf16* rt_ = wsp<bf16>(F, W_RT);
      for (int i = (F.vcu * NWAVES + F.wave) * 64 + F.lane; i < 36 * 1024; i += NGW * 64) { const int c = i >> 10, k = i & 1023;
          const float v = (c < 4 ? wrg[k * 4 + c] : wre[((size_t)((c - 4) >> 3) * 1024 + k) * 8 + ((c - 4) & 7)]) * gm[k]; rt_[(size_t)c * 1024 + k] = (bf16)f2bf(v); } }
    { const float* x = F.in[0]; bf16* xb = wsp<bf16>(F, WS_XB); float* rstd0 = wsp<float>(F, WS_RSTD0);
      for (int m0 = gw * 4; m0 < T + NBATCH * NMEM; m0 += NGW * 4) {
          f32x4 v[4][4]; float s[4];
#pragma unroll
          for (int q = 0; q < 4; ++q) { const int m = m0 + q; const bool ismem = m >= T; const int mm = ismem ? m - T : m;
              const GAS f32x4* xr = (const GAS f32x4*)((ismem ? F.in[1] : x) + (size_t)mm * DM) + F.lane;
#pragma unroll
              for (int j = 0; j < 4; ++j) v[q][j] = xr[64 * j]; }
#pragma unroll
          for (int q = 0; q < 4; ++q) { s[q] = 0.f;
#pragma unroll
              for (int j = 0; j < 4; ++j) s[q] += (v[q][j].x * v[q][j].x + v[q][j].y * v[q][j].y) + (v[q][j].z * v[q][j].z + v[q][j].w * v[q][j].w); }
#pragma unroll
          for (int o = 1; o < 64; o <<= 1) {
#pragma unroll
              for (int q = 0; q < 4; ++q) s[q] += __shfl_xor(s[q], o); }
#pragma unroll
          for (int q = 0; q < 4; ++q) { const int m = m0 + q; const bool ismem = m >= T; const int mm = ismem ? m - T : m;
              const float rs = 1.0f / sqrtf(s[q] * (1.0f / DM) + EPS);
              GAS unsigned long long* o8 = (GAS unsigned long long*)((ismem ? wsp<bf16>(F, WS_MEMB) : xb) + (size_t)mm * DM) + F.lane;
#pragma unroll
              for (int j = 0; j < 4; ++j) o8[64 * j] = (unsigned long long)pk2(v[q][j].x, v[q][j].y) | ((unsigned long long)pk2(v[q][j].z, v[q][j].w) << 32);
              if (F.lane == 0) { if (ismem) wsp<float>(F, WS_RSTDM)[mm] = rs; else rstd0[mm] = rs; } }
      } }
    { const int* pos = (const int*)F.in[2]; float* rope = wsp<float>(F, WS_ROPE);
      for (int i = (F.vcu * NWAVES + F.wave) * 64 + F.lane; i < T * 32; i += NGW * 64) { const int tok = i >> 5, fi = i & 31;
          double inv = 1.0; const double rr = 0.74989420933245582730;
          for (int q = 0; q < fi; ++q) inv *= rr;
          const float ang = (float)pos[tok] * (float)inv;
          const double a = (double)ang; const double kq = __builtin_rint(a * 0.63661977236758134308);
          const double rd = (a - kq * 1.57079632679489655800) - kq * 6.12323399573676603587e-17;
          const double r2 = rd * rd;
          double sn = rd * (1.0 + r2 * (-1.0 / 6 + r2 * (1.0 / 120 + r2 * (-1.0 / 5040 + r2 * (1.0 / 362880 + r2 * (-1.0 / 39916800 + r2 * (1.0 / 6227020800.0 + r2 * (-1.0 / 1307674368000.0))))))));
          double cs = 1.0 + r2 * (-0.5 + r2 * (1.0 / 24 + r2 * (-1.0 / 720 + r2 * (1.0 / 40320 + r2 * (-1.0 / 3628800 + r2 * (1.0 / 479001600.0 + r2 * (-1.0 / 87178291200.0 + r2 * (1.0 / 20922789888000.0))))))));
          const int qd = ((int)kq) & 3; double c_, s_;
          if (qd == 0) { c_ = cs; s_ = sn; } else if (qd == 1) { c_ = -sn; s_ = cs; } else if (qd == 2) { c_ = -cs; s_ = -sn; } else { c_ = sn; s_ = -cs; }
          rope[(size_t)tok * 64 + fi] = (float)c_; rope[(size_t)tok * 64 + 32 + fi] = (float)s_; } }
}

typedef float f32x16 __attribute__((ext_vector_type(16)));
__device__ __forceinline__ f32x16 mfma32(bf16x8 a, bf16x8 b, f32x16 c) { return __builtin_amdgcn_mfma_f32_32x32x16_bf16(a, b, c, 0, 0, 0); }
__device__ __forceinline__ f32x4 mfma16(bf16x8 a, bf16x8 b, f32x4 c) { return __builtin_amdgcn_mfma_f32_16x16x32_bf16(a, b, c, 0, 0, 0); }
__device__ __forceinline__ int crow32(int r, int hi) { return (r & 3) + 8 * (r >> 2) + 4 * hi; }
#define WG_SYNC() do { asm volatile("s_waitcnt vmcnt(0) lgkmcnt(0)" ::: "memory"); __builtin_amdgcn_s_barrier(); asm volatile("" ::: "memory"); } while (0)

__device__ __forceinline__ float wave_sum_dpp(float v) {
#define DPPF0(v_, ctrl_) __builtin_bit_cast(float, __builtin_amdgcn_update_dpp(0, __builtin_bit_cast(int, v_), ctrl_, 0xF, 0xF, true))
    v += DPPF0(v, 0xB1); v += DPPF0(v, 0x4E); v += DPPF0(v, 0x141); v += DPPF0(v, 0x140);
#undef DPPF0
    const float a = __builtin_bit_cast(float, __builtin_amdgcn_readlane(__builtin_bit_cast(int, v), 0)), b = __builtin_bit_cast(float, __builtin_amdgcn_readlane(__builtin_bit_cast(int, v), 16)),
                cc = __builtin_bit_cast(float, __builtin_amdgcn_readlane(__builtin_bit_cast(int, v), 32)), d = __builtin_bit_cast(float, __builtin_amdgcn_readlane(__builtin_bit_cast(int, v), 48));
    return (a + b) + (cc + d);
}
__device__ __forceinline__ void conv_phase(Frame& F) {
    const bf16* U = wsp<bf16>(F, WS_U); bf16* CA = wsp<bf16>(F, WS_CA);
    const float* cw = F.in[6]; const float* cb = F.in[7]; const float* lg = F.in[8]; const float* lb = F.in[9];
    LAS float* yy = (LAS float*)F.lds;
    const int lane = F.lane, wv = F.wave, c = wv * 64 + lane;
    float w[31];
#pragma unroll
    for (int j = 0; j < 31; ++j) w[j] = cw[j * 512 + c];
    const float bias = cb[c];
    const f32x4 g0 = *(const f32x4*)(lg + 8 * lane), g1 = *(const f32x4*)(lg + 8 * lane + 4), b0 = *(const f32x4*)(lb + 8 * lane), b1 = *(const f32x4*)(lb + 8 * lane + 4);
    for (int unit = F.vcu; unit < T / 128; unit += F.G) {
        const int tok0 = unit * 128, s0 = tok0 & (SEQ - 1);
        float in[62];
#pragma unroll
        for (int t = 0; t < 30; ++t) in[t] = (s0 - 30 + t >= 0) ? bf2f(U[(size_t)(tok0 - 30 + t) * 512 + c]) : 0.f;
        unsigned short nx[32];
#pragma unroll
        for (int t = 0; t < 32; ++t) nx[t] = U[(size_t)(tok0 + t) * 512 + c];
#pragma unroll 1
        for (int sb = 0; sb < 4; ++sb) {
#pragma unroll
            for (int t = 0; t < 32; ++t) in[30 + t] = bf2f(nx[t]);
            { const int sbn = sb < 3 ? sb + 1 : 3; const bf16* up = U + (size_t)(tok0 + 32 * sbn) * 512 + c;
#pragma unroll
              for (int t = 0; t < 32; ++t) nx[t] = up[(size_t)t * 512]; }
#pragma unroll
            for (int t = 0; t < 32; ++t) { float a = bias;
#pragma unroll
                for (int j = 0; j < 31; ++j) a = __builtin_fmaf(w[j], in[t + j], a);
                yy[t * 512 + c] = a; }
#pragma unroll
            for (int t = 0; t < 30; ++t) in[t] = in[32 + t];
            WG_SYNC();
            { f32x4 v0[4], v1[4]; float s[4];
#pragma unroll
              for (int q = 0; q < 4; ++q) { const int t = 4 * wv + q; v0[q] = *(const LAS f32x4*)(yy + t * 512 + 8 * lane); v1[q] = *(const LAS f32x4*)(yy + t * 512 + 8 * lane + 4);
                  s[q] = (v0[q][0] + v0[q][1]) + (v0[q][2] + v0[q][3]) + (v1[q][0] + v1[q][1]) + (v1[q][2] + v1[q][3]); }
#pragma unroll
              for (int q = 0; q < 4; ++q) s[q] = wave_sum_dpp(s[q]);
#pragma unroll
              for (int q = 0; q < 4; ++q) { const float mean = s[q] * (1.0f / 512.0f); v0[q] = v0[q] - mean; v1[q] = v1[q] - mean;
                  s[q] = (v0[q][0] * v0[q][0] + v0[q][1] * v0[q][1]) + (v0[q][2] * v0[q][2] + v0[q][3] * v0[q][3]) + (v1[q][0] * v1[q][0] + v1[q][1] * v1[q][1]) + (v1[q][2] * v1[q][2] + v1[q][3] * v1[q][3]); }
#pragma unroll
              for (int q = 0; q < 4; ++q) s[q] = wave_sum_dpp(s[q]);
#pragma unroll
              for (int q = 0; q < 4; ++q) { const int t = 4 * wv + q; const float rs = 1.0f / sqrtf(s[q] * (1.0f / 512.0f) + EPS);
                  f32x4 a = v0[q] * rs * g0 + b0, b = v1[q] * rs * g1 + b1;
                  a = a * pg8::sigmoid4(a); b = b * pg8::sigmoid4(b);
                  *(GAS pg8::u32x4*)(CA + (size_t)(tok0 + 32 * sb + t) * 512 + 8 * lane) = pg8::pack8(a, b); } }
            WG_SYNC();
        }
    }
}

#define DPPF(v_, ctrl_) __builtin_bit_cast(float, __builtin_amdgcn_update_dpp(0, __builtin_bit_cast(int, v_), ctrl_, 0xF, 0xF, true))
__device__ __forceinline__ float wave_min_dpp(float v) {
    v = fminf(v, DPPF(v, 0xB1)); v = fminf(v, DPPF(v, 0x4E)); v = fminf(v, DPPF(v, 0x141)); v = fminf(v, DPPF(v, 0x140));
    const float a = __builtin_bit_cast(float, __builtin_amdgcn_readlane(__builtin_bit_cast(int, v), 0)), b = __builtin_bit_cast(float, __builtin_amdgcn_readlane(__builtin_bit_cast(int, v), 16)),
                cc = __builtin_bit_cast(float, __builtin_amdgcn_readlane(__builtin_bit_cast(int, v), 32)), d = __builtin_bit_cast(float, __builtin_amdgcn_readlane(__builtin_bit_cast(int, v), 48));
    return fminf(fminf(a, b), fminf(cc, d));
}
__device__ __forceinline__ float wave_max_dpp(float v) {
    v = fmaxf(v, DPPF(v, 0xB1)); v = fmaxf(v, DPPF(v, 0x4E)); v = fmaxf(v, DPPF(v, 0x141)); v = fmaxf(v, DPPF(v, 0x140));
    const float a = __builtin_bit_cast(float, __builtin_amdgcn_readlane(__builtin_bit_cast(int, v), 0)), b = __builtin_bit_cast(float, __builtin_amdgcn_readlane(__builtin_bit_cast(int, v), 16)),
                cc = __builtin_bit_cast(float, __builtin_amdgcn_readlane(__builtin_bit_cast(int, v), 32)), d = __builtin_bit_cast(float, __builtin_amdgcn_readlane(__builtin_bit_cast(int, v), 48));
    return fmaxf(fmaxf(a, b), fmaxf(cc, d));
}
__device__ __forceinline__ unsigned wave_suffix_sum_dpp(unsigned v, int lane) {
#define DPPU(v_, ctrl_) ((unsigned)__builtin_amdgcn_update_dpp(0, (int)(v_), ctrl_, 0xF, 0xF, true))
    v += DPPU(v, 0x101); v += DPPU(v, 0x102); v += DPPU(v, 0x104); v += DPPU(v, 0x108);
    const unsigned t1 = (unsigned)__builtin_amdgcn_readlane((int)v, 16), t2 = (unsigned)__builtin_amdgcn_readlane((int)v, 32), t3 = (unsigned)__builtin_amdgcn_readlane((int)v, 48);
    const int r = lane >> 4; return v + (r == 0 ? t1 + t2 + t3 : (r == 1 ? t2 + t3 : (r == 2 ? t3 : 0u)));
#undef DPPU
}
__device__ __forceinline__ unsigned wave_prefix_sum_dpp(unsigned v, int lane) {
#define DPPU(v_, ctrl_) ((unsigned)__builtin_amdgcn_update_dpp(0, (int)(v_), ctrl_, 0xF, 0xF, true))
    v += DPPU(v, 0x111); v += DPPU(v, 0x112); v += DPPU(v, 0x114); v += DPPU(v, 0x118);
    const unsigned t0 = (unsigned)__builtin_amdgcn_readlane((int)v, 15), t1 = (unsigned)__builtin_amdgcn_readlane((int)v, 31), t2 = (unsigned)__builtin_amdgcn_readlane((int)v, 47);
    const int r = lane >> 4; return v + (r == 0 ? 0u : (r == 1 ? t0 : (r == 2 ? t0 + t1 : t0 + t1 + t2)));
#undef DPPU
}
__device__ __forceinline__ unsigned fkey(float f) { const unsigned u = __builtin_bit_cast(unsigned, f); return (u & 0x80000000u) ? ~u : (u | 0x80000000u); }
__device__ __forceinline__ int srow_addr(int k) { return (k >> 8) * 256 + (k & 63) * 4 + ((k >> 6) & 3); }
typedef _Float16 srow_t;
__device__ __forceinline__ void select_row_slow(const LAS srow_t* row, int nch, LAS unsigned long long* mw64, int lane) {
    unsigned tau = 0u; bool exact = false;
    for (int bit = 31; bit >= 0; --bit) { const unsigned cand = tau | (1u << bit); int cnt = 0;
        for (int c = 0; c < nch; ++c) cnt += __builtin_popcountll(__ballot(fkey((float)row[(c >> 2) * 256 + lane * 4 + (c & 3)]) >= cand));
        if (cnt >= 256) { tau = cand; if (cnt == 256) { exact = true; break; } } }
    int rem = 0;
    if (!exact) { int cgt = 0; for (int c = 0; c < nch; ++c) cgt += __builtin_popcountll(__ballot(fkey((float)row[(c >> 2) * 256 + lane * 4 + (c & 3)]) > tau)); rem = 256 - cgt; }
    for (int c = 0; c < 64; ++c) { unsigned long long sel = 0ull;
        if (c < nch) { const unsigned k = fkey((float)row[(c >> 2) * 256 + lane * 4 + (c & 3)]);
            if (exact) sel = __ballot(k >= tau);
            else { sel = __ballot(k > tau); unsigned long long eq = __ballot(k == tau);
                while (eq != 0ull && rem > 0) { const unsigned long long low = eq & (0ull - eq); sel |= low; eq ^= low; --rem; } } }
        if (lane == 0) mw64[c] = sel; }
}
#define SEL_B(BODY, i) if (nch >= 4 * (i) + 4) { BODY(i, 0) BODY(i, 1) BODY(i, 2) BODY(i, 3) if (nch == 4 * (i) + 4) break; } else { BODY(i, 0) if (nch == 4 * (i) + 1) break; BODY(i, 1) if (nch == 4 * (i) + 2) break; BODY(i, 2) break; }
#define SEL_CHUNKS(BODY) do { SEL_B(BODY, 0) SEL_B(BODY, 1) SEL_B(BODY, 2) SEL_B(BODY, 3) SEL_B(BODY, 4) SEL_B(BODY, 5) SEL_B(BODY, 6) SEL_B(BODY, 7) SEL_B(BODY, 8) SEL_B(BODY, 9) SEL_B(BODY, 10) SEL_B(BODY, 11) SEL_B(BODY, 12) SEL_B(BODY, 13) SEL_B(BODY, 14) SEL_B(BODY, 15) } while (0)
__device__ __forceinline__ void select_row(const LAS srow_t* row, int nch_, LAS unsigned* hist, LAS unsigned short* clist, LAS unsigned long long* mw64, int lane, unsigned long long* mrow) {
    int nch = nch_; asm volatile("" : "+s"(nch));
    const int nb = (nch + 3) >> 2;
    float e[16][4];
#pragma unroll
    for (int i = 0; i < 16; ++i) if (i < nb) { typedef _Float16 h4_t __attribute__((ext_vector_type(4))); const h4_t v = *(const LAS h4_t*)(row + i * 256 + lane * 4); e[i][0] = (float)v[0]; e[i][1] = (float)v[1]; e[i][2] = (float)v[2]; e[i][3] = (float)v[3]; }
    float mn = INFINITY, mx = -INFINITY;
#define BODY_A(i, j) { mn = fminf(mn, e[i][j]); mx = fmaxf(mx, e[i][j]); }
    SEL_CHUNKS(BODY_A);
#undef BODY_A
    mn = wave_min_dpp(mn); mx = wave_max_dpp(mx);
    const float scale = (mx - mn > 1e-30f) ? 256.0f / (mx - mn) : 0.f, off = -mn * scale;
    *(LAS v4u*)(hist + 4 * lane) = (v4u){0u, 0u, 0u, 0u};
#define BODY_B(i, j) { const float t = __builtin_fmaf(e[i][j], scale, off); e[i][j] = t; const unsigned bn = (unsigned)__builtin_amdgcn_fmed3f(t, 0.f, 255.f); \
        (void)__hip_atomic_fetch_add(hist + bn, 1u, __ATOMIC_RELAXED, __HIP_MEMORY_SCOPE_WORKGROUP); }
    SEL_CHUNKS(BODY_B);
#undef BODY_B
    asm volatile("s_waitcnt lgkmcnt(0)" ::: "memory");
    const v4u h = *(const LAS v4u*)(hist + 4 * lane);
    const unsigned s4 = h.x + h.y + h.z + h.w; const unsigned suf = wave_suffix_sum_dpp(s4, lane);
    const unsigned long long bm = __ballot(suf >= 256u);
    const int lstar = 63 - __builtin_clzll(bm);
    unsigned run = suf - s4, bl, ab, cn;
    if (run + h.w >= 256u) { bl = 3; ab = run; cn = h.w; } else { run += h.w;
        if (run + h.z >= 256u) { bl = 2; ab = run; cn = h.z; } else { run += h.z;
            if (run + h.y >= 256u) { bl = 1; ab = run; cn = h.y; } else { run += h.y; bl = 0; ab = run; cn = h.x; } } }
    const int bstar = 4 * lstar + __builtin_amdgcn_readlane((int)bl, lstar);
    const int above = __builtin_amdgcn_readlane((int)ab, lstar), cntb = __builtin_amdgcn_readlane((int)cn, lstar);
    const float T0 = bstar == 0 ? -INFINITY : (float)bstar, T1 = bstar == 255 ? INFINITY : (float)(bstar + 1);
    unsigned wlo = 0u, whi = 0u, clo = 0u, chi = 0u;
#define BODY_C(i, j) { const float t = e[i][j]; const unsigned long long sel = __ballot(t >= T1), cand = __ballot(t >= T0) & ~sel; \
        asm volatile("v_writelane_b32 %0, %2, %4\n\tv_writelane_b32 %1, %3, %4" : "+v"(wlo), "+v"(whi) : "s"((unsigned)sel), "s"((unsigned)(sel >> 32)), "n"(4 * (i) + (j))); \
        asm volatile("v_writelane_b32 %0, %2, %4\n\tv_writelane_b32 %1, %3, %4" : "+v"(clo), "+v"(chi) : "s"((unsigned)cand), "s"((unsigned)(cand >> 32)), "n"(4 * (i) + (j))); }
    SEL_CHUNKS(BODY_C);
#undef BODY_C
    { unsigned long long cw = ((unsigned long long)chi << 32) | clo;
        const int npc = __builtin_popcountll(cw); int base = (int)wave_prefix_sum_dpp((unsigned)npc, lane) - npc;
        while (__ballot(cw != 0ull) != 0ull) {
            if (cw != 0ull) { const int bit = __builtin_ctzll(cw); if (base < 256) clist[base] = (unsigned short)(64 * lane + bit); cw &= cw - 1ull; ++base; } } }
    mw64[lane] = ((unsigned long long)whi << 32) | wlo;
    asm volatile("s_waitcnt lgkmcnt(0)" ::: "memory");
    const int need2 = 256 - above;
    LAS unsigned* mw32 = (LAS unsigned*)mw64;
    if (cntb > 256) { select_row_slow(row, nch, mw64, lane); }
    else if (cntb <= 64) {
        const bool valid = lane < cntb; const int idx = valid ? (int)clist[lane] : 0; const unsigned key = valid ? fkey((float)row[srow_addr(idx)]) : 0u;
        bool take = valid;
        if (cntb != need2) { int rank = 0;
            for (int i = 0; i < cntb; ++i) { const unsigned ki = (unsigned)__builtin_amdgcn_readlane((int)key, i); rank += (ki > key || (ki == key && i < lane)) ? 1 : 0; }
            take = valid && rank < need2; }
        if (take) (void)__hip_atomic_fetch_or(mw32 + (idx >> 5), 1u << (idx & 31), __ATOMIC_RELAXED, __HIP_MEMORY_SCOPE_WORKGROUP);
    }
    else {
        unsigned key[4]; int idx[4]; bool take[4];
#pragma unroll
        for (int s = 0; s < 4; ++s) { const int jj = lane + 64 * s; const bool valid = jj < cntb; idx[s] = valid ? (int)clist[jj] : 0; key[s] = valid ? fkey((float)row[srow_addr(idx[s])]) : 0u; take[s] = valid; }
        if (cntb != need2) {
            unsigned tau = 0u; bool exact = false;
            for (int bit = 31; bit >= 0; --bit) { const unsigned cand = tau | (1u << bit); int cnt = 0;
#pragma unroll
                for (int s = 0; s < 4; ++s) cnt += __builtin_popcountll(__ballot(key[s] >= cand));
                if (cnt >= need2) { tau = cand; if (cnt == need2) { exact = true; break; } } }
            if (exact) {
#pragma unroll
                for (int s = 0; s < 4; ++s) take[s] = key[s] >= tau; }
            else { int cgt = 0;
#pragma unroll
                for (int s = 0; s < 4; ++s) cgt += __builtin_popcountll(__ballot(key[s] > tau));
                int rem = need2 - cgt;
#pragma unroll
                for (int s = 0; s < 4; ++s) { const bool iseq = key[s] == tau; const unsigned long long eq = __ballot(iseq);
                    const int rk = (int)__builtin_amdgcn_mbcnt_hi((unsigned)(eq >> 32), __builtin_amdgcn_mbcnt_lo((unsigned)eq, 0u));
                    take[s] = (key[s] > tau) || (iseq && rk < rem); const int ne = __builtin_popcountll(eq); rem = rem > ne ? rem - ne : 0; } }
        }
#pragma unroll
        for (int s = 0; s < 4; ++s) if (take[s]) (void)__hip_atomic_fetch_or(mw32 + (idx[s] >> 5), 1u << (idx[s] & 31), __ATOMIC_RELAXED, __HIP_MEMORY_SCOPE_WORKGROUP);
    }
    asm volatile("s_waitcnt lgkmcnt(0)" ::: "memory");
    mrow[lane] = mw64[lane];
}
__device__ __forceinline__ void indexer_scores(const bf16* QI, const bf16* KI, const float* WI, int b, int tb, int g, int ntile, LAS srow_t* Sd, int wv, int lane) {
    const int c32 = lane & 31, hl = lane >> 5;
    bf16x8 qa[2][4]; float wq[2][16];
#pragma unroll
    for (int rt = 0; rt < 2; ++rt) {
        const int quad = c32 >> 2, qq = ((quad >> 2) << 1) | (quad & 1), head = ((quad >> 1) & 1) * 4 + (c32 & 3);
        const bf16* qp = QI + (size_t)(tb + 8 * g + 4 * rt + qq) * 512 + head * 64 + 8 * hl;
#pragma unroll
        for (int ks = 0; ks < 4; ++ks) qa[rt][ks] = *(const GAS bf16x8*)(qp + 16 * ks);
        const float* w0 = WI + (size_t)(tb + 8 * g + 4 * rt + hl) * 8; const float* w1 = w0 + 16;
#pragma unroll
        for (int h = 0; h < 8; ++h) { wq[rt][h] = w0[h]; wq[rt][8 + h] = w1[h]; }
    }
    const bf16* kbase = KI + (size_t)(b * SEQ) * 64 + lane * 8;
    const int ntw = (ntile - wv + NWAVES - 1) / NWAVES;
    bf16x8 k0[4], k1[4], k2[4];
#define IDX_LOAD(dst, pi_) do { const int pc_ = (pi_) < ntw ? (pi_) : ntw - 1; const bf16* kp_ = kbase + (size_t)(wv + NWAVES * pc_) * 2048; \
        _Pragma("unroll") for (int ks = 0; ks < 4; ++ks) dst[ks] = *(const GAS bf16x8*)(kp_ + 512 * ks); } while (0)
#define IDX_TILE(kt_, kb_) do { const int sa = ((kt_) >> 3) * 256 + (32 * ((kt_) & 1) + c32) * 4 + (((kt_) >> 1) & 3); \
        _Pragma("unroll") for (int rt = 0; rt < 2; ++rt) { f32x16 acc = {}; \
            _Pragma("unroll") for (int ks = 0; ks < 4; ++ks) acc = mfma32(qa[rt][ks], kb_[ks], acc); \
            float s0 = 0.f, s1 = 0.f; \
            _Pragma("unroll") for (int h = 0; h < 8; ++h) { s0 = __builtin_fmaf(wq[rt][h], __builtin_amdgcn_fmed3f(acc[h], 0.f, 3.0e38f), s0); s1 = __builtin_fmaf(wq[rt][8 + h], __builtin_amdgcn_fmed3f(acc[8 + h], 0.f, 3.0e38f), s1); } \
            Sd[(4 * rt + hl) * 4096 + sa] = (srow_t)__builtin_amdgcn_fmed3f(s0, -65504.f, 65504.f); Sd[(4 * rt + 2 + hl) * 4096 + sa] = (srow_t)__builtin_amdgcn_fmed3f(s1, -65504.f, 65504.f); } } while (0)
    IDX_LOAD(k0, 0); IDX_LOAD(k1, 1);
    int p0 = 0;
#pragma unroll 1
    for (; p0 + 3 <= ntw; p0 += 3) {
        IDX_LOAD(k2, p0 + 2); IDX_TILE(wv + NWAVES * p0, k0);
        IDX_LOAD(k0, p0 + 3); IDX_TILE(wv + NWAVES * (p0 + 1), k1);
        IDX_LOAD(k1, p0 + 4); IDX_TILE(wv + NWAVES * (p0 + 2), k2);
    }
    if (p0 < ntw) { IDX_TILE(wv + NWAVES * p0, k0); if (p0 + 1 < ntw) IDX_TILE(wv + NWAVES * (p0 + 1), k1); }
#undef IDX_LOAD
#undef IDX_TILE
}
__device__ __forceinline__ void indexer_block(Frame& F, int b, int n) {
    const bf16* QI = wsp<bf16>(F, WS_QI); const bf16* KI = wsp<bf16>(F, WS_KI); const float* WI = wsp<float>(F, WS_WI);
    unsigned long long* MASK = wsp<unsigned long long>(F, WS_MASK);
    const int tb = b * SEQ + 64 * n, L = 64 * (n + 1), nw = n + 1;
    int lane; asm volatile("v_mbcnt_lo_u32_b32 %0, -1, 0\n\tv_mbcnt_hi_u32_b32 %0, -1, %0" : "=v"(lane));
    const int wv = F.wave, tid = wv * 64 + lane;
    if (n < 4) {
        for (int i = tid; i < 64 * 4; i += NWAVES * 64) { const int q = i >> 2, wd = i & 3; MASK[(size_t)(tb + q) * 64 + wd] = wd < nw ? ~0ull : 0ull; }
        return;
    }
    LAS srow_t* S = (LAS srow_t*)F.lds;
    LAS unsigned* hist = (LAS unsigned*)(F.lds + 131072) + wv * 256;
    LAS unsigned short* clist = (LAS unsigned short*)(F.lds + 131072 + 8192) + wv * 256;
    LAS unsigned long long* mw64 = (LAS unsigned long long*)(F.lds + 131072 + 8192 + 4096) + wv * 64;
    const int ntile = L / 32;
    indexer_scores(QI, KI, WI, b, tb, 0, ntile, S, wv, lane);
    WG_SYNC();
#pragma unroll 1
    for (int g = 0; g < 8; ++g) {
        LAS srow_t* Sc = S + (g & 1) * (8 * 4096); LAS srow_t* Sn = S + ((g + 1) & 1) * (8 * 4096);
        if (wv < 4 && g + 1 < 8) indexer_scores(QI, KI, WI, b, tb, g + 1, ntile, Sn, wv, lane);
        select_row(Sc + wv * 4096, nw, hist, clist, mw64, lane, MASK + (size_t)(tb + 8 * g + wv) * 64);
        if (wv >= 4 && g + 1 < 8) indexer_scores(QI, KI, WI, b, tb, g + 1, ntile, Sn, wv, lane);
        WG_SYNC();
    }
}
__device__ __forceinline__ void indexer_phase(Frame& F) {
    for (int u = F.vcu; u < NBATCH * 32; u += F.G) { const int b = u >> 5, j = u & 31;
#pragma unroll 1
        for (int k = 0; k < 2; ++k) indexer_block(F, b, k ? j : 63 - j); }
}

__device__ __forceinline__ void xattn_phase(Frame& F) {
    const bf16* QX = wsp<bf16>(F, WS_K); const bf16* KX = wsp<bf16>(F, WS_KX); const bf16* VT = wsp<bf16>(F, WS_VT); bf16* OX = wsp<bf16>(F, WS_QI);
    const int wv = F.wave;
    LAS float* wsf = (LAS float*)(F.lds + 131072) + wv * 64;
    for (int ui = 0; ui < 2; ++ui) {
        int lane; asm volatile("v_mbcnt_lo_u32_b32 %0, -1, 0\n\tv_mbcnt_hi_u32_b32 %0, -1, %0" : "=v"(lane)); const int tid = wv * 64 + lane, r32 = lane & 31, hi = lane >> 5;
        const int u = F.vcu * 2 + ui; if (u >= NBATCH * 4 * 16) break;
        const int bh = u >> 4, qb = u & 15, b = bh >> 2, h = bh & 3;
        const int tok = b * SEQ + qb * 256 + wv * 32 + r32;
        const bf16* qp = QX + (size_t)tok * 1024 + h * 256 + 8 * hi;
        f32x16 O[8];
#pragma unroll
        for (int i = 0; i < 8; ++i) O[i] = f32x16{};
        float mrun = -INFINITY, lrun = 0.f;
        v4u preg[4];
#define XA_LOADK(t_) do { _Pragma("unroll") for (int i = 0; i < 4; ++i) { const int ci = tid + 512 * i, r = ci >> 5, c = ci & 31; preg[i] = *(const GAS v4u*)(KX + (size_t)(b * 256 + 64 * (t_) + r) * 1024 + h * 256 + c * 8); } } while (0)
#define XA_LOADV(t_) do { _Pragma("unroll") for (int i = 0; i < 4; ++i) { const int ci = tid + 512 * i, dv = ci >> 3, c = ci & 7; preg[i] = *(const GAS v4u*)(VT + ((size_t)(b * 4 + h) * 256 + dv) * 256 + 64 * (t_) + c * 8); } } while (0)
#define XA_STOREK(buf_) do { _Pragma("unroll") for (int i = 0; i < 4; ++i) { const int ci = tid + 512 * i, r = ci >> 5, c = ci & 31; *(LAS v4u*)(F.lds + (buf_) * 65536 + r * 512 + ((c ^ (r & 15)) << 4)) = preg[i]; } } while (0)
#define XA_STOREV(buf_) do { _Pragma("unroll") for (int i = 0; i < 4; ++i) { const int ci = tid + 512 * i, dv = ci >> 3, c = ci & 7; *(LAS v4u*)(F.lds + (buf_) * 65536 + 32768 + dv * 128 + ((c ^ (dv & 7)) << 4)) = preg[i]; } } while (0)
        WG_SYNC();
        XA_LOADK(0); XA_STOREK(0); XA_LOADV(0); XA_STOREV(0);
        WG_SYNC();
        for (int t = 0; t < 4; ++t) {
            LAS unsigned char* Kt = F.lds + (t & 1) * 65536; LAS unsigned char* Vt = Kt + 32768;
            if (t < 3) XA_LOADK(t + 1);
            f32x16 p0 = f32x16{}, p1 = f32x16{};
#pragma unroll 4
            for (int ks = 0; ks < 16; ++ks) { const bf16x8 qf = *(const GAS bf16x8*)(qp + 16 * ks);
                const int c = 2 * ks + hi;
                const bf16x8 k0 = *(const LAS bf16x8*)(Kt + r32 * 512 + ((c ^ (r32 & 15)) << 4));
                const bf16x8 k1 = *(const LAS bf16x8*)(Kt + (32 + r32) * 512 + ((c ^ (r32 & 15)) << 4));
                p0 = mfma32(k0, qf, p0); p1 = mfma32(k1, qf, p1); }
            if (t < 3) { XA_STOREK((t + 1) & 1); XA_LOADV(t + 1); }
            float rm = p0[0];
#pragma unroll
            for (int r = 1; r < 16; ++r) rm = fmaxf(rm, p0[r]);
#pragma unroll
            for (int r = 0; r < 16; ++r) rm = fmaxf(rm, p1[r]);
            rm = fmaxf(rm, __shfl_xor(rm, 32));
            const float mnew = fmaxf(mrun, rm), alpha = __builtin_amdgcn_exp2f(mrun - mnew); mrun = mnew;
            float ps = 0.f;
#pragma unroll
            for (int r = 0; r < 16; ++r) { p0[r] = __builtin_amdgcn_exp2f(p0[r] - mnew); p1[r] = __builtin_amdgcn_exp2f(p1[r] - mnew); ps += p0[r] + p1[r]; }
            lrun = lrun * alpha + ps;
            if (hi == 0) wsf[r32] = alpha;
            asm volatile("s_waitcnt lgkmcnt(0)" ::: "memory");
#pragma unroll
            for (int r = 0; r < 16; ++r) { const float a = wsf[crow32(r, hi)];
#pragma unroll
                for (int i = 0; i < 8; ++i) O[i][r] *= a; }
            pg8::u32x4 pw[4];
            pw[0] = pg8::pack8((f32x4){p0[0], p0[1], p0[2], p0[3]}, (f32x4){p0[4], p0[5], p0[6], p0[7]});
            pw[1] = pg8::pack8((f32x4){p0[8], p0[9], p0[10], p0[11]}, (f32x4){p0[12], p0[13], p0[14], p0[15]});
            pw[2] = pg8::pack8((f32x4){p1[0], p1[1], p1[2], p1[3]}, (f32x4){p1[4], p1[5], p1[6], p1[7]});
            pw[3] = pg8::pack8((f32x4){p1[8], p1[9], p1[10], p1[11]}, (f32x4){p1[12], p1[13], p1[14], p1[15]});
#pragma unroll
            for (int blk = 0; blk < 8; ++blk) { const int dv = 32 * blk + r32;
#pragma unroll
                for (int s = 0; s < 4; ++s) { const int c = 2 * s + hi;
                    const bf16x8 vf = *(const LAS bf16x8*)(Vt + dv * 128 + ((c ^ (dv & 7)) << 4));
                    O[blk] = mfma32(__builtin_bit_cast(bf16x8, pw[s]), vf, O[blk]); } }
            if (t < 3) XA_STOREV((t + 1) & 1);
            WG_SYNC();
        }
#undef XA_LOADK
#undef XA_LOADV
#undef XA_STOREK
#undef XA_STOREV
        lrun += __shfl_xor(lrun, 32);
        asm volatile("s_waitcnt lgkmcnt(0)" ::: "memory");
        if (hi == 0) wsf[r32] = 1.0f / lrun;
        asm volatile("s_waitcnt lgkmcnt(0)" ::: "memory");
        bf16* ob = OX + (size_t)(b * SEQ + qb * 256 + wv * 32) * 1024 + h * 256 + r32;
#pragma unroll
        for (int r = 0; r < 16; ++r) { const int q = crow32(r, hi); const float a = wsf[q];
#pragma unroll
            for (int i = 0; i < 8; ++i) ob[(size_t)q * 1024 + 32 * i] = (bf16)f2bf(O[i][r] * a);
            if (r & 1) asm volatile("" ::: "memory"); }
    }
    WG_SYNC();
}

__device__ __forceinline__ void router_phase(Frame& F) {
    const bf16* XB = wsp<bf16>(F, WS_Q); const bf16* RT = wsp<bf16>(F, W_RT);
    const float* rowsq = (const float*)(F.ctl + CW_ROWSQ2); const float* brg = F.in[19]; const float* bre = F.in[21];
    gu32* cnt = F.ctl + CW_CNT; int* list = wsp<int>(F, WS_LIST); float* cE = wsp<float>(F, WS_CE); unsigned* tokpos = wsp<unsigned>(F, WS_TOKC);
    const int lane = F.lane, wv = F.wave, fr = lane & 15, fq = lane >> 4;
    LAS unsigned char* WL = F.lds;
    LAS float* lg = (LAS float*)(F.lds + 98304) + wv * (16 * 48);
    LAS unsigned* lcnt = (LAS unsigned*)(F.lds + 122880); LAS unsigned* gbase = lcnt + 32;
    if (F.tid < 32) lcnt[F.tid] = 0u;
    { v4u wv_[12];
#pragma unroll
      for (int j = 0; j < 12; ++j) { const int i = F.tid + 512 * j, r = i >> 7, ch = i & 127; wv_[j] = *(const GAS v4u*)(RT + (size_t)r * 1024 + ch * 8); }
#pragma unroll
      for (int j = 0; j < 12; ++j) { const int i = F.tid + 512 * j, r = i >> 7, ch = i & 127; *(LAS v4u*)(WL + r * 2048 + ((ch ^ (r & 15)) << 4)) = wv_[j]; } }
    WG_SYNC();
    for (int unit = F.vcu; unit < T / 128; unit += F.G) {
        const int tok0 = unit * 128 + wv * 16;
        const bf16* ap = XB + (size_t)(tok0 + fr) * 1024 + 8 * fq;
        bf16x8 af[32];
#pragma unroll
        for (int ks = 0; ks < 32; ++ks) af[ks] = *(const GAS bf16x8*)(ap + 32 * ks);
        f32x4 acc[3] = {f32x4{}, f32x4{}, f32x4{}};
#pragma unroll
        for (int ks = 0; ks < 32; ++ks) { const int ch = 4 * ks + fq;
#pragma unroll
            for (int ct = 0; ct < 3; ++ct) { const int r = 16 * ct + fr; const bf16x8 bb = *(const LAS bf16x8*)(WL + r * 2048 + ((ch ^ (r & 15)) << 4)); acc[ct] = mfma16(af[ks], bb, acc[ct]); } }
#pragma unroll
        for (int ct = 0; ct < 3; ++ct)
#pragma unroll
            for (int r = 0; r < 4; ++r) lg[(4 * fq + r) * 48 + 16 * ct + fr] = acc[ct][r];
        asm volatile("s_waitcnt lgkmcnt(0)" ::: "memory");
        int e0 = 0, e1 = 0, r0 = 0, r1 = 0; float c0 = 0.f, c1 = 0.f;
        if (lane < 16) { const int tok = tok0 + lane; const LAS float* l = lg + lane * 48;
            const float rs = __builtin_amdgcn_rsqf(rowsq[tok] * (1.0f / 1024.0f) + EPS);
            float gl[4]; int gs = 0; float gm;
#pragma unroll
            for (int g = 0; g < 4; ++g) gl[g] = l[g] * rs + brg[g];
            gm = gl[0];
#pragma unroll
            for (int g = 1; g < 4; ++g) if (gl[g] > gm) { gm = gl[g]; gs = g; }
            float den = 0.f;
#pragma unroll
            for (int g = 0; g < 4; ++g) den += __expf(gl[g] - gm);
            const float ggate = 1.0f / den;
            float v1 = -INFINITY, v2 = -INFINITY; int i1 = 0, i2 = 0;
            for (int e = 0; e < 8; ++e) { const float v = l[4 + 8 * gs + e] * rs + bre[gs * 8 + e];
                if (v > v1) { v2 = v1; i2 = i1; v1 = v; i1 = e; } else if (v > v2) { v2 = v; i2 = e; } }
            const float e21 = __expf(v2 - v1), w1 = ggate / (1.0f + e21), w2 = ggate * e21 / (1.0f + e21);
            const int lo = i1 < i2 ? i1 : i2, hi_ = i1 < i2 ? i2 : i1; const float clo = i1 < i2 ? w1 : w2, chi = i1 < i2 ? w2 : w1;
            e0 = gs * 8 + lo; e1 = gs * 8 + hi_; c0 = clo; c1 = chi;
            r0 = (int)__hip_atomic_fetch_add(lcnt + e0, 1u, __ATOMIC_RELAXED, __HIP_MEMORY_SCOPE_WORKGROUP); r1 = (int)__hip_atomic_fetch_add(lcnt + e1, 1u, __ATOMIC_RELAXED, __HIP_MEMORY_SCOPE_WORKGROUP); }
        WG_SYNC();
        if (F.tid < 32) { const unsigned n = lcnt[F.tid]; gbase[F.tid] = n ? __hip_atomic_fetch_add(cnt + 64 * F.tid, n, RLX_AGENT) : 0u; lcnt[F.tid] = 0u; }
        WG_SYNC();
        if (lane < 16) { const int tok = tok0 + lane; const unsigned s0 = gbase[e0] + (unsigned)r0, s1 = gbase[e1] + (unsigned)r1;
            list[(size_t)e0 * T + s0] = tok; cE[(size_t)e0 * T + s0] = c0; list[(size_t)e1 * T + s1] = tok; cE[(size_t)e1 * T + s1] = c1;
            tokpos[2 * tok] = ((unsigned)e0 << 16) | s0; tokpos[2 * tok + 1] = ((unsigned)e1 << 16) | s1; }
        asm volatile("s_waitcnt lgkmcnt(0)" ::: "memory");
    }
    WG_SYNC();
}

#define FRESH_LANE(l_) asm volatile("v_mbcnt_lo_u32_b32 %0, -1, 0\n\tv_mbcnt_hi_u32_b32 %0, -1, %0" : "=v"(l_))
__device__ __forceinline__ void final_phase(Frame& F) {
    const bf16* XB = wsp<bf16>(F, WS_Q); const bf16* YS = wsp<bf16>(F, WS_YS); const unsigned* tokpos = wsp<unsigned>(F, WS_TOKC); const float* gfin = F.in[25]; float* out = F.out;
    LAS int* pre = (LAS int*)(F.lds + 131072);
    if (F.tid == 0) { int acc = 0; for (int c = 0; c < 32; ++c) { pre[c] = acc; const int n = (int)__hip_atomic_load(F.ctl + CW_CNT + 64 * c, RLX_AGENT); acc += (n + 255) >> 8; } pre[32] = acc; }
    WG_SYNC();
    const int lane = F.lane, gw = F.vcu * NWAVES + F.wave, NGW = F.G * NWAVES;
    f32x4 g[4];
#pragma unroll
    for (int j = 0; j < 4; ++j) g[j] = *(const f32x4*)(gfin + 256 * j + 4 * lane);
    typedef unsigned u32x2_t __attribute__((ext_vector_type(2)));
    for (int m0 = gw * 4; m0 < T; m0 += NGW * 4) {
        f32x4 v[4][4]; float s[4]; size_t r0[4], r1[4];
#pragma unroll
        for (int q = 0; q < 4; ++q) { const int tok = m0 + q; const unsigned p0 = tokpos[2 * tok], p1 = tokpos[2 * tok + 1];
            r0[q] = (size_t)pre[p0 >> 16] * 256 + (p0 & 0xffffu); r1[q] = (size_t)pre[p1 >> 16] * 256 + (p1 & 0xffffu); }
#pragma unroll
        for (int q = 0; q < 4; ++q) { const int tok = m0 + q; s[q] = 0.f;
#pragma unroll
            for (int j = 0; j < 4; ++j) { const int col = 256 * j + 4 * lane;
                const u32x2_t xa = *(const GAS u32x2_t*)(XB + (size_t)tok * 1024 + col), ya = *(const GAS u32x2_t*)(YS + r0[q] * 1024 + col), za = *(const GAS u32x2_t*)(YS + r1[q] * 1024 + col);
                f32x4 t;
                t[0] = __builtin_bit_cast(float, xa.x << 16) + (__builtin_bit_cast(float, ya.x << 16) + __builtin_bit_cast(float, za.x << 16));
                t[1] = __builtin_bit_cast(float, xa.x & 0xffff0000u) + (__builtin_bit_cast(float, ya.x & 0xffff0000u) + __builtin_bit_cast(float, za.x & 0xffff0000u));
                t[2] = __builtin_bit_cast(float, xa.y << 16) + (__builtin_bit_cast(float, ya.y << 16) + __builtin_bit_cast(float, za.y << 16));
                t[3] = __builtin_bit_cast(float, xa.y & 0xffff0000u) + (__builtin_bit_cast(float, ya.y & 0xffff0000u) + __builtin_bit_cast(float, za.y & 0xffff0000u));
                v[q][j] = t; s[q] += (t[0] * t[0] + t[1] * t[1]) + (t[2] * t[2] + t[3] * t[3]); } }
#pragma unroll
        for (int o = 1; o < 64; o <<= 1) { s[0] += __shfl_xor(s[0], o); s[1] += __shfl_xor(s[1], o); s[2] += __shfl_xor(s[2], o); s[3] += __shfl_xor(s[3], o); }
#pragma unroll
        for (int q = 0; q < 4; ++q) { const float rs = __builtin_amdgcn_rsqf(s[q] * (1.0f / 1024.0f) + EPS); float* op = out + (size_t)(m0 + q) * 1024 + 4 * lane;
#pragma unroll
            for (int j = 0; j < 4; ++j) *(GAS f32x4*)(op + 256 * j) = v[q][j] * rs * g[j]; }
    }
}

struct Args { const float* in[26]; float* out; unsigned char* ws; int ph_lo, ph_hi; };
__global__ void __launch_bounds__(NWAVES * 64, 2) fwd_kernel(Args args) {
    extern __shared__ __attribute__((aligned(16))) unsigned char lds[];
    Frame F;
    F.lds = (LAS unsigned char*)lds;
    F.MISC = (volatile LAS unsigned*)(F.lds + MISC_OFF);
    F.tid = threadIdx.x; F.lane = F.tid & 63; F.wave = __builtin_amdgcn_readfirstlane(F.tid >> 6);
    F.G = gridDim.x; { const int bx = blockIdx.x; F.vcu = (F.G % 8 == 0) ? (bx % 8) * (F.G / 8) + bx / 8 : bx; }
    F.ws = args.ws; F.ctl = (gu32*)(args.ws + WS_CTL); F.out = args.out;
    F.in = args.in;
    for (int u = F.tid; u < (LDS_BYTES - LDSCTL_OFF) / 4; u += NWAVES * 64) ((LAS unsigned*)(F.lds + LDSCTL_OFF))[u] = 0u;
    __syncthreads();
    const bool one = (args.ph_hi - args.ph_lo) > 1;
    XcdBarrier bar; bar.bar = (unsigned*)(F.ctl + CW_BAR); bar.x = 0; bar.st = nullptr; bar.wave = F.wave;
    if (one) bar = xcd_barrier_post((unsigned*)(F.ctl + CW_BAR), F.MISC + 8, F.wave);
    const int lo = args.ph_lo, hi = args.ph_hi;
#define REFRESH() do { int l_; asm volatile("v_mbcnt_lo_u32_b32 %0, -1, 0\n\tv_mbcnt_hi_u32_b32 %0, -1, %0" : "=v"(l_)); F.lane = l_; F.tid = F.wave * 64 + l_; } while (0)
#ifndef MK_REPEAT_MASK
#define MK_REPEAT_MASK 0
#endif
#define REP(k) ((MK_REPEAT_MASK >> (k)) & 1)
#ifndef MK_PHASE_MASK
#define MK_PHASE_MASK 0x3FFF
#endif
#define IN(k) (((MK_PHASE_MASK >> (k)) & 1) && lo <= (k) && (k) < hi)
#ifndef MK_PROBE_BLK
#define MK_PROBE_BLK 0
#endif
#ifndef MK_STAMP_A
#define MK_STAMP_A -1
#endif
#ifndef MK_STAMP_B
#define MK_STAMP_B -1
#endif
#define SEAM(k) do { if (IN(k) && IN((k) + 1)) xcd_barrier(bar); if (MK_STAMP_A >= 0 && blockIdx.x == MK_PROBE_BLK && F.tid == 0) { const unsigned long long t_ = rt(); F.MISC[32 + 2 * (k)] = (unsigned)t_; } } while (0)
    const float* rstd0 = wsp<float>(F, WS_RSTD0);
    const float* rope = wsp<float>(F, WS_ROPE);
    const int bx = (int)blockIdx.x;

    if (MK_STAMP_A >= 0 && blockIdx.x == MK_PROBE_BLK && F.tid == 0) F.MISC[30] = (unsigned)rt();
    if (IN(0)) { REFRESH(); p0_prologue(F); if (REP(0)) { WG_SYNC(); p0_prologue(F); } if (REP(13)) { for (int xb_ = 0; xb_ < 10; ++xb_) xcd_barrier(bar); } } SEAM(0);

    if (IN(1)) for (int rep1_ = 0; rep1_ < 1 + REP(1); ++rep1_) { REFRESH();
        const pg8::bf16_t* XB = wsp<pg8::bf16_t>(F, WS_XB);
        { static_assert(W_V == W_R + 1536 * 2048 && W_G == W_V + 512 * 2048 && W_X == W_G + 1024 * 2048 && WS_K - WS_Q == WS_QI - WS_K, "in-proj weight rows contiguous; Q, K, QI equally spaced");
          pg8::Gemm g{XB, wsp<pg8::bf16_t>(F, W_R), T, 3328, 1024}; pg8::StaticOrder S; S.init(T, 3328, F.G, bx);
          pg8::EpiInProj E{pg8::EpiRope{wsp<pg8::bf16_t>(F, WS_Q), (size_t)(WS_K - WS_Q) / 2, rstd0, rope}, pg8::EpiScale{wsp<pg8::bf16_t>(F, WS_V), 512, rstd0, nullptr, EPS},
                           pg8::EpiGlu{wsp<pg8::bf16_t>(F, WS_U), rstd0}, pg8::EpiKiWi{wsp<pg8::bf16_t>(F, WS_KI), wsp<float>(F, WS_WI), rstd0, rope}};
          pg8::gemm_phase<pg8::EpiInProj, pg8::StaticOrder, PG8_ALIGN, PG8_SP2>(F.lds, g, S, E, F.wave); }
        { pg8::Gemm g{wsp<pg8::bf16_t>(F, WS_MEMB), wsp<pg8::bf16_t>(F, W_KVX), NBATCH * NMEM, 2048, 1024}; pg8::StaticOrder S; S.init(NBATCH * NMEM, 2048, F.G, (bx + 128) % F.G);
          pg8::EpiMemKV E{wsp<pg8::bf16_t>(F, WS_KXH), wsp<pg8::bf16_t>(F, WS_VH), wsp<float>(F, WS_RSTDM)};
          pg8::gemm_phase<pg8::EpiMemKV, pg8::StaticOrder, PG8_ALIGN, PG8_SP2>(F.lds, g, S, E, F.wave); }
    } SEAM(1);

    if (IN(2)) { REFRESH(); indexer_phase(F); if (REP(2)) indexer_phase(F);
        if (MK_STAMP_A >= 0 && blockIdx.x == MK_PROBE_BLK && F.tid == 0) { const unsigned t_ = (unsigned)rt(); F.MISC[30 + 2 * 51] = t_; F.MISC[32 + 2 * 50] = t_; F.MISC[30 + 2 * 50] = F.MISC[32 + 2 * 1]; }
        conv_phase(F); if (REP(12)) conv_phase(F);
        if (MK_STAMP_A >= 0 && blockIdx.x == MK_PROBE_BLK && F.tid == 0) F.MISC[32 + 2 * 51] = (unsigned)rt();
        REFRESH();
        { pg8::Gemm g{wsp<pg8::bf16_t>(F, WS_KXH), wsp<pg8::bf16_t>(F, W_QH), 0, 0, 256}; pg8::WkOrder S{F.G, F.vcu};
          pg8::EpiWk E{wsp<pg8::bf16_t>(F, WS_WK)};
          pg8::gemm_phase<pg8::EpiWk, pg8::WkOrder, PG8_ALIGN, PG8_SP2>(F.lds, g, S, E, F.wave); }
        { pg8::Gemm g{wsp<pg8::bf16_t>(F, W_OH), wsp<pg8::bf16_t>(F, WS_VH), 0, 0, 256}; pg8::VwOrder S{F.G, (F.vcu + 128) % F.G};
          pg8::EpiVw E{wsp<pg8::bf16_t>(F, WS_VWT)};
          pg8::gemm_phase<pg8::EpiVw, pg8::VwOrder, PG8_ALIGN, PG8_SP2>(F.lds, g, S, E, F.wave); }
    } SEAM(2);

    if (IN(3)) { REFRESH();
        const attn_body::AttnTensors AT{(const attn_body::bf16*)wsp<bf16>(F, WS_Q), (const attn_body::bf16*)wsp<bf16>(F, WS_K), (const attn_body::bf16*)wsp<bf16>(F, WS_V), (attn_body::bf16*)wsp<bf16>(F, WS_Q), wsp<uint2>(F, WS_MASK)};
        const attn_body::StaticOrder S((int)F.G, bx);
        if (REP(3)) attn_body::attn_phase<attn_body::StaticOrder>((char*)lds, AT, S, F.wave, true);
        attn_body::attn_phase<attn_body::StaticOrder>((char*)lds, AT, S, F.wave);
    } SEAM(3);

    if (IN(4)) for (int rep4_ = 0; rep4_ < 1 + REP(4); ++rep4_) { REFRESH();
        { pg8::Gemm g{wsp<pg8::bf16_t>(F, WS_Q), wsp<pg8::bf16_t>(F, W_OA), T, 1024, 512}; pg8::StaticOrder S; S.init(T, 1024, F.G, bx);
          pg8::EpiScale E{wsp<pg8::bf16_t>(F, WS_K), 1024, nullptr, nullptr, EPS};
          pg8::gemm_phase<pg8::EpiScale, pg8::StaticOrder, PG8_ALIGN, PG8_SP2>(F.lds, g, S, E, F.wave); }
        { pg8::Gemm g{wsp<pg8::bf16_t>(F, WS_CA), wsp<pg8::bf16_t>(F, W_CO), T, 1024, 512}; pg8::StaticOrder S; S.init(T, 1024, F.G, bx);
          pg8::EpiScale E{wsp<pg8::bf16_t>(F, WS_QI), 1024, nullptr, nullptr, EPS};
          pg8::gemm_phase<pg8::EpiScale, pg8::StaticOrder, PG8_ALIGN, PG8_SP2>(F.lds, g, S, E, F.wave); }
    } SEAM(4);

    if (IN(5)) for (int rep5_ = 0; rep5_ < 1 + REP(5); ++rep5_) { REFRESH();
        pg8::Gemm g{wsp<pg8::bf16_t>(F, WS_XB), wsp<pg8::bf16_t>(F, W_GT), T, 2048, 1024}; pg8::StaticOrder S; S.init(T, 2048, F.G, bx);
        pg8::EpiMerge E{wsp<pg8::bf16_t>(F, WS_K), wsp<pg8::bf16_t>(F, WS_QI), wsp<pg8::bf16_t>(F, WS_Q), rstd0};
        pg8::gemm_phase<pg8::EpiMerge, pg8::StaticOrder, PG8_ALIGN, PG8_SP2>(F.lds, g, S, E, F.wave);
    } SEAM(5);

    if (IN(6)) { REFRESH();
        pg8::Gemm g{wsp<pg8::bf16_t>(F, WS_Q), wsp<pg8::bf16_t>(F, W_OUT), T, 1024, 1024}; pg8::StaticOrder S; S.init(T, 1024, F.G, bx);
        pg8::EpiResid E{wsp<pg8::bf16_t>(F, WS_XB), wsp<pg8::bf16_t>(F, WS_XB), (float*)(F.ctl + CW_ROWSQ1)};
        pg8::gemm_phase<pg8::EpiResid, pg8::StaticOrder, PG8_ALIGN, PG8_SP2>(F.lds, g, S, E, F.wave);
    } SEAM(6);

    if (IN(7)) { REFRESH();
        static_assert(PG8_ALIGN, "EpiSoftmax takes workgroup barriers inside the epilogue: both half-workgroups must run it together");
        pg8::Gemm g{wsp<pg8::bf16_t>(F, WS_XB), wsp<pg8::bf16_t>(F, WS_WK), T, 1024, 1024}; pg8::BatchOrder S; S.init(T, 1024, F.G, bx);
        pg8::EpiSoftmax E{wsp<pg8::bf16_t>(F, WS_K), (const float*)(F.ctl + CW_ROWSQ1), EPS, (PG8_LAS float*)(F.lds + 131072 + 4096)};
        pg8::gemm_phase<pg8::EpiSoftmax, pg8::BatchOrder, PG8_ALIGN, PG8_SP2>(F.lds, g, S, E, F.wave);
    } SEAM(7);


    if (IN(9)) { REFRESH();
        pg8::Gemm g{wsp<pg8::bf16_t>(F, WS_K), wsp<pg8::bf16_t>(F, WS_VWT), T, 1024, 1024}; pg8::BatchOrder S; S.init(T, 1024, F.G, bx);
        pg8::EpiResid E{wsp<pg8::bf16_t>(F, WS_XB), wsp<pg8::bf16_t>(F, WS_Q), (float*)(F.ctl + CW_ROWSQ2)};
        pg8::gemm_phase<pg8::EpiResid, pg8::BatchOrder, PG8_ALIGN, PG8_SP2>(F.lds, g, S, E, F.wave);
    } SEAM(9);

    if (IN(10)) { REFRESH(); router_phase(F); } SEAM(10);

    if (IN(11) || IN(12)) {
        REFRESH();
        LAS int* pre = (LAS int*)(F.lds + 131072); LAS int* cntl = pre + 64; LAS unsigned char* t2e = (LAS unsigned char*)(pre + 128);
        if (F.tid == 0) { int acc = 0; for (int c = 0; c < 32; ++c) { pre[c] = acc; const int n = (int)__hip_atomic_load(F.ctl + CW_CNT + 64 * c, RLX_AGENT); cntl[c] = n; const int nt_ = (n + 255) >> 8; for (int q = 0; q < nt_; ++q) t2e[acc + q] = (unsigned char)c; acc += nt_; } pre[32] = acc;
            const int G_ = F.G, U1 = 2 * acc, U2 = 4 * acc, al = U1 / G_, H = U1 % G_;
            int Tt = 15 * al + 3 * (U2 / G_), nl = 0, nh = 0, f = 0;
            for (;; ++Tt) { nl = (Tt - 15 * al) / 3; nh = (Tt - 15 * (al + 1)) / 3; nl = nl > 0 ? nl : 0; nh = nh > 0 ? nh : 0; f = H * nh + (G_ - H) * nl; if (f >= U2) break; }
            const int X = f - U2, Xl = nl > 0 ? (X < G_ - H ? X : G_ - H) : 0, Xh = X - Xl;
            const int g0 = (F.vcu >> 5) << 5, g1 = g0 + 32 < G_ ? g0 + 32 : G_;
            int se[2];
            for (int q = 0; q < 2; ++q) { const int c_ = q ? g1 : g0;
                if (c_ <= H) { const int d = c_ - (H - Xh); se[q] = c_ * nh - (d > 0 ? d : 0); }
                else { const int d = c_ - (G_ - Xl); se[q] = H * nh - Xh + (c_ - H) * nl - (d > 0 ? d : 0); } }
            pre[96] = se[0]; pre[97] = se[1]; pre[98] = (int)0xFFFE0000u; pre[99] = F.vcu - g0; pre[100] = g1 - g0; }
        WG_SYNC();
        if (MK_STAMP_A >= 0 && blockIdx.x == MK_PROBE_BLK && F.tid == 0) F.MISC[230] = (unsigned)rt();
        if (IN(11)) {
            const int U1_ = 2 * pre[32], al_ = U1_ / (int)F.G;
#pragma unroll 1
            for (int call = 0; call < 2; ++call) { const int r0 = call ? al_ : 0, r1 = call ? al_ + 1 : al_;
                REFRESH();
                pg8::MoeOrderT<1> S{pre, cntl, t2e, wsp<int>(F, WS_LIST), F.G, F.vcu, T, r0, r1};
                pg8::Gemm g{wsp<pg8::bf16_t>(F, WS_Q), wsp<pg8::bf16_t>(F, W_E1), 0, 0, 1024};
                pg8::EpiMoeH E{wsp<pg8::bf16_t>(F, WS_HS), (const float*)(F.ctl + CW_ROWSQ2), wsp<float>(F, WS_CE), EPS, S};
                pg8::gemm_phase<pg8::EpiMoeH, pg8::MoeOrderT<1>, PG8_ALIGN, PG8_SP2, true>(F.lds, g, S, E, F.wave);
                if (r0 * (int)F.G + F.vcu >= U1_ || r0 >= r1) { if (MK_STAMP_A >= 0 && blockIdx.x == MK_PROBE_BLK && F.tid == 0) F.MISC[232 + 2 * call] = (unsigned)rt(); continue; }
                asm volatile("s_waitcnt vmcnt(0)" ::: "memory"); WG_SYNC(); REFRESH();
                if (F.tid == 0) { __builtin_amdgcn_fence(__ATOMIC_RELEASE, "agent"); asm volatile("s_waitcnt vmcnt(0)" ::: "memory");
                    unsigned n_ = 0u;
                    for (int r = r0; r < r1; ++r) { const int L = r * (int)F.G + F.vcu; if (L < U1_) { (void)__hip_atomic_fetch_add(F.ctl + CW_RDY + 64 * (L >> 1), 1u, RLX_AGENT); ++n_; } }
                    (void)__hip_atomic_fetch_add(F.ctl + CW_RDYTOT + 64 * call, n_, RLX_AGENT); }
                if (MK_STAMP_A >= 0 && blockIdx.x == MK_PROBE_BLK && F.tid == 0) F.MISC[232 + 2 * call] = (unsigned)rt();
            }
        }
        if (MK_STAMP_A >= 0 && blockIdx.x == MK_PROBE_BLK && F.tid == 0) { const unsigned long long t_ = rt(); F.MISC[32 + 2 * 11] = (unsigned)t_; }
#ifdef MK_DEP_BARRIER
        xcd_barrier(bar);
#endif
        if (IN(12)) {
            WG_SYNC();
            REFRESH();
            const int U1_ = 2 * pre[32], fu_ = (U1_ / (int)F.G) * (int)F.G;
            pg8::MoeOrder2 S{pre, t2e, (LAS unsigned*)(pre + 98), F.ctl + CW_RDY, F.ctl + CW_RDYTOT, pre[96], pre[97], pre[99], pre[100], F.wave, fu_ >> 1, (unsigned)fu_, (unsigned)U1_};
            pg8::Gemm g{wsp<pg8::bf16_t>(F, WS_HS), wsp<pg8::bf16_t>(F, W_E2), 0, 0, 256};
            pg8::EpiMoeY E{wsp<pg8::bf16_t>(F, WS_YS)};
            pg8::gemm_phase<pg8::EpiMoeY, pg8::MoeOrder2, PG8_ALIGN, PG8_SP2, false>(F.lds, g, S, E, F.wave);
            if (MK_STAMP_A >= 0 && blockIdx.x == MK_PROBE_BLK && F.tid == 0) F.MISC[236] = (unsigned)rt();
        }
    } SEAM(12);
    if (MK_STAMP_A >= 0 && blockIdx.x == MK_PROBE_BLK && F.tid == 0) { const unsigned t_ = (unsigned)rt(); F.MISC[238] = t_; F.MISC[242] = t_; F.MISC[240] = F.MISC[230]; }

    if (IN(13)) { REFRESH(); final_phase(F); if (REP(14)) final_phase(F); }
    if (MK_STAMP_A >= 0) {
        xcd_barrier(bar);
        if (blockIdx.x == MK_PROBE_BLK) { if (F.tid == 0) { F.MISC[32 + 2 * 13] = (unsigned)rt();
                const unsigned a0_ = F.MISC[30 + 2 * MK_STAMP_A], a1_ = F.MISC[32 + 2 * MK_STAMP_A]; F.out[0] = (float)(a1_ - a0_) * 0.01f * (MK_STAMP_A >= 100 ? 1.0f : 0.25f);
                const unsigned b0_ = F.MISC[30 + 2 * (MK_STAMP_B < 0 ? 0 : MK_STAMP_B)], b1_ = F.MISC[32 + 2 * (MK_STAMP_B < 0 ? 0 : MK_STAMP_B)]; F.MISC[29] = __builtin_bit_cast(unsigned, (MK_STAMP_B >= 100 ? 0.032f : 0.008f) * sqrtf((float)(b1_ - b0_) * 0.01f)); }
            __syncthreads();
            if (MK_STAMP_B >= 0) { const float dd_ = __builtin_bit_cast(float, (unsigned)F.MISC[29]); for (int i = F.tid; i < (1 << 20); i += 512) F.out[(1 << 20) + i] += dd_; } }
    }
#undef IN
#undef SEAM
#undef REFRESH
}

constexpr int N_PHASES = 14;
#ifndef MK_ONE_LAUNCH
#define MK_ONE_LAUNCH 1
#endif
extern "C" void kernel_launch(void* const* d_in, const int* in_sizes, int n_in, void* d_out, int out_size, void* d_ws, size_t ws_size, hipStream_t stream) {
    static int grid = 0;
    if (grid == 0) {
        if (n_in != 26 || in_sizes[0] != T * DM || out_size != T * DM || ws_size < WS_END) { fprintf(stderr, "kernel_launch: unexpected shapes (n_in %d, in0 %d, out %d, ws %zu); nothing launched\n", n_in, n_in > 0 ? in_sizes[0] : -1, out_size, ws_size); grid = -1; return; }
        int dev = 0, cus = 0, per_cu = 0;
        if (hipGetDevice(&dev) != hipSuccess || hipDeviceGetAttribute(&cus, hipDeviceAttributeMultiprocessorCount, dev) != hipSuccess) { grid = -1; return; }
        if (hipFuncSetAttribute((const void*)fwd_kernel, hipFuncAttributeMaxDynamicSharedMemorySize, LDS_BYTES) != hipSuccess) { fprintf(stderr, "kernel_launch: hipFuncSetAttribute failed\n"); grid = -1; return; }
        if (hipOccupancyMaxActiveBlocksPerMultiprocessor(&per_cu, (const void*)fwd_kernel, NWAVES * 64, LDS_BYTES) != hipSuccess || per_cu < 1) { fprintf(stderr, "kernel_launch: occupancy query says %d blocks per CU\n", per_cu); }
        (void)hipGetLastError();
        grid = cus;
    }
    if (grid < 0) return;
    if (hipMemsetAsync((char*)d_ws + WS_CTL, 0, CTL_ZERO_BYTES, stream) != hipSuccess) return;
    Args a{};
    for (int i = 0; i < 26; ++i) a.in[i] = (const float*)d_in[i];
    a.out = (float*)d_out; a.ws = (unsigned char*)d_ws;
#if MK_ONE_LAUNCH
    a.ph_lo = 0; a.ph_hi = N_PHASES;
    hipLaunchKernelGGL(fwd_kernel, dim3(grid), dim3(NWAVES * 64), LDS_BYTES, stream, a);
#else
    for (int p = 0; p < N_PHASES; ++p) { a.ph_lo = p; a.ph_hi = p + 1; hipLaunchKernelGGL(fwd_kernel, dim3(grid), dim3(NWAVES * 64), LDS_BYTES, stream, a); }
#endif
}
```

```cpp
#include <hip/hip_runtime.h>
#include <hip/hip_bf16.h>
#include <cstdio>
#include <cstdint>
#include <cmath>
namespace pg8 {
#define PG8_LAS __attribute__((address_space(3)))
typedef unsigned short bf16_t;
typedef short bf16x8 __attribute__((ext_vector_type(8)));
typedef float f32x4 __attribute__((ext_vector_type(4)));
typedef unsigned u32x4 __attribute__((ext_vector_type(4)));
constexpr int BM = 256, BK = 64, HALF = 128, HTB = HALF * BK * 2  , STAGE_BYTES = 8 * HTB, NXCD = 8, WGM = 8;

__host__ __device__ __forceinline__ int lds_byte(int r, int c) { const int st = (r >> 4) * 2 + (c >> 5), rr = r & 15, cc = c & 31, ob = rr * 64 + cc * 2; return st * 1024 + (ob ^ (((ob >> 9) & 1) << 5)); }
__host__ __device__ __forceinline__ void stage_rc(int b, int& R, int& C) { const int st = b / 1024, sb = b % 1024, swz = sb ^ (((sb >> 9) & 1) << 5); R = (st >> 1) * 16 + swz / 64; C = (st & 1) * 32 + (swz % 64) / 2; }
__host__ __device__ __forceinline__ int perm32(int rho) { const int n = rho >> 4, i = rho & 15; return 8 * (i >> 2) + 4 * n + (i & 3); }

struct Unit { int pm, pn; };
struct Gemm { const bf16_t* A; const bf16_t* Bt; int M, N, K; };

struct StaticOrder {
    int nM, nN, nwg, G, c;
    __host__ __device__ void init(int M, int N, int G_, int c_) { nM = M / BM; nN = N / BM; nwg = nM * nN; G = G_; c = c_; }
    __host__ __device__ bool next(int i, Unit& u) const {
        const long L = (long)i * G + c; if (L >= nwg) return false;
        int wgid = (int)L; { const int q = nwg / NXCD, r = nwg % NXCD, xcd = wgid % NXCD, off = wgid / NXCD; wgid = (xcd < r ? xcd * (q + 1) : r * (q + 1) + (xcd - r) * q) + off; }
        const int nig = WGM * nN, gid = wgid / nig, fm = gid * WGM, gsz = (nM - fm) < WGM ? (nM - fm) : WGM;
        u.pm = fm + ((wgid % nig) % gsz); u.pn = (wgid % nig) / gsz; return true;
    }
    __device__ __forceinline__ void a_ready(const Unit&) const {}
    __device__ __forceinline__ void done(const Unit&) const {}
};

__device__ __forceinline__ unsigned cvt_pk_bf16(float lo, float hi) { unsigned r; asm volatile("v_cvt_pk_bf16_f32 %0, %1, %2" : "=v"(r) : "v"(lo), "v"(hi)); return r; }
typedef float f32x2 __attribute__((ext_vector_type(2)));
__device__ __forceinline__ f32x2 gelu_pk(f32x2 v) {
    const f32x2 av = __builtin_elementwise_abs(v), d = av * 0.2316418882f + 1.0f;
    f32x2 t; t.x = __builtin_amdgcn_rcpf(d.x); t.y = __builtin_amdgcn_rcpf(d.y);
    f32x2 q = t * 0.5307027145f + (-0.7265760135f); q = q * t + 0.7107068705f; q = q * t + (-0.142248368f); q = q * t + 0.127414796f; q = q * t;
    const f32x2 s = (v * v) * (-0.72134752044f);
    f32x2 e; e.x = __builtin_amdgcn_exp2f(s.x); e.y = __builtin_amdgcn_exp2f(s.y);
    const f32x2 m = v * (q * e), r = v - m;
    f32x2 o; o.x = v.x < 0.f ? m.x : r.x; o.y = v.y < 0.f ? m.y : r.y; return o;
}

template <int ACT  > struct EpiBf16 {
    static constexpr bool PERM = true, AFTER_DRAIN = false; static_assert(ACT == 0 || ACT == 1, "EpiBf16: ACT is 0 (none) or 1 (gelu_pk)");
    bf16_t* O; int ldc; const float* bias; int split_cols; size_t split_stride; float scale0;
    __device__ __forceinline__ void operator()(const f32x4 (&acc)[2][2][4][2], const Unit& u, int wr, int wc, int fr, int fq) const {
        const int row0 = u.pm * BM + wr * 64 + fr; int colt = u.pn * BM; bf16_t* base = O;
        float sc = 1.f; if (split_cols) { const int t = colt / split_cols; base += (size_t)t * split_stride; colt -= t * split_cols; if (t == 0) sc = scale0; }
        const int col0 = colt + wc * 32 + 8 * fq, bcol0 = u.pn * BM + wc * 32 + 8 * fq;
        f32x4 bv[2][2];
#pragma unroll
        for (int bj = 0; bj < 2; ++bj)
#pragma unroll
            for (int n = 0; n < 2; ++n) bv[bj][n] = bias ? *(const f32x4*)(bias + bcol0 + bj * HALF + 4 * n) : (f32x4){0.f, 0.f, 0.f, 0.f};
#pragma unroll
        for (int ai = 0; ai < 2; ++ai)
#pragma unroll
            for (int m = 0; m < 4; ++m) { bf16_t* rowp = base + (size_t)(row0 + ai * HALF + m * 16) * ldc + col0;
#pragma unroll
                for (int bj = 0; bj < 2; ++bj) { f32x4 v0 = acc[ai][bj][m][0] + bv[bj][0], v1 = acc[ai][bj][m][1] + bv[bj][1];
                    if (ACT == 1) { f32x2 a = gelu_pk((f32x2){v0[0], v0[1]}), b = gelu_pk((f32x2){v0[2], v0[3]}), c = gelu_pk((f32x2){v1[0], v1[1]}), d = gelu_pk((f32x2){v1[2], v1[3]});
                        v0 = (f32x4){a.x, a.y, b.x, b.y}; v1 = (f32x4){c.x, c.y, d.x, d.y}; }
                    v0 = v0 * sc; v1 = v1 * sc; u32x4 w; w.x = cvt_pk_bf16(v0[0], v0[1]); w.y = cvt_pk_bf16(v0[2], v0[3]); w.z = cvt_pk_bf16(v1[0], v1[1]); w.w = cvt_pk_bf16(v1[2], v1[3]);
                    *(u32x4*)(rowp + bj * HALF) = w; } }
    }
};
__device__ __forceinline__ u32x4 pack8(const f32x4& a, const f32x4& b) { u32x4 w; w.x = cvt_pk_bf16(a[0], a[1]); w.y = cvt_pk_bf16(a[2], a[3]); w.z = cvt_pk_bf16(b[0], b[1]); w.w = cvt_pk_bf16(b[2], b[3]); return w; }
__device__ __forceinline__ unsigned short f2bf_rne(float f) { unsigned u = __builtin_bit_cast(unsigned, f); return (unsigned short)((u + 0x7fffu + ((u >> 16) & 1u)) >> 16); }
__device__ __forceinline__ f32x4 bf_lo4(const u32x4& w) { return (f32x4){__builtin_bit_cast(float, w.x << 16), __builtin_bit_cast(float, w.x & 0xffff0000u), __builtin_bit_cast(float, w.y << 16), __builtin_bit_cast(float, w.y & 0xffff0000u)}; }
__device__ __forceinline__ f32x4 bf_hi4(const u32x4& w) { return (f32x4){__builtin_bit_cast(float, w.z << 16), __builtin_bit_cast(float, w.z & 0xffff0000u), __builtin_bit_cast(float, w.w << 16), __builtin_bit_cast(float, w.w & 0xffff0000u)}; }
__device__ __forceinline__ f32x4 sigmoid4(const f32x4& v) { f32x4 r;
#pragma unroll
    for (int i = 0; i < 4; ++i) r[i] = __builtin_amdgcn_rcpf(1.0f + __builtin_amdgcn_exp2f(-1.4426950408889634f * v[i]));
    return r; }

struct EpiRope {
    static constexpr bool PERM = true, AFTER_DRAIN = false;
    bf16_t* O0; size_t tstride; const float* rstd; const float* rope;
    __device__ __forceinline__ void operator()(const f32x4 (&acc)[2][2][4][2], const Unit& u, int wr, int wc, int fr, int fq) const {
        bf16_t* base = O0 + (size_t)(u.pn >> 1) * tstride + (((u.pn & 1) * 4 + wc) * 64 + 8 * fq);
        const int row0 = u.pm * BM + wr * 64 + fr;
#pragma unroll
        for (int ai = 0; ai < 2; ++ai)
#pragma unroll
            for (int m = 0; m < 4; ++m) {
                const int row = row0 + ai * HALF + m * 16; const float rs = rstd[row];
                const float* rp = rope + (size_t)row * 64 + 8 * fq;
                const f32x4 c0 = *(const f32x4*)rp, c1 = *(const f32x4*)(rp + 4), s0 = *(const f32x4*)(rp + 32), s1 = *(const f32x4*)(rp + 36);
                const f32x4 x1a = acc[ai][0][m][0] * rs, x1b = acc[ai][0][m][1] * rs, x2a = acc[ai][1][m][0] * rs, x2b = acc[ai][1][m][1] * rs;
                bf16_t* op = base + (size_t)row * 512;
                *(u32x4*)op = pack8(x1a * c0 - x2a * s0, x1b * c1 - x2b * s1);
                *(u32x4*)(op + 32) = pack8(x2a * c0 + x1a * s0, x2b * c1 + x1b * s1);
            }
    }
};
struct EpiScale {
    static constexpr bool PERM = true, AFTER_DRAIN = false;
    bf16_t* O; int ldc; const float* rstd; const float* rowsq; float eps;
    __device__ __forceinline__ void operator()(const f32x4 (&acc)[2][2][4][2], const Unit& u, int wr, int wc, int fr, int fq) const {
        const int row0 = u.pm * BM + wr * 64 + fr, col0 = u.pn * BM + wc * 32 + 8 * fq;
#pragma unroll
        for (int ai = 0; ai < 2; ++ai)
#pragma unroll
            for (int m = 0; m < 4; ++m) {
                const int row = row0 + ai * HALF + m * 16;
                const float rs = rstd ? rstd[row] : (rowsq ? __builtin_amdgcn_rsqf(rowsq[row] * (1.0f / 1024.0f) + eps) : 1.0f);
                bf16_t* op = O + (size_t)row * ldc + col0;
#pragma unroll
                for (int bj = 0; bj < 2; ++bj) *(u32x4*)(op + bj * HALF) = pack8(acc[ai][bj][m][0] * rs, acc[ai][bj][m][1] * rs);
            }
    }
};
struct EpiMemKV {
    static constexpr bool PERM = true, AFTER_DRAIN = false;
    bf16_t* KXH; bf16_t* VH; const float* rstd;
    __device__ __forceinline__ void operator()(const f32x4 (&acc)[2][2][4][2], const Unit& u, int wr, int wc, int fr, int fq) const {
        const int row0 = u.pm * BM + wr * 64 + fr, col0 = (u.pn & 3) * BM + wc * 32 + 8 * fq; bf16_t* base = u.pn < 4 ? KXH : VH;
#pragma unroll
        for (int ai = 0; ai < 2; ++ai)
#pragma unroll
            for (int m = 0; m < 4; ++m) {
                const int row = row0 + ai * HALF + m * 16; const float rs = rstd[row]; const int b = row >> 8, key = row & 255;
#pragma unroll
                for (int bj = 0; bj < 2; ++bj) { const int col = col0 + bj * HALF, h = col >> 8, d = col & 255;
                    *(u32x4*)(base + ((size_t)(b * 4 + h) * 256 + key) * 256 + d) = pack8(acc[ai][bj][m][0] * rs, acc[ai][bj][m][1] * rs); }
            }
    }
};
struct EpiGlu {
    static constexpr bool PERM = true, AFTER_DRAIN = false;
    bf16_t* U; const float* rstd;
    __device__ __forceinline__ void operator()(const f32x4 (&acc)[2][2][4][2], const Unit& u, int wr, int wc, int fr, int fq) const {
        const int row0 = u.pm * BM + wr * 64 + fr, col0 = u.pn * HALF + wc * 32 + 8 * fq;
#pragma unroll
        for (int ai = 0; ai < 2; ++ai)
#pragma unroll
            for (int m = 0; m < 4; ++m) {
                const int row = row0 + ai * HALF + m * 16; const float rs = rstd[row];
                const f32x4 a0 = acc[ai][0][m][0] * rs, a1 = acc[ai][0][m][1] * rs, b0 = acc[ai][1][m][0] * rs, b1 = acc[ai][1][m][1] * rs;
                *(u32x4*)(U + (size_t)row * 512 + col0) = pack8(a0 * sigmoid4(b0), a1 * sigmoid4(b1));
            }
    }
};
struct EpiKiWi {
    static constexpr bool PERM = true, AFTER_DRAIN = false;
    bf16_t* KI; float* WI; const float* rstd; const float* rope;
    __device__ __forceinline__ void operator()(const f32x4 (&acc)[2][2][4][2], const Unit& u, int wr, int wc, int fr, int fq) const {
        const int row0 = u.pm * BM + wr * 64 + fr;
        if (wc == 0) {
#pragma unroll
            for (int ai = 0; ai < 2; ++ai)
#pragma unroll
                for (int m = 0; m < 4; ++m) {
                    const int row = row0 + ai * HALF + m * 16; const float rs = rstd[row];
                    const float* rp = rope + (size_t)row * 64 + 8 * fq;
                    const f32x4 c0 = *(const f32x4*)rp, c1 = *(const f32x4*)(rp + 4), s0 = *(const f32x4*)(rp + 32), s1 = *(const f32x4*)(rp + 36);
                    const f32x4 x1a = acc[ai][0][m][0] * rs, x1b = acc[ai][0][m][1] * rs, x2a = acc[ai][1][m][0] * rs, x2b = acc[ai][1][m][1] * rs;
                    bf16_t* op = KI + (((size_t)(row >> 5) * 4 + (fq >> 1)) * 64 + (fq & 1) * 32 + (row & 31)) * 8;
                    *(u32x4*)op = pack8(x1a * c0 - x2a * s0, x1b * c1 - x2b * s1);
                    *(u32x4*)(op + 2 * 64 * 8) = pack8(x2a * c0 + x1a * s0, x2b * c1 + x1b * s1);
                }
        } else if (wc == 1 && fq == 0) {
#pragma unroll
            for (int ai = 0; ai < 2; ++ai)
#pragma unroll
                for (int m = 0; m < 4; ++m) {
                    const int row = row0 + ai * HALF + m * 16; const float rs = rstd[row];
                    float* op = WI + (size_t)row * 8;
                    *(f32x4*)op = acc[ai][0][m][0] * rs; *(f32x4*)(op + 4) = acc[ai][0][m][1] * rs;
                }
        }
    }
};
struct EpiMerge {
    static constexpr bool PERM = true, AFTER_DRAIN = false;
    const bf16_t* YA; const bf16_t* YC; bf16_t* MG; const float* rstd;
    __device__ __forceinline__ void operator()(const f32x4 (&acc)[2][2][4][2], const Unit& u, int wr, int wc, int fr, int fq) const {
        const int row0 = u.pm * BM + wr * 64 + fr, col0 = u.pn * HALF + wc * 32 + 8 * fq;
#pragma unroll
        for (int ai = 0; ai < 2; ++ai)
#pragma unroll
            for (int m = 0; m < 4; ++m) {
                const int row = row0 + ai * HALF + m * 16; const float rs = rstd[row]; const size_t off = (size_t)row * 1024 + col0;
                const u32x4 ya = *(const u32x4*)(YA + off), yc = *(const u32x4*)(YC + off);
                const f32x4 o0 = sigmoid4(acc[ai][0][m][0] * rs) * bf_lo4(ya) + sigmoid4(acc[ai][1][m][0] * rs) * bf_lo4(yc);
                const f32x4 o1 = sigmoid4(acc[ai][0][m][1] * rs) * bf_hi4(ya) + sigmoid4(acc[ai][1][m][1] * rs) * bf_hi4(yc);
                *(u32x4*)(MG + off) = pack8(o0, o1);
            }
    }
};
struct EpiResid {
    static constexpr bool PERM = true, AFTER_DRAIN = false;
    const bf16_t* resid; bf16_t* xb; float* rowsq;
    __device__ __forceinline__ void operator()(const f32x4 (&acc)[2][2][4][2], const Unit& u, int wr, int wc, int fr, int fq) const {
        const int row0 = u.pm * BM + wr * 64 + fr, col0 = (u.pn & 3) * BM + wc * 32 + 8 * fq;
#pragma unroll
        for (int ai = 0; ai < 2; ++ai)
#pragma unroll
            for (int m = 0; m < 4; ++m) {
                const int row = row0 + ai * HALF + m * 16; float ss = 0.f;
#pragma unroll
                for (int bj = 0; bj < 2; ++bj) { const size_t off = (size_t)row * 1024 + col0 + bj * HALF;
                    const u32x4 rw = *(const u32x4*)(resid + off);
                    const f32x4 v0 = bf_lo4(rw) + acc[ai][bj][m][0], v1 = bf_hi4(rw) + acc[ai][bj][m][1];
                    *(u32x4*)(xb + off) = pack8(v0, v1);
                    ss += (v0[0] * v0[0] + v0[1] * v0[1]) + (v0[2] * v0[2] + v0[3] * v0[3]) + (v1[0] * v1[0] + v1[1] * v1[1]) + (v1[2] * v1[2] + v1[3] * v1[3]); }
                ss += __shfl_xor(ss, 16); ss += __shfl_xor(ss, 32);
                if (fq == 0) atomicAdd(rowsq + row, ss);
            }
    }
};
struct EpiInProj {
    static constexpr bool PERM = true, AFTER_DRAIN = false;
    EpiRope rope; EpiScale v; EpiGlu glu; EpiKiWi kw;
    __device__ __forceinline__ void operator()(const f32x4 (&acc)[2][2][4][2], const Unit& u, int wr, int wc, int fr, int fq) const {
        if (u.pn < 6) rope(acc, u, wr, wc, fr, fq);
        else if (u.pn < 8) { Unit u2 = u; u2.pn -= 6; v(acc, u2, wr, wc, fr, fq); }
        else if (u.pn < 12) { Unit u2 = u; u2.pn -= 8; glu(acc, u2, wr, wc, fr, fq); }
        else { Unit u2 = u; u2.pn = 0; kw(acc, u2, wr, wc, fr, fq); }
    }
};
template <int LOGN> struct MoeOrderT {
    const PG8_LAS int* pre; const PG8_LAS int* cnt; const PG8_LAS unsigned char* t2e; const int* list; int G, c, Tcap, r0, r1;
    __device__ __forceinline__ bool next(int i, Unit& u) const {
        if (i + r0 >= r1) return false;
        const long L = (long)(i + r0) * G + c; const int ntiles = pre[32]; if (L >= ((long)ntiles << LOGN)) return false;
        const int t = (int)(L >> LOGN), n = (int)(L & ((1 << LOGN) - 1)); const int e = t2e[t];
        u.pm = t; u.pn = (e << LOGN) + n; return true;
    }
    __device__ __forceinline__ unsigned arow(const Unit& u, int r) const {
        const int e = u.pn >> LOGN, slot = (u.pm - pre[e]) * 256 + r; return (unsigned)list[(size_t)e * Tcap + (slot < cnt[e] ? slot : 0)];
    }
    __device__ __forceinline__ void a_ready(const Unit&) const {}
    __device__ __forceinline__ void done(const Unit&) const {}
};
typedef MoeOrderT<1> MoeOrder;
typedef __attribute__((address_space(1))) unsigned moe_gu32;
struct MoeOrder2 {
    const PG8_LAS int* pre; const PG8_LAS unsigned char* t2e; PG8_LAS unsigned* dflag; moe_gu32* ready; moe_gu32* tot; int gs, ge, j, gstr, wave, late; unsigned fullu, allu;
    __device__ __forceinline__ bool next(int i, Unit& u) const {
        const int L = gs + i * gstr + j; if (L >= ge) return false;
        const int t = L >> 2, n = L & 3, e = t2e[t]; u.pm = t; u.pn = (e << 2) + n; wait_tile(u, (unsigned)i); return true;
    }
    __device__ __forceinline__ unsigned arow(const Unit&, int) const { return 0u; }
    __device__ __forceinline__ void a_ready(const Unit&) const {}
    __device__ __forceinline__ void wait_tile(const Unit& u, unsigned i) const {
        const unsigned df = (unsigned)__builtin_amdgcn_readfirstlane((int)*dflag), st = df >> 16;
        const bool islate = u.pm >= late;
        if ((st == 0xFFFFu || (st == 0xFFFDu && !islate) || st == (unsigned)u.pm) && (df & 0xFFFFu) <= i) return;
        if (wave == 0) {
            unsigned polls = 0;
            if (islate) { while ((unsigned)__builtin_amdgcn_readfirstlane((int)__hip_atomic_load(ready + 64 * u.pm, __ATOMIC_RELAXED, __HIP_MEMORY_SCOPE_AGENT)) < 2u && ++polls < (1u << 21)) __builtin_amdgcn_s_sleep(2); }
            else { while ((unsigned)__builtin_amdgcn_readfirstlane((int)__hip_atomic_load(tot, __ATOMIC_RELAXED, __HIP_MEMORY_SCOPE_AGENT)) < fullu && ++polls < (1u << 21)) __builtin_amdgcn_s_sleep(2); }
            const unsigned tt = (unsigned)__builtin_amdgcn_readfirstlane((int)__hip_atomic_load(tot, __ATOMIC_RELAXED, __HIP_MEMORY_SCOPE_AGENT))
                              + (unsigned)__builtin_amdgcn_readfirstlane((int)__hip_atomic_load(tot + 64, __ATOMIC_RELAXED, __HIP_MEMORY_SCOPE_AGENT));
            __builtin_amdgcn_fence(__ATOMIC_ACQUIRE, "agent");
            asm volatile("s_waitcnt vmcnt(0)" ::: "memory");
            *dflag = ((tt >= allu ? 0xFFFFu : (islate ? (unsigned)u.pm : 0xFFFDu)) << 16) | (i + 1u);
            asm volatile("s_waitcnt lgkmcnt(0)" ::: "memory");
        }
        asm volatile("" ::: "memory"); __builtin_amdgcn_s_barrier(); asm volatile("" ::: "memory");
    }
    __device__ __forceinline__ void done(const Unit&) const {}
};
struct EpiMoeH {
    static constexpr bool PERM = true, AFTER_DRAIN = false;
    bf16_t* HS; const float* rowsq; const float* cE; float eps; MoeOrder S;
    __device__ __forceinline__ void operator()(const f32x4 (&acc)[2][2][4][2], const Unit& u, int wr, int wc, int fr_, int fq_) const {
        int fr = fr_, fq = fq_; asm volatile("" : "+v"(fr), "+v"(fq));
        const int e = u.pn >> 1, nt = u.pn & 1, slot0 = (u.pm - S.pre[e]) * 256, ne = S.cnt[e];
#pragma unroll
        for (int ai = 0; ai < 2; ++ai)
#pragma unroll
            for (int m = 0; m < 4; ++m) {
                const int r = ai * HALF + wr * 64 + m * 16 + fr, slot = slot0 + r; const bool live = slot < ne;
                const int tok = S.list[(size_t)e * S.Tcap + (live ? slot : 0)];
                const float rs = __builtin_amdgcn_rsqf(rowsq[tok] * (1.0f / 1024.0f) + eps), cw = live ? cE[(size_t)e * S.Tcap + slot] : 0.f;
                const f32x4 g0 = acc[ai][0][m][0] * rs, g1 = acc[ai][0][m][1] * rs, u0 = acc[ai][1][m][0] * (rs * cw), u1 = acc[ai][1][m][1] * (rs * cw);
                *(u32x4*)(HS + ((size_t)u.pm * 256 + r) * 256 + nt * HALF + wc * 32 + 8 * fq) = pack8(g0 * sigmoid4(g0) * u0, g1 * sigmoid4(g1) * u1);
            }
    }
};
struct EpiMoeY {
    static constexpr bool PERM = true, AFTER_DRAIN = false;
    bf16_t* YS;
    __device__ __forceinline__ void operator()(const f32x4 (&acc)[2][2][4][2], const Unit& u, int wr, int wc, int fr_, int fq_) const {
        int fr = fr_, fq = fq_; asm volatile("" : "+v"(fr), "+v"(fq));
        const int col0 = (u.pn & 3) * BM + wc * 32 + 8 * fq;
#pragma unroll
        for (int ai = 0; ai < 2; ++ai)
#pragma unroll
            for (int m = 0; m < 4; ++m) { bf16_t* op = YS + ((size_t)u.pm * 256 + ai * HALF + wr * 64 + m * 16 + fr) * 1024 + col0;
#pragma unroll
                for (int bj = 0; bj < 2; ++bj) *(u32x4*)(op + bj * HALF) = pack8(acc[ai][bj][m][0], acc[ai][bj][m][1]); }
    }
};
struct BatchOrder : StaticOrder {
    __device__ __forceinline__ bool next(int i, Unit& u) const { if (!StaticOrder::next(i, u)) return false; u.pn += (u.pm >> 4) * 4; return true; }
};
struct WkOrder { int G, c;
    __device__ __forceinline__ bool next(int i, Unit& u) const { const int L = i * G + c; if (L >= 128) return false; u.pm = L >> 2; u.pn = ((L >> 2) & 3) * 4 + (L & 3); return true; }
    __device__ __forceinline__ void a_ready(const Unit&) const {} __device__ __forceinline__ void done(const Unit&) const {} };
struct VwOrder { int G, c;
    __device__ __forceinline__ bool next(int i, Unit& u) const { const int L = i * G + c; if (L >= 128) return false; const int b = L >> 4, h = (L >> 2) & 3, mt = L & 3; u.pm = h * 4 + mt; u.pn = b * 4 + h; return true; }
    __device__ __forceinline__ void a_ready(const Unit&) const {} __device__ __forceinline__ void done(const Unit&) const {} };
struct EpiWk {
    static constexpr bool PERM = true, AFTER_DRAIN = false;
    bf16_t* O;
    __device__ __forceinline__ void operator()(const f32x4 (&acc)[2][2][4][2], const Unit& u, int wr, int wc, int fr, int fq) const {
        const int col0 = (u.pn & 3) * BM + wc * 32 + 8 * fq;
#pragma unroll
        for (int ai = 0; ai < 2; ++ai)
#pragma unroll
            for (int m = 0; m < 4; ++m) { bf16_t* op = O + ((size_t)u.pm * 256 + ai * HALF + wr * 64 + m * 16 + fr) * 1024 + col0;
#pragma unroll
                for (int bj = 0; bj < 2; ++bj) *(u32x4*)(op + bj * HALF) = pack8(acc[ai][bj][m][0], acc[ai][bj][m][1]); }
    }
};
struct EpiVw {
    static constexpr bool PERM = true, AFTER_DRAIN = false;
    bf16_t* O;
    __device__ __forceinline__ void operator()(const f32x4 (&acc)[2][2][4][2], const Unit& u, int wr, int wc, int fr, int fq) const {
        const int b = u.pn >> 2, h = u.pn & 3, mt = u.pm & 3, col0 = h * BM + wc * 32 + 8 * fq;
#pragma unroll
        for (int ai = 0; ai < 2; ++ai)
#pragma unroll
            for (int m = 0; m < 4; ++m) { bf16_t* op = O + ((size_t)b * 1024 + mt * 256 + ai * HALF + wr * 64 + m * 16 + fr) * 1024 + col0;
#pragma unroll
                for (int bj = 0; bj < 2; ++bj) *(u32x4*)(op + bj * HALF) = pack8(acc[ai][bj][m][0], acc[ai][bj][m][1]); }
    }
};
struct EpiSoftmax {
    static constexpr bool PERM = true, AFTER_DRAIN = false;
    bf16_t* P; const float* rowsq; float eps; PG8_LAS float* X;
    __device__ __forceinline__ void operator()(const f32x4 (&acc)[2][2][4][2], const Unit& u, int wr, int wc, int fr_, int fq_) const {
        int fr = fr_, fq = fq_; asm volatile("" : "+v"(fr), "+v"(fq));
#pragma unroll
        for (int ai = 0; ai < 2; ++ai)
#pragma unroll
            for (int m = 0; m < 4; ++m) { const int rl = ai * HALF + wr * 64 + m * 16 + fr; const float rs = __builtin_amdgcn_rsqf(rowsq[u.pm * BM + rl] * (1.0f / 1024.0f) + eps);
                float mx = -3.0e38f;
#pragma unroll
                for (int bj = 0; bj < 2; ++bj)
#pragma unroll
                    for (int n = 0; n < 2; ++n)
#pragma unroll
                        for (int j = 0; j < 4; ++j) mx = fmaxf(mx, acc[ai][bj][m][n][j] * rs);
                mx = fmaxf(mx, __shfl_xor(mx, 16)); mx = fmaxf(mx, __shfl_xor(mx, 32));
                float s = 0.f;
#pragma unroll
                for (int bj = 0; bj < 2; ++bj)
#pragma unroll
                    for (int n = 0; n < 2; ++n)
#pragma unroll
                        for (int j = 0; j < 4; ++j) s += __builtin_amdgcn_exp2f(acc[ai][bj][m][n][j] * rs - mx);
                s += __shfl_xor(s, 16); s += __shfl_xor(s, 32);
                if (fq == 0) { X[(rl * 4 + wc) * 2] = mx; X[(rl * 4 + wc) * 2 + 1] = s; } }
        asm volatile("s_waitcnt lgkmcnt(0)" ::: "memory"); __builtin_amdgcn_s_barrier(); asm volatile("" ::: "memory");
        const int col0 = (u.pn & 3) * BM + wc * 32 + 8 * fq;
#pragma unroll
        for (int ai = 0; ai < 2; ++ai)
#pragma unroll
            for (int m = 0; m < 4; ++m) { const int rl = ai * HALF + wr * 64 + m * 16 + fr; const float rs = __builtin_amdgcn_rsqf(rowsq[u.pm * BM + rl] * (1.0f / 1024.0f) + eps);
                const f32x4 xa = *(const PG8_LAS f32x4*)(X + rl * 8), xb = *(const PG8_LAS f32x4*)(X + rl * 8 + 4);
                const float M = fmaxf(fmaxf(xa[0], xa[2]), fmaxf(xb[0], xb[2]));
                const float S = xa[1] * __builtin_amdgcn_exp2f(xa[0] - M) + xa[3] * __builtin_amdgcn_exp2f(xa[2] - M) + xb[1] * __builtin_amdgcn_exp2f(xb[0] - M) + xb[3] * __builtin_amdgcn_exp2f(xb[2] - M);
                const float inv = __builtin_amdgcn_rcpf(S); bf16_t* op = P + (size_t)(u.pm * BM + rl) * 1024 + col0;
#pragma unroll
                for (int bj = 0; bj < 2; ++bj) { f32x4 p0, p1;
#pragma unroll
                    for (int j = 0; j < 4; ++j) { p0[j] = __builtin_amdgcn_exp2f(acc[ai][bj][m][0][j] * rs - M) * inv; p1[j] = __builtin_amdgcn_exp2f(acc[ai][bj][m][1][j] * rs - M) * inv; }
                    *(u32x4*)(op + bj * HALF) = pack8(p0, p1); } }
        asm volatile("s_waitcnt lgkmcnt(0)" ::: "memory"); __builtin_amdgcn_s_barrier(); asm volatile("" ::: "memory");
    }
};
template <class Epi, class Sched, bool ALIGN_EPI = false, bool SP2 = false, bool GATHER = false>
__device__ __forceinline__ void gemm_phase(PG8_LAS unsigned char* lds, const Gemm g, const Sched& S, const Epi& E, int wave_) {
    int lane; asm volatile("v_mbcnt_lo_u32_b32 %0, -1, 0\n\tv_mbcnt_hi_u32_b32 %0, -1, %0" : "=v"(lane));
    const int wid = __builtin_amdgcn_readfirstlane(wave_), tid = wid * 64 + lane, wr = wid >> 2, wc = wid & 3, fr = lane & 15, fq = lane >> 4;
    const int K = g.K, nt = K / BK;
    unsigned voffA[2], voffB[2];
#pragma unroll
    for (int i = 0; i < 2; ++i) { int R, C; stage_rc(tid * 16 + i * 8192, R, C); const int Rb = Epi::PERM ? ((R & ~31) + perm32(R & 31)) : R;
        voffA[i] = (unsigned)(R * K + C) * 2u; voffB[i] = (unsigned)(Rb * K + C) * 2u; }
    unsigned cvo[2][2];
    PG8_LAS unsigned* gsl = (PG8_LAS unsigned*)(lds + STAGE_BYTES + 1024) + tid * 4;
#define PG8_GOFF(dst, un) do { _Pragma("unroll") for (int _h = 0; _h < 2; ++_h) _Pragma("unroll") for (int _i = 0; _i < 2; ++_i) { int R_, C_; stage_rc(tid * 16 + _i * 8192, R_, C_); \
        dst[_h][_i] = (unsigned)(S.arow(un, 128 * _h + R_) * K + C_) * 2u; } } while (0)
#define PG8_STAGE_A(bufoff, base, h, nsel) do { if constexpr (GATHER) { PG8_STAGE(bufoff, base, cvo[h]); } else { PG8_STAGE(bufoff, (base) + (h) * hstep, voffA); } } while (0)
    const size_t kstep = (size_t)(BK * 2);
    const size_t hstep = (size_t)HALF * K * 2;
    const size_t tstep = 2 * hstep;
    const unsigned ldsw = (unsigned)wid * 1024u;
    const int aoff = lds_byte(wr * 64 + fr, fq * 8), boff = lds_byte(wc * 32 + fr, fq * 8);
#define PG8_SA(b, h) (((b) * 2 + (h)) * HTB)
#define PG8_SB(b, h) ((4 + (b) * 2 + (h)) * HTB)
#define PG8_STAGE(bufoff, gbase, voff) do { _Pragma("unroll") for (int _i = 0; _i < 2; ++_i) \
        __builtin_amdgcn_global_load_lds((const unsigned*)((const char*)(gbase) + (voff)[_i]), (PG8_LAS unsigned*)(lds + (bufoff) + ldsw + _i * 8192), 16, 0, 0); } while (0)
#define PG8_LDA(dst, b, h) do { _Pragma("unroll") for (int m = 0; m < 4; ++m) _Pragma("unroll") for (int k = 0; k < 2; ++k) dst[m][k] = *(const PG8_LAS bf16x8*)(lds + PG8_SA(b, h) + aoff + m * 2048 + k * 1024); } while (0)
#define PG8_LDB(dst, b, h) do { _Pragma("unroll") for (int n = 0; n < 2; ++n) _Pragma("unroll") for (int k = 0; k < 2; ++k) dst[n][k] = *(const PG8_LAS bf16x8*)(lds + PG8_SB(b, h) + boff + n * 2048 + k * 1024); } while (0)
#define PG8_MMA(ai, bj, At, Bt) do { __builtin_amdgcn_s_setprio(1); _Pragma("unroll") for (int m = 0; m < 4; ++m) _Pragma("unroll") for (int n = 0; n < 2; ++n) _Pragma("unroll") for (int k = 0; k < 2; ++k) \
        acc[ai][bj][m][n] = __builtin_amdgcn_mfma_f32_16x16x32_bf16(Bt[n][k], At[m][k], acc[ai][bj][m][n], 0, 0, 0); __builtin_amdgcn_s_setprio(0); } while (0)
#define PG8_WAIT_V(n) asm volatile("s_waitcnt vmcnt(" #n ")" ::: "memory")
#define PG8_WAIT_L(n) asm volatile("s_waitcnt lgkmcnt(" #n ")" ::: "memory")
#define PG8_BAR __builtin_amdgcn_s_barrier()
#define PG8_SCHED __builtin_amdgcn_sched_barrier(0)
    Unit cur, nxt; int ui = 0;
    if (!S.next(0, cur)) return;
    f32x4 acc[2][2][4][2];
#pragma unroll
    for (int a = 0; a < 2; ++a)
#pragma unroll
        for (int b = 0; b < 2; ++b)
#pragma unroll
            for (int m = 0; m < 4; ++m)
#pragma unroll
                for (int n = 0; n < 2; ++n) acc[a][b][m][n] = (f32x4){0.f, 0.f, 0.f, 0.f};
    bf16x8 At[4][2], B0[2][2], B1[2][2];
    const char* cA = (const char*)g.A + (GATHER ? (size_t)0 : (size_t)cur.pm * tstep); const char* cB = (const char*)g.Bt + (size_t)cur.pn * tstep;
    if constexpr (GATHER) { PG8_GOFF(cvo, cur); }
    S.a_ready(cur);
    if constexpr (SP2) {
        PG8_STAGE(PG8_SB(0, 0), cB, voffB); PG8_STAGE(PG8_SB(0, 1), cB + hstep, voffB); PG8_STAGE_A(PG8_SA(0, 0), cA, 0, false); PG8_STAGE_A(PG8_SA(0, 1), cA, 1, false);
        if (wr == 1) PG8_BAR;
        PG8_WAIT_V(2); PG8_BAR;
        PG8_STAGE(PG8_SB(1, 0), cB + kstep, voffB); PG8_STAGE_A(PG8_SA(1, 0), cA + kstep, 0, false); PG8_STAGE(PG8_SB(1, 1), cB + hstep + kstep, voffB);
        PG8_WAIT_V(6); PG8_BAR;
    } else {
        PG8_STAGE(PG8_SB(0, 0), cB, voffB); PG8_STAGE(PG8_SA(0, 0), cA, voffA); PG8_STAGE(PG8_SB(0, 1), cB + hstep, voffB); PG8_STAGE(PG8_SA(0, 1), cA + hstep, voffA);
        if (wr == 1) PG8_BAR;
        PG8_WAIT_V(4); PG8_BAR;
        PG8_STAGE(PG8_SB(1, 0), cB + kstep, voffB); PG8_STAGE(PG8_SA(1, 0), cA + kstep, voffA); PG8_STAGE(PG8_SB(1, 1), cB + hstep + kstep, voffB);
        PG8_WAIT_V(6); PG8_BAR;
    }
    for (;;) {
        const bool has_next = S.next(ui + 1, nxt);
        if constexpr (GATHER) { unsigned nvo_[2][2]; if (has_next) { PG8_GOFF(nvo_, nxt); } else { _Pragma("unroll") for (int _h = 0; _h < 2; ++_h) _Pragma("unroll") for (int _i = 0; _i < 2; ++_i) nvo_[_h][_i] = cvo[_h][_i]; }
            *(PG8_LAS u32x4*)gsl = (u32x4){nvo_[0][0], nvo_[0][1], nvo_[1][0], nvo_[1][1]}; }
        const char* nA = GATHER ? cA : (has_next ? (const char*)g.A + (size_t)nxt.pm * tstep : cA); const char* nB = has_next ? (const char*)g.Bt + (size_t)nxt.pn * tstep : cB;
        for (int t = 0; t < nt; t += 2) {
            const bool last = (t == nt - 2);
            const char* a1 = cA + (size_t)(t + 1) * kstep;
            const char* a2 = last ? nA : cA + (size_t)(t + 2) * kstep; const char* b2 = last ? nB : cB + (size_t)(t + 2) * kstep;
            const char* a3 = a2 + kstep; const char* b3 = b2 + kstep;
            if (last && has_next) S.a_ready(nxt);
            if constexpr (SP2) {
            PG8_LDB(B0, 0, 0); PG8_LDB(B1, 0, 1); PG8_SCHED; PG8_LDA(At, 0, 0); PG8_STAGE_A(PG8_SA(1, 1), a1, 1, false);
            if constexpr (GATHER) { if (last) { const u32x4 nv_ = *(const PG8_LAS u32x4*)gsl; cvo[0][0] = nv_.x; cvo[0][1] = nv_.y; cvo[1][0] = nv_.z; cvo[1][1] = nv_.w; } }
            PG8_WAIT_V(8); PG8_WAIT_L(0); PG8_BAR; PG8_MMA(0, 0, At, B0); PG8_MMA(0, 1, At, B1); PG8_BAR; PG8_SCHED;
            PG8_LDA(At, 0, 1); PG8_STAGE(PG8_SB(0, 0), b2, voffB); PG8_STAGE(PG8_SB(0, 1), b2 + hstep, voffB); PG8_STAGE_A(PG8_SA(0, 0), a2, 0, last);
            PG8_WAIT_V(8); PG8_WAIT_L(0); PG8_BAR; PG8_MMA(1, 0, At, B0); PG8_MMA(1, 1, At, B1); PG8_BAR; PG8_SCHED;
            PG8_LDB(B0, 1, 0); PG8_LDB(B1, 1, 1); PG8_SCHED; PG8_LDA(At, 1, 0); PG8_STAGE_A(PG8_SA(0, 1), a2, 1, last);
            PG8_WAIT_V(8); PG8_WAIT_L(0); PG8_BAR; PG8_MMA(0, 0, At, B0); PG8_MMA(0, 1, At, B1); PG8_BAR; PG8_SCHED;
            PG8_LDA(At, 1, 1); PG8_STAGE(PG8_SB(1, 0), b3, voffB); PG8_STAGE(PG8_SB(1, 1), b3 + hstep, voffB); PG8_STAGE_A(PG8_SA(1, 0), a3, 0, last);
            PG8_WAIT_V(8); PG8_WAIT_L(0); PG8_BAR; PG8_MMA(1, 0, At, B0); PG8_MMA(1, 1, At, B1); PG8_BAR; PG8_SCHED;
            } else {
            PG8_LDB(B0, 0, 0); PG8_SCHED; PG8_LDA(At, 0, 0); PG8_STAGE(PG8_SA(1, 1), a1 + hstep, voffA);
            PG8_WAIT_L(8); PG8_BAR; PG8_WAIT_L(0); PG8_MMA(0, 0, At, B0); PG8_BAR; PG8_SCHED;
            PG8_LDB(B1, 0, 1); PG8_STAGE(PG8_SB(0, 0), b2, voffB);
            PG8_BAR; PG8_WAIT_L(0); PG8_MMA(0, 1, At, B1); PG8_BAR;
            PG8_LDA(At, 0, 1); PG8_STAGE(PG8_SA(0, 0), a2, voffA);
            PG8_BAR; PG8_WAIT_L(0); PG8_MMA(1, 0, At, B0); PG8_BAR; PG8_SCHED;
            PG8_STAGE(PG8_SB(0, 1), b2 + hstep, voffB);
            PG8_WAIT_V(6); PG8_BAR; PG8_MMA(1, 1, At, B1); PG8_BAR;
            PG8_LDB(B0, 1, 0); PG8_SCHED; PG8_LDA(At, 1, 0); PG8_STAGE(PG8_SA(0, 1), a2 + hstep, voffA);
            PG8_WAIT_L(8); PG8_BAR; PG8_WAIT_L(0); PG8_MMA(0, 0, At, B0); PG8_BAR; PG8_SCHED;
            PG8_LDB(B1, 1, 1); PG8_STAGE(PG8_SB(1, 0), b3, voffB);
            PG8_BAR; PG8_WAIT_L(0); PG8_MMA(0, 1, At, B1); PG8_BAR;
            PG8_LDA(At, 1, 1); PG8_STAGE(PG8_SA(1, 0), a3, voffA);
            PG8_BAR; PG8_WAIT_L(0); PG8_MMA(1, 0, At, B0); PG8_BAR; PG8_SCHED;
            PG8_STAGE(PG8_SB(1, 1), b3 + hstep, voffB);
            PG8_WAIT_V(6); PG8_BAR; PG8_MMA(1, 1, At, B1); PG8_BAR;
            }
        }
        if constexpr (ALIGN_EPI) { if (wr == 0) PG8_BAR; }
        if constexpr (!Epi::AFTER_DRAIN) { int ln_; asm volatile("v_mbcnt_lo_u32_b32 %0, -1, 0\n\tv_mbcnt_hi_u32_b32 %0, -1, %0" : "=v"(ln_)); E(acc, cur, wr, wc, ln_ & 15, ln_ >> 4); S.done(cur); }
        if (!has_next) break;
#pragma unroll
        for (int a = 0; a < 2; ++a)
#pragma unroll
            for (int b = 0; b < 2; ++b)
#pragma unroll
                for (int m = 0; m < 4; ++m)
#pragma unroll
                    for (int n = 0; n < 2; ++n) acc[a][b][m][n] = (f32x4){0.f, 0.f, 0.f, 0.f};
        cur = nxt; cA = nA; cB = nB; ++ui;

        if constexpr (ALIGN_EPI) { if (wr == 1) PG8_BAR; }
    }
    PG8_WAIT_V(0);
    if constexpr (!ALIGN_EPI) { if (wr == 0) PG8_BAR; }
    PG8_BAR;
    if constexpr (Epi::AFTER_DRAIN) { E.fused(acc, cur, wr, wc, fr, fq, lds, wid, lane); S.done(cur); }
#undef PG8_SA
#undef PG8_SB
#undef PG8_STAGE
#undef PG8_STAGE_A
#undef PG8_GOFF
#undef PG8_LDA
#undef PG8_LDB
#undef PG8_MMA
#undef PG8_WAIT_V
#undef PG8_WAIT_L
#undef PG8_BAR
#undef PG8_SCHED
}
}
#ifndef PG8_SP2
#define PG8_SP2 true
#endif
#ifndef PG8_ALIGN
#define PG8_ALIGN true
#endif
template <int BIT> __device__ __forceinline__ unsigned mbfe(unsigned mw) { unsigned m; asm("v_bfe_i32 %0, %1, %2, 1" : "=v"(m) : "v"(mw), "n"(BIT)); return m; }
namespace attn_body {
using bf16=__hip_bfloat16;
using bf16x8=__attribute__((ext_vector_type(8)))short;
using s16x4=__attribute__((ext_vector_type(4)))short;
using f32x16=__attribute__((ext_vector_type(16)))float;
using u32x4=__attribute__((ext_vector_type(4)))unsigned;
constexpr int BATCH=8,NHEAD=8,SEQ=4096,D=64,DM=NHEAD*D;
constexpr int NW=8,QBLK=32,QB=QBLK*NW,KVBLK=64,NQB=SEQ/QB;
constexpr int ATTN_PITCH=DM, ATTN_UNIT_ROWS=QB;
__device__ __forceinline__ int crow(int r,int hi){return (r&3)+8*(r>>2)+4*hi;}
#define SBAR() __builtin_amdgcn_sched_barrier(0)
__device__ __forceinline__ void cmask(f32x16&p0,f32x16&p1,int jb,int qrel,int hi){
  const float NEG=-INFINITY; int kb=64*jb+4*hi;
  #pragma unroll
  for(int r=0;r<16;++r){int kv=kb+(r&3)+8*(r>>2); if(kv>qrel)p0[r]=NEG; if(kv+32>qrel)p1[r]=NEG;}
}

constexpr int NSLOT=3, SLOTB=8192;
constexpr int LDS_K=0, LDS_V=NSLOT*SLOTB, LDS_WS=2*NSLOT*SLOTB, LDS_OST=LDS_WS+NW*64*4, LDS_BYTES=LDS_OST+NW*4096;
constexpr float C2=0.125f*1.4426950408889634f;
__device__ __forceinline__ void glds16(const void*gsrc,unsigned lds_dst){unsigned keep;
  asm volatile("s_mov_b32 %0, m0\n\ts_mov_b32 m0, %2\n\ts_nop 0\n\tglobal_load_lds_dwordx4 %1, off\n\ts_mov_b32 m0, %0":"=&s"(keep):"v"(gsrc),"s"(lds_dst):"memory");}
__device__ __forceinline__ float max3f(float a,float b,float c){float r;asm("v_max3_f32 %0, %1, %2, %3":"=v"(r):"v"(a),"v"(b),"v"(c));return r;}
__device__ __forceinline__ float max2f(float a,float b){float r;asm("v_max_f32_e32 %0, %1, %2":"=v"(r):"v"(a),"v"(b));return r;}
__device__ __forceinline__ float fadd_s(float a,float b){float r;asm("v_add_f32_e32 %0, %1, %2":"=v"(r):"v"(a),"v"(b));return r;}
__device__ __forceinline__ float fsub_s(float a,float b){float r;asm("v_sub_f32_e32 %0, %1, %2":"=v"(r):"v"(a),"v"(b));return r;}
typedef float f32x2_t __attribute__((ext_vector_type(2))); typedef __bf16 bf16x2_t __attribute__((ext_vector_type(2)));
__device__ __forceinline__ unsigned cvtpk_s(float lo,float hi){f32x2_t v={lo,hi};bf16x2_t b=__builtin_convertvector(v,bf16x2_t);return __builtin_bit_cast(unsigned,b);}
#define WAIT_BAR(N) asm volatile("s_waitcnt vmcnt(" #N ") lgkmcnt(0)\n\ts_barrier":::"memory")

__device__ __forceinline__ void qkt(f32x16&p0,f32x16&p1,const char*Kslot,const bf16x8*qr,const f32x16&negm,int r32,int hi){
  const char*kb=Kslot+hi*1024+r32*16;
  #pragma unroll
  for(int d0=0;d0<4;++d0){
    const bf16x8 b0=*reinterpret_cast<const bf16x8*>(kb+d0*2048);
    const bf16x8 b1=*reinterpret_cast<const bf16x8*>(kb+d0*2048+512);
    if(d0==0){p0=__builtin_amdgcn_mfma_f32_32x32x16_bf16(b0,qr[0],negm,0,0,0);p1=__builtin_amdgcn_mfma_f32_32x32x16_bf16(b1,qr[0],negm,0,0,0);}
    else{p0=__builtin_amdgcn_mfma_f32_32x32x16_bf16(b0,qr[d0],p0,0,0,0);p1=__builtin_amdgcn_mfma_f32_32x32x16_bf16(b1,qr[d0],p1,0,0,0);}}
}
typedef __attribute__((address_space(3))) const char* lds_cptr;
typedef short v4i16_t __attribute__((ext_vector_type(4)));
__device__ __forceinline__ void kload8(bf16x8*kf,lds_cptr kp){
  kf[0]=*(const __attribute__((address_space(3))) bf16x8*)(kp);      kf[1]=*(const __attribute__((address_space(3))) bf16x8*)(kp+512);
  kf[2]=*(const __attribute__((address_space(3))) bf16x8*)(kp+2048); kf[3]=*(const __attribute__((address_space(3))) bf16x8*)(kp+2560);
  kf[4]=*(const __attribute__((address_space(3))) bf16x8*)(kp+4096); kf[5]=*(const __attribute__((address_space(3))) bf16x8*)(kp+4608);
  kf[6]=*(const __attribute__((address_space(3))) bf16x8*)(kp+6144); kf[7]=*(const __attribute__((address_space(3))) bf16x8*)(kp+6656);
}
__device__ __forceinline__ void kload2(bf16x8*kf,lds_cptr kp,int j){ kf[2*j]=*(const __attribute__((address_space(3))) bf16x8*)(kp+j*2048); kf[2*j+1]=*(const __attribute__((address_space(3))) bf16x8*)(kp+j*2048+512); }
__device__ __forceinline__ s16x4 vtr(lds_cptr p){ return __builtin_bit_cast(s16x4,__builtin_amdgcn_ds_read_tr16_b64_v4i16((__attribute__((address_space(3))) v4i16_t*)p)); }
__device__ __forceinline__ float rowmax(const f32x16&p0,const f32x16&p1){
  float a=max3f(p0[0],p0[1],p1[0]),b=max3f(p0[2],p0[3],p1[1]);a=max3f(a,p1[2],p1[3]);
  #pragma unroll
  for(int r=4;r<16;r+=4){a=max3f(a,p0[r],p0[r+1]);b=max3f(b,p0[r+2],p0[r+3]);a=max3f(a,p1[r],p1[r+1]);b=max3f(b,p1[r+2],p1[r+3]);}
  const float m=max2f(a,b);
  auto rr=__builtin_amdgcn_permlane32_swap(__float_as_uint(m),__float_as_uint(m),false,false);
  return max2f(__uint_as_float(rr[0]),__uint_as_float(rr[1]));
}
__device__ __forceinline__ void pv(f32x16*o,int vb,bf16x8 pa0,bf16x8 pa1,bf16x8 pa2,bf16x8 pa3){
  #pragma unroll
  for(int d0=0;d0<2;++d0){s16x4 lo[4],hi[4];
    #pragma unroll
    for(int ks=0;ks<4;++ks){
      asm volatile("ds_read_b64_tr_b16 %0,%1 offset:%c2":"=&v"(lo[ks]):"v"(vb),"i"(d0*4096+ks*1024):"memory");
      asm volatile("ds_read_b64_tr_b16 %0,%1 offset:%c2":"=&v"(hi[ks]):"v"(vb),"i"(d0*4096+ks*1024+512):"memory");}
    asm volatile("s_waitcnt lgkmcnt(0)":::"memory");SBAR();
    #define PK(k) (bf16x8){lo[k][0],lo[k][1],lo[k][2],lo[k][3],hi[k][0],hi[k][1],hi[k][2],hi[k][3]}
    o[d0]=__builtin_amdgcn_mfma_f32_32x32x16_bf16(pa0,PK(0),o[d0],0,0,0);
    o[d0]=__builtin_amdgcn_mfma_f32_32x32x16_bf16(pa1,PK(1),o[d0],0,0,0);
    o[d0]=__builtin_amdgcn_mfma_f32_32x32x16_bf16(pa2,PK(2),o[d0],0,0,0);
    o[d0]=__builtin_amdgcn_mfma_f32_32x32x16_bf16(pa3,PK(3),o[d0],0,0,0);
    #undef PK
  }
}

#ifndef ATTN_STORE16
#define ATTN_STORE16(p,v) do{ if(!dry) *(u32x4*)(p)=(v); }while(0)
#endif
template<int THRL> __device__ __forceinline__ void attn_unit(int b,int h,int qb,const bf16*Q,const bf16*__restrict__ K,const bf16*__restrict__ V,bf16*O,const uint2*MaskBase,char*shm,bool dry,int wave_){
  int lane; asm volatile("v_mbcnt_lo_u32_b32 %0, -1, 0\n\tv_mbcnt_hi_u32_b32 %0, -1, %0" : "=v"(lane)); const int wid=__builtin_amdgcn_readfirstlane(wave_),tid=wid*64+lane,r32=lane&31,hi=lane>>5;
  const long rowbase=(long)b*SEQ; const int q0=qb*QB;
  const bf16*Qw=Q+(rowbase+q0+wid*QBLK)*DM+h*D;
  const bf16*Kh=K+rowbase*DM+h*D,*Vh=V+rowbase*DM+h*D;
  const unsigned lds0=(unsigned)(uintptr_t)shm;
  float*wsf=(float*)(shm+LDS_WS)+wid*64;
  const bf16*ksrc=Kh+(long)lane*DM+wid*8;
  const bf16*vsrc=Vh+(long)(16*(wid&3)+(lane>>2))*DM+(wid>>2)*32+(lane&3)*8;
  const unsigned kdst=lds0+LDS_K+wid*1024, vdst=lds0+LDS_V+wid*1024;
  #define DMA_K(t,slot) glds16(ksrc+(long)(t)*KVBLK*DM,(unsigned)__builtin_amdgcn_readfirstlane(kdst+(slot)))
  #define DMA_V(t,slot) glds16(vsrc+(long)(t)*KVBLK*DM,(unsigned)__builtin_amdgcn_readfirstlane(vdst+(slot)))
  const int vb0=(int)(lds0+LDS_V)+((lane>>4)&1)*32+(lane&3)*8+(4*hi+((lane&15)>>2))*64;
  const char*Kbase=shm+LDS_K; bf16x8 kf[8];
  const lds_cptr shm3=(lds_cptr)shm; const lds_cptr kp0=shm3+LDS_K+hi*1024+r32*16; const lds_cptr vp0=shm3+LDS_V+((lane>>4)&1)*32+(lane&3)*8+(4*hi+((lane&15)>>2))*64;
  const int NT=(q0+QB)/KVBLK;
  DMA_K(0,0);DMA_V(0,0);DMA_K(1,SLOTB);
  bf16x8 qr[4];
  #pragma unroll
  for(int d0=0;d0<4;++d0)qr[d0]=*reinterpret_cast<const bf16x8*>(&Qw[(long)r32*DM+d0*16+hi*8]);
  float mhat=0.f,l_reg=0.f;f32x16 o[2];o[0]=f32x16{};o[1]=f32x16{};f32x16 negm=f32x16{};asm volatile("":"+v"(negm));
  const int qrel=wid*QBLK+r32;
  const uint2*mrow=MaskBase+((size_t)(rowbase+q0+qrel))*64;
  const int sh4=4*hi; uint2 mraw=mrow[0]; unsigned mw0=mraw.x>>sh4, mw1=mraw.y>>sh4; mraw=mrow[1]; unsigned mwc0=mraw.x>>sh4, mwc1=mraw.y>>sh4, mwn0=mwc0, mwn1=mwc1;
  #define MSKB(v,mw,bit) __uint_as_float(__float_as_uint(v)&mbfe<(bit)>(mw))
  #define MSKV(v,mw,bit) __uint_as_float(__float_as_uint(v)&(unsigned)(((int)((mw)<<(31-(bit))))>>31))
  #define MBIT(r) (((r)&3)+8*((r)>>2))
  #define MCONV() do{ asm volatile("" : "+v"(mraw)); mwc0=mraw.x>>sh4; mwc1=mraw.y>>sh4; }while(0)
  #define CMASK(P0,P1,t) do{}while(0)
  bool resc=false;
  #define START(P0,P1) do{ const float rm=rowmax(P0,P1); resc=false; \
    { const float dl=rm; mhat=fadd_s(mhat,dl); \
      _Pragma("unroll") for(int r=0;r<16;++r){P0[r]=fsub_s(P0[r],dl);P1[r]=fsub_s(P1[r],dl);} \
      _Pragma("unroll") for(int r=0;r<16;++r)negm[r]=-mhat; asm volatile("":"+v"(negm)); } \
    _Pragma("unroll") for(int r=0;r<16;++r)P0[r]=MSKV(__builtin_amdgcn_exp2f(P0[r]),mw0,MBIT(r)); }while(0)
  #define RESC() do{ if(resc){ asm volatile("s_waitcnt lgkmcnt(0)":::"memory"); \
      _Pragma("unroll") for(int d_=0;d_<2;++d_) _Pragma("unroll") for(int r=0;r<16;++r)o[d_][r]*=wsf[crow(r,hi)]; } }while(0)
  f32x16 pA0,pA1,pB0,pB1;
  int sl_prev=0,sl_cur=0,sl_next=SLOTB;
  #define ROT() do{sl_prev=sl_cur;sl_cur=sl_next;sl_next=(sl_next==(NSLOT-1)*SLOTB)?0:sl_next+SLOTB;}while(0)
  DMA_K(2,2*SLOTB);
  WAIT_BAR(3);
  qkt(pA0,pA1,Kbase,qr,negm,r32,hi);asm volatile("s_nop 15\n\ts_nop 7":"+v"(pA0),"+v"(pA1));CMASK(pA0,pA1,0);
  START(pA0,pA1);
  _Pragma("unroll") for(int r=0;r<16;++r)pA1[r]=MSKV(__builtin_amdgcn_exp2f(pA1[r]),mw1,MBIT(r));
  WAIT_BAR(0);
  DMA_K(3,0);DMA_V(1,SLOTB);
  ROT();
  kload8(kf,kp0+sl_cur);
  WAIT_BAR(2);
  s16x4 vlo[8],vhi[8]; u32x4 pw0,pw1,pw2,pw3;
  #define PKW(P,B) cvtpk_s(P[B],P[B+1])
  #define PAF(k) __builtin_bit_cast(bf16x8,pw##k)
  #define VFR(i) (bf16x8){vlo[i][0],vlo[i][1],vlo[i][2],vlo[i][3],vhi[i][0],vhi[i][1],vhi[i][2],vhi[i][3]}
  #define PIN(x) asm volatile("":"+v"(x))
  #define MX3(a,b,c) __builtin_fmaxf(__builtin_fmaxf((a),(b)),(c))
  #define GAPA(MF,A0,A1,A2,A3,W0,W1,PW) do{ MF; sacc+=A0; sacc+=A1; sacc+=A2; sacc+=A3; PIN(sacc); W0; W1; PIN(PW); SBAR(); }while(0)
  #define EX(v) __builtin_amdgcn_exp2f(v)
  #define GAPB(MF,X,B,MW) do{ MF; X[B]=MSKB(EX(X[B]),MW,2*(B)); X[B+1]=MSKB(EX(X[B+1]),MW,2*(B)+1); X[B+2]=MSKB(EX(X[B+2]),MW,2*(B)+2); X[B+3]=MSKB(EX(X[B+3]),MW,2*(B)+3); PIN(X); SBAR(); }while(0)
  #define VRD(i) do{ vlo[i]=vtr(vp_+(((i)>>2)*4096+((i)&3)*1024)); vhi[i]=vtr(vp_+(((i)>>2)*4096+((i)&3)*1024+512)); }while(0)
  #define KRD(G,j) do{ if(G){ kload2(kf,kp0+sl_next,j); SBAR(); } }while(0)
  #define STEP(C0,C1,P0,P1,t,GK,GV,GL,ML) do{ SBAR(); if(ML){ asm volatile("global_load_dwordx2 %0, %1, off" : "=v"(mraw) : "v"(mrow+(t)+1) : "memory"); } \
    const lds_cptr vp_=vp0+sl_prev; \
    VRD(0); SBAR(); float sacc=(P0[0]+P0[1]); \
    GAPA(C0=__builtin_amdgcn_mfma_f32_32x32x16_bf16(kf[0],qr[0],negm,0,0,0), P0[2],P0[3],P0[4],P0[5],     pw0[0]=PKW(P0,0), pw0[1]=PKW(P0,2), pw0); \
    VRD(4); SBAR(); GAPA(C1=__builtin_amdgcn_mfma_f32_32x32x16_bf16(kf[1],qr[0],negm,0,0,0), P0[6],P0[7],P0[8],P0[9],     pw0[2]=PKW(P0,4), pw0[3]=PKW(P0,6), pw0); \
    VRD(1); SBAR(); GAPA(C0=__builtin_amdgcn_mfma_f32_32x32x16_bf16(kf[2],qr[1],C0,0,0,0),   P0[10],P0[11],P0[12],P0[13], pw1[0]=PKW(P0,8), pw1[1]=PKW(P0,10), pw1); \
    VRD(5); SBAR(); GAPA(C1=__builtin_amdgcn_mfma_f32_32x32x16_bf16(kf[3],qr[1],C1,0,0,0),   P0[14],P0[15],P1[0],P1[1],   pw1[2]=PKW(P0,12),pw1[3]=PKW(P0,14), pw1); \
    VRD(2); SBAR(); GAPA(C0=__builtin_amdgcn_mfma_f32_32x32x16_bf16(kf[4],qr[2],C0,0,0,0),   P1[2],P1[3],P1[4],P1[5],     pw2[0]=PKW(P1,0), pw2[1]=PKW(P1,2), pw2); \
    VRD(6); SBAR(); GAPA(C1=__builtin_amdgcn_mfma_f32_32x32x16_bf16(kf[5],qr[2],C1,0,0,0),   P1[6],P1[7],P1[8],P1[9],     pw2[2]=PKW(P1,4), pw2[3]=PKW(P1,6), pw2); \
    VRD(3); SBAR(); GAPA(C0=__builtin_amdgcn_mfma_f32_32x32x16_bf16(kf[6],qr[3],C0,0,0,0),   P1[10],P1[11],P1[12],P1[13], pw3[0]=PKW(P1,8), pw3[1]=PKW(P1,10), pw3); \
    VRD(7); SBAR(); GAPA(C1=__builtin_amdgcn_mfma_f32_32x32x16_bf16(kf[7],qr[3],C1,0,0,0),   P1[14],P1[15],0.f,0.f,       pw3[2]=PKW(P1,12),pw3[3]=PKW(P1,14), pw3); \
    l_reg+=sacc; \
    if(GK){DMA_K((t)+3,sl_cur);} if(GV){DMA_V((t)+1,sl_next);} \
    CMASK(C0,C1,t); \
    { float a=MX3(C0[0],C0[1],C1[0]),b=MX3(C0[2],C0[3],C1[1]); a=MX3(a,C1[2],C1[3]); \
      _Pragma("unroll") for(int r=4;r<16;r+=4){a=MX3(a,C0[r],C0[r+1]);b=MX3(b,C0[r+2],C0[r+3]);a=MX3(a,C1[r],C1[r+1]);b=MX3(b,C1[r+2],C1[r+3]);} \
      float rm=__builtin_fmaxf(a,b); { auto rr=__builtin_amdgcn_permlane32_swap(__float_as_uint(rm),__float_as_uint(rm),false,false); rm=__builtin_fmaxf(__uint_as_float(rr[0]),__uint_as_float(rr[1])); } \
      resc=false; \
      if(__builtin_expect(__any(rm>(float)THRL),0)){ const float dl=__builtin_fmaxf(rm,0.f); mhat+=dl; \
        _Pragma("unroll") for(int r=0;r<16;++r){C0[r]-=dl;C1[r]-=dl;} \
        _Pragma("unroll") for(int r=0;r<16;++r)negm[r]=-mhat; asm volatile("":"+v"(negm)); \
        const float f=__builtin_amdgcn_exp2f(-dl); l_reg*=f; if(hi==0)wsf[r32]=f; resc=true; } } \
    SBAR(); \
    GAPB(o[0]=__builtin_amdgcn_mfma_f32_32x32x16_bf16(PAF(0),VFR(0),o[0],0,0,0), C0,0,mwc0); \
    GAPB(o[1]=__builtin_amdgcn_mfma_f32_32x32x16_bf16(PAF(0),VFR(4),o[1],0,0,0), C0,4,mwc0); \
    KRD(GL,0); GAPB(o[0]=__builtin_amdgcn_mfma_f32_32x32x16_bf16(PAF(1),VFR(1),o[0],0,0,0), C0,8,mwc0); \
    KRD(GL,1); GAPB(o[1]=__builtin_amdgcn_mfma_f32_32x32x16_bf16(PAF(1),VFR(5),o[1],0,0,0), C0,12,mwc0); \
    KRD(GL,2); GAPB(o[0]=__builtin_amdgcn_mfma_f32_32x32x16_bf16(PAF(2),VFR(2),o[0],0,0,0), C1,0,mwc1); \
    KRD(GL,3); GAPB(o[1]=__builtin_amdgcn_mfma_f32_32x32x16_bf16(PAF(2),VFR(6),o[1],0,0,0), C1,4,mwc1); \
    GAPB(o[0]=__builtin_amdgcn_mfma_f32_32x32x16_bf16(PAF(3),VFR(3),o[0],0,0,0), C1,8,mwc1); \
    GAPB(o[1]=__builtin_amdgcn_mfma_f32_32x32x16_bf16(PAF(3),VFR(7),o[1],0,0,0), C1,12,mwc1); \
    }while(0)
  int t=1;
  #undef CMASK
  #define CMASK(P0,P1,t) do{}while(0)
  for(;t+5<NT;t+=2){
    STEP(pB0,pB1,pA0,pA1,t,true,true,true,true);     WAIT_BAR(2); MCONV(); RESC(); ROT();
    STEP(pA0,pA1,pB0,pB1,t+1,true,true,true,true);   WAIT_BAR(2); MCONV(); RESC(); ROT();
  }
  #undef CMASK
  #define CMASK(P0,P1,t) do{}while(0)
  #define ENDW(tt) do{ if((tt)+3<NT){WAIT_BAR(2);} else if((tt)+2<NT){WAIT_BAR(1);} else {WAIT_BAR(0);} }while(0)
  for(;t+1<NT;t+=2){
    STEP(pB0,pB1,pA0,pA1,t,(t+3<NT),(t+1<NT),(t+1<NT),(t+1<NT));       ENDW(t); if(t+1<NT){MCONV();}   RESC(); ROT();
    STEP(pA0,pA1,pB0,pB1,t+1,(t+4<NT),(t+2<NT),(t+2<NT),(t+2<NT));     ENDW(t+1); if(t+2<NT){MCONV();} RESC(); ROT();
  }
  STEP(pB0,pB1,pA0,pA1,NT-1,false,false,false,false); RESC();
  { float sacc=pB0[0]+pB0[1]; _Pragma("unroll") for(int r=2;r<16;++r)sacc+=pB0[r]; _Pragma("unroll") for(int r=0;r<16;++r)sacc+=pB1[r]; l_reg+=sacc;
    pw0=(u32x4){PKW(pB0,0),PKW(pB0,2),PKW(pB0,4),PKW(pB0,6)};pw1=(u32x4){PKW(pB0,8),PKW(pB0,10),PKW(pB0,12),PKW(pB0,14)};pw2=(u32x4){PKW(pB1,0),PKW(pB1,2),PKW(pB1,4),PKW(pB1,6)};pw3=(u32x4){PKW(pB1,8),PKW(pB1,10),PKW(pB1,12),PKW(pB1,14)};
    SBAR(); pv(o,vb0+sl_cur,PAF(0),PAF(1),PAF(2),PAF(3)); }
  #undef PKW
  #undef PAF
  #undef VFR
  #undef PIN
  #undef MX3
  #undef GAPA
  #undef GAPB
  #undef EX
  #undef VRD
  #undef KRD
  #undef STEP
  #undef ENDW
  {auto rr=__builtin_amdgcn_permlane32_swap(__float_as_uint(l_reg),__float_as_uint(l_reg),false,false);l_reg=__uint_as_float(rr[0])+__uint_as_float(rr[1]);}
  if(hi==0)wsf[32+r32]=l_reg;asm volatile("s_waitcnt lgkmcnt(0)":::"memory");
  float rli[16];
  #pragma unroll
  for(int r=0;r<16;++r)rli[r]=__builtin_amdgcn_rcpf(wsf[32+crow(r,hi)]);
  bf16*Ow=O+(rowbase+q0+wid*QBLK)*DM+h*D;
  { bf16*stg=(bf16*)(shm+LDS_OST)+wid*2048;
    #pragma unroll
    for(int r=0;r<16;++r){const int orow=crow(r,hi);
      #pragma unroll
      for(int d0=0;d0<2;++d0)stg[orow*64+d0*32+r32]=__float2bfloat16(o[d0][r]*rli[r]);}
    asm volatile("s_waitcnt lgkmcnt(0)":::"memory");
    #pragma unroll
    for(int i=0;i<4;++i){const int row=i*8+(lane>>3),ch=lane&7; const u32x4 v=*(const u32x4*)(stg+row*64+ch*8); ATTN_STORE16(Ow+(long)row*DM+ch*8,v);} }
  asm volatile("s_waitcnt lgkmcnt(0)\n\ts_barrier":::"memory");
  #undef DMA_K
  #undef DMA_V
  #undef CMASK
  #undef MSKB
  #undef MSKV
  #undef MBIT
  #undef MCONV
  #undef START
  #undef RESC
  #undef ROT
}
constexpr int ATTN_LDS_BYTES=LDS_BYTES;
struct AttnTensors { const bf16* Q; const bf16* K; const bf16* V; bf16* O; const uint2* Mask; };
struct AttnUnit { int bh; int qb; };
struct StaticOrder {
  int vcu;
  __device__ __forceinline__ explicit StaticOrder(int grid,int block):vcu((block%8)*(grid/8)+block/8){}
  __device__ __forceinline__ bool next(int i,AttnUnit&u)const{ if(i>=4)return false; const int s=vcu&3; u.bh=vcu>>2; u.qb=(i==0)?s:(i==1)?7-s:(i==2)?8+s:15-s; return true; }
  __device__ __forceinline__ void a_ready(const AttnUnit&)const{}
  __device__ __forceinline__ void done(const AttnUnit&)const{}
};
template<class Sched,int THRL=8> __device__ __forceinline__ void attn_phase(char*lds,const AttnTensors&T,const Sched&S,int wave_,bool dry=false){
  AttnUnit u;
  for(int i=0;S.next(i,u);++i){ S.a_ready(u); attn_unit<THRL>(u.bh/NHEAD,u.bh%NHEAD,u.qb,T.Q,T.K,T.V,T.O,T.Mask,lds,dry,wave_); S.done(u); }
}
#undef SBAR
#undef WAIT_BAR
}
#define GAS __attribute__((address_space(1)))
#define LAS __attribute__((address_space(3)))
typedef unsigned short bf16;
typedef unsigned v4u __attribute__((ext_vector_type(4)));
typedef float f32x4 __attribute__((ext_vector_type(4)));
typedef short bf16x8 __attribute__((ext_vector_type(8)));
typedef GAS unsigned gu32;
typedef GAS unsigned long long gu64;
#define RLX_AGENT __ATOMIC_RELAXED, __HIP_MEMORY_SCOPE_AGENT
#define LDS_WAIT() asm volatile("s_waitcnt lgkmcnt(0)" ::: "memory")
#define VM_WAIT() asm volatile("s_waitcnt vmcnt(0)" ::: "memory")
__device__ __forceinline__ unsigned long long rt() { return __builtin_amdgcn_s_memrealtime(); }
__device__ __forceinline__ unsigned f2bf(float f) { unsigned u = __builtin_bit_cast(unsigned, f); return (u + 0x7fffu + ((u >> 16) & 1u)) >> 16; }
__device__ __forceinline__ unsigned pk2(float lo, float hi) { return f2bf(lo) | (f2bf(hi) << 16); }

#define XB_TMO      128
#define XB_XCNT(j)  (256  + 64 * (j))
#define XB_XSUB(j)  (1280 + 64 * (j))
#define XB_XGEN(j)  (2304 + 64 * (j))
#define XB_TOP      3328
#define XB_TOPGEN   3392
#define XCD_BAR_WORDS 3456
#define XB_SPIN_CAP (1u << 18)

__device__ __forceinline__ unsigned xb_ld(unsigned* p)              { return __hip_atomic_load(p, __ATOMIC_RELAXED, __HIP_MEMORY_SCOPE_AGENT); }
__device__ __forceinline__ unsigned xb_add(unsigned* p, unsigned v) { return __hip_atomic_fetch_add(p, v, __ATOMIC_RELAXED, __HIP_MEMORY_SCOPE_AGENT); }
__device__ __forceinline__ unsigned xb_xcc_id() { return (unsigned)__builtin_amdgcn_s_getreg((3 << 11) | 20) & 0xFu; }
#define XB_SPIN(cond, bar) do { unsigned _sp = 0; while (cond) { __builtin_amdgcn_s_sleep(1); \
    if ((++_sp & 255u) == 0u) { if (xb_ld(&(bar)[XB_TMO])) break; if (_sp > XB_SPIN_CAP) { atomicAdd(&(bar)[XB_TMO], 1u); break; } } } } while (0)

struct XcdBarrier {
    unsigned* bar; unsigned x; int wave;
    volatile LAS unsigned* st;
};

__device__ __forceinline__ XcdBarrier xcd_barrier_post(unsigned* bar, volatile LAS unsigned* st, int wave) {
    XcdBarrier b; b.bar = bar; b.x = xb_xcc_id(); b.st = st; b.wave = wave;
    if (threadIdx.x == 0) (void)xb_add(&bar[XB_XCNT(b.x)], 1u);
    return b;
}
__device__ __forceinline__ void xcd_barrier_complete(unsigned* bar, unsigned x, unsigned& nloc, unsigned& nx) {
    const unsigned G = gridDim.x * gridDim.y * gridDim.z;
    unsigned sum, cnt, mine, sp = 0u;
    for (;;) {
        sum = 0u; cnt = 0u; mine = 0u;
#pragma unroll
        for (unsigned j = 0; j < 16; ++j) { const unsigned c = xb_ld(&bar[XB_XCNT(j)]); sum += c; cnt += (c > 0u) ? 1u : 0u; mine = (j == x) ? c : mine; }
        if (sum == G) break;
        __builtin_amdgcn_s_sleep(1);
        if ((++sp & 255u) == 0u) { if (xb_ld(&bar[XB_TMO])) break; if (sp > XB_SPIN_CAP) { atomicAdd(&bar[XB_TMO], 1u); break; } }
    }
    nloc = mine > 0u ? mine : 1u; nx = cnt > 0u ? cnt : 1u;
}

__device__ __forceinline__ void xcd_barrier(const XcdBarrier& b) {
    asm volatile("s_waitcnt vmcnt(0)" ::: "memory");
    __syncthreads();
    int xl_; asm volatile("v_mbcnt_lo_u32_b32 %0, -1, 0\n\tv_mbcnt_hi_u32_b32 %0, -1, %0" : "=v"(xl_));
    if (b.wave == 0 && xl_ == 0) {
        unsigned* bar = b.bar;
        __builtin_amdgcn_s_waitcnt(0);
        unsigned nloc = b.st[0], nx = b.st[1];
        if (nloc == 0u) { xcd_barrier_complete(bar, b.x, nloc, nx); b.st[0] = nloc; b.st[1] = nx; }
        const unsigned old = xb_add(&bar[XB_XSUB(b.x)], 1u);
        const unsigned gen = old / nloc;
        if (old + 1u == (gen + 1u) * nloc) {
            __builtin_amdgcn_fence(__ATOMIC_RELEASE, "agent");
            asm volatile("s_waitcnt vmcnt(0)" ::: "memory");
            const unsigned og = xb_add(&bar[XB_TOP], 1u);
            const unsigned tg = og / nx;
            if (og + 1u == (tg + 1u) * nx) xb_add(&bar[XB_TOPGEN], 1u);
            else XB_SPIN(xb_ld(&bar[XB_TOPGEN]) == tg, bar);
            __builtin_amdgcn_fence(__ATOMIC_ACQUIRE, "agent");
            xb_add(&bar[XB_XGEN(b.x)], 1u);
            asm volatile("s_waitcnt vmcnt(0)" ::: "memory");
        } else {
            XB_SPIN(xb_ld(&bar[XB_XGEN(b.x)]) == gen, bar);
            __builtin_amdgcn_fence(__ATOMIC_ACQUIRE, "agent");
            asm volatile("s_waitcnt vmcnt(0)" ::: "memory");
        }
    }
    __syncthreads();
}

constexpr int NWAVES = 8;
constexpr int T = 32768, DM = 1024, SEQ = 4096, NBATCH = 8, NMEM = 256;
constexpr float EPS = 1e-6f;
constexpr int IN_W = 5192;
constexpr int NCLS = 112;
constexpr size_t MiB = 1u << 20;
constexpr size_t WS_CTL = 0, CTL_ZERO_BYTES = 1 * MiB;
constexpr size_t WS_RSTD0 = 1 * MiB, WS_RSTDM = WS_RSTD0 + 131072, WS_TOKC = WS_RSTD0 + 262144;
constexpr size_t WS_ROPE = 3 * MiB;
constexpr size_t WS_W = 11 * MiB;
constexpr size_t W_R = WS_W, W_V = W_R + 3 * MiB, W_G = W_V + 1 * MiB, W_X = W_G + 2 * MiB, W_GT = W_X + MiB / 2, W_OA = W_GT + 4 * MiB, W_CO = W_OA + 1 * MiB,
                 W_OUT = W_CO + 1 * MiB, W_QX = W_OUT + 2 * MiB, W_KVX = W_QX + 2 * MiB, W_OX = W_KVX + 4 * MiB, W_RT = W_OX + 2 * MiB, W_E1 = W_RT + MiB / 2, W_E2 = W_E1 + 32 * MiB, W_END = W_E2 + 16 * MiB;
static_assert(W_END == 82 * MiB, "weights map");
constexpr size_t WS_XB = 82 * MiB;
constexpr size_t WS_Q = 146 * MiB, WS_CA = 178 * MiB;
constexpr size_t WS_K = 210 * MiB, WS_V = 242 * MiB, WS_QI = 274 * MiB, WS_U = 306 * MiB;
constexpr size_t WS_KI = 338 * MiB, WS_WI = 342 * MiB, WS_MASK = 343 * MiB, WS_KX = 359 * MiB, WS_VT = 363 * MiB, WS_MEMB = 367 * MiB, WS_LIST = 371 * MiB, WS_CE = 375 * MiB;
constexpr size_t W_QH = 385 * MiB, W_OH = 387 * MiB;
constexpr size_t WS_KXH = 389 * MiB, WS_VH = 393 * MiB;
constexpr size_t WS_WK = 397 * MiB, WS_VWT = 413 * MiB, WS_END = 429 * MiB;
constexpr size_t WS_HS = 82 * MiB;
constexpr size_t WS_YS = 210 * MiB;
constexpr int CW_TMO = 0, CW_CODE = 1, CW_BAR = 4096, CW_ROWSQ1 = 32768, CW_ROWSQ2 = 65536, CW_CNT = 98304;
constexpr int CW_RDY = 131072, CW_RDYTOT = 196608;
static_assert((CW_CNT + 64 * NCLS) <= CW_RDY && CW_RDY + 64 * 288 <= CW_RDYTOT && (CW_RDYTOT + 128) * 4 <= (int)CTL_ZERO_BYTES, "CTL words inside the memset region");
constexpr int SCR_BYTES = 147456;
constexpr int LDSCTL_OFF = SCR_BYTES, MISC_OFF = LDSCTL_OFF + 320, LDS_BYTES = SCR_BYTES + 4096;


struct Frame {
    LAS unsigned char* lds;
    volatile LAS unsigned* MISC;
    gu32* ctl;
    unsigned char* ws;
    int tid, lane, wave, vcu, G;
    const float* const* in;
    float* out;
};
template <class TT> __device__ __forceinline__ TT* wsp(const Frame& F, size_t off) { return (TT*)(F.ws + off); }
__device__ __forceinline__ float wave_sum(float v) {
#pragma unroll
    for (int o = 1; o < 64; o <<= 1) v += __shfl_xor(v, o);
    return v;
}
__device__ __forceinline__ float bf2f(unsigned short h) { return __builtin_bit_cast(float, (unsigned)h << 16); }

template <class DstFn>
__device__ __forceinline__ void p0_item(const float* W, int N, int n0, int k0, const float* gain, float scale, DstFn dst, LAS float* scr, int lane) {
    f32x4 v[8];
#pragma unroll
    for (int i = 0; i < 8; ++i) v[i] = *(const GAS f32x4*)(W + (size_t)(k0 + 8 * i + (lane >> 3)) * N + n0 + 4 * (lane & 7));
#pragma unroll
    for (int i = 0; i < 8; ++i) { const int kk = 8 * i + (lane >> 3); const float g = gain ? gain[k0 + kk] * scale : scale; LAS float* sp = scr + kk * 33 + 4 * (lane & 7);
        sp[0] = v[i][0] * g; sp[1] = v[i][1] * g; sp[2] = v[i][2] * g; sp[3] = v[i][3] * g; }
    LDS_WAIT(); asm volatile("" ::: "memory");
    const int c = lane & 7;
#pragma unroll
    for (int j = 0; j < 4; ++j) { const int n = (lane >> 3) + 8 * j; const LAS float* s = scr + (8 * c) * 33 + n;
        v4u o; o.x = pk2(s[0 * 33], s[1 * 33]); o.y = pk2(s[2 * 33], s[3 * 33]); o.z = pk2(s[4 * 33], s[5 * 33]); o.w = pk2(s[6 * 33], s[7 * 33]);
        *(GAS v4u*)dst(n, c) = o; }
    LDS_WAIT(); asm volatile("" ::: "memory");
}
#define P0_PLAIN(Wsrc, Nsrc, n0src, Kdim, gainp, scl, WT, row0) do { const int k0_ = 64 * kb; bf16* wt_ = (WT); const int r0_ = (row0); const int Kd_ = (Kdim); \
    p0_item((Wsrc), (Nsrc), (n0src), k0_, (gainp), (scl), [=](int n, int c) { return wt_ + (size_t)(r0_ + n) * Kd_ + k0_ + 8 * c; }, scr, F.lane); } while (0)

__device__ __forceinline__ void p0_prologue(Frame& F) {
    LAS float* scr = (LAS float*)(F.lds + F.wave * 16384);
    const int gw = F.vcu * NWAVES + F.wave, NGW = F.G * NWAVES;
    const float* w_in = F.in[4]; const float* g_mix = F.in[3];
    constexpr int I_QKQ = 16 * 16, I_V = 16 * 16, I_GLU = 16 * 32, I_X = 16 * 3, I_GT = 16 * 64, I_OA = 8 * 32, I_CO = 8 * 32, I_OUT = 16 * 32, I_QX = 16 * 32, I_KVX = 16 * 64, I_OX = 16 * 32,
                  I_EG = 32 * 16 * 8, I_EU = I_EG, I_ED = 32 * 4 * 32;
    constexpr int NITEMS = 3 * I_QKQ + I_V + I_GLU + I_X + I_GT + I_OA + I_CO + I_OUT + I_QX + I_KVX + I_OX + I_EG + I_EU + I_ED;
    constexpr float C2 = 0.125f * 1.4426950408889634f;
    constexpr float CX = 0.0625f * 1.4426950408889634f;
    for (int it = gw; it < NITEMS; it += NGW) {
        int r = it;
        if (r < 3 * I_QKQ) {
            const int t = r / I_QKQ; r -= t * I_QKQ; const int kb = r / 16, nb = r % 16, H = nb >> 1, s = nb & 1;
            const int srcc = (t == 0 ? 0 : (t == 1 ? 512 : 1536)) + nb * 32;
            P0_PLAIN(w_in, IN_W, srcc, 1024, g_mix, (t == 0 ? C2 : 1.0f), wsp<bf16>(F, W_R), t * 512 + 256 * (H >> 2) + 128 * s + 32 * (H & 3)); continue; }
        r -= 3 * I_QKQ;
        if (r < I_V) { const int kb = r / 16, nb = r % 16; P0_PLAIN(w_in, IN_W, 1024 + nb * 32, 1024, g_mix, 1.0f, wsp<bf16>(F, W_V), nb * 32); continue; }
        r -= I_V;
        if (r < I_GLU) { const int kb = r / 32, nb = r % 32, half = nb >> 4, cb = nb & 15;
            P0_PLAIN(w_in, IN_W, 2120 + nb * 32, 1024, g_mix, 1.0f, wsp<bf16>(F, W_G), 256 * (cb >> 2) + 128 * half + 32 * (cb & 3)); continue; }
        r -= I_GLU;
        if (r < I_X) { const int kb = r / 3, nb = r % 3;
            P0_PLAIN(w_in, IN_W, (nb == 0 ? 2048 : (nb == 1 ? 2080 : 2112)), 1024, g_mix, 1.0f, wsp<bf16>(F, W_X), (nb == 0 ? 0 : (nb == 1 ? 128 : 32))); continue; }
        r -= I_X;
        if (r < I_GT) { const int kb = r / 64, nb = r % 64, br = nb >> 5, cb = nb & 31;
            P0_PLAIN(w_in, IN_W, 3144 + nb * 32, 1024, g_mix, 1.0f, wsp<bf16>(F, W_GT), 256 * (cb >> 2) + 128 * br + 32 * (cb & 3)); continue; }
        r -= I_GT;
        if (r < I_OA) { const int kb = r / 32, nb = r % 32; P0_PLAIN(F.in[5], 1024, nb * 32, 512, (const float*)nullptr, 1.0f, wsp<bf16>(F, W_OA), nb * 32); continue; }
        r -= I_OA;
        if (r < I_CO) { const int kb = r / 32, nb = r % 32; P0_PLAIN(F.in[10], 1024, nb * 32, 512, (const float*)nullptr, 1.0f, wsp<bf16>(F, W_CO), nb * 32); continue; }
        r -= I_CO;
        if (r < I_OUT) { const int kb = r / 32, nb = r % 32; P0_PLAIN(F.in[11], 1024, nb * 32, 1024, (const float*)nullptr, 1.0f, wsp<bf16>(F, W_OUT), nb * 32); continue; }
        r -= I_OUT;
        if (r < I_QX) {
            const int kb = r / 32, nb = r % 32, hh = nb >> 3, d0 = (nb & 7) * 32; const float* src = F.in[14]; const float* gx = F.in[12]; bf16* dst = wsp<bf16>(F, W_QH);
            for (int q = 0; q < 4; ++q) { const int k = 64 * kb + 16 * q + (F.lane >> 2), dd = d0 + 8 * (F.lane & 3); const float gsc = gx[k] * CX;
                const f32x4 v0 = *(const GAS f32x4*)(src + (size_t)k * 1024 + hh * 256 + dd), v1 = *(const GAS f32x4*)(src + (size_t)k * 1024 + hh * 256 + dd + 4);
                v4u o; o.x = pk2(v0.x * gsc, v0.y * gsc); o.y = pk2(v0.z * gsc, v0.w * gsc); o.z = pk2(v1.x * gsc, v1.y * gsc); o.w = pk2(v1.z * gsc, v1.w * gsc);
                *(GAS v4u*)(dst + ((size_t)hh * 1024 + k) * 256 + dd) = o; }
            continue; }
        r -= I_QX;
        if (r < I_KVX) { const int kb = r / 64, nb = r % 64; P0_PLAIN(F.in[15], 2048, nb * 32, 1024, F.in[13], 1.0f, wsp<bf16>(F, W_KVX), nb * 32); continue; }
        r -= I_KVX;
        if (r < I_OX) {
            const int hh = r / 128, r2 = r % 128, kb = r2 / 32, nb = r2 % 32;
            P0_PLAIN(F.in[16] + (size_t)hh * 256 * 1024, 1024, nb * 32, 256, (const float*)nullptr, 1.0f, wsp<bf16>(F, W_OH) + (size_t)hh * 1024 * 256, nb * 32); continue; }
        r -= I_OX;
        if (r < I_EG + I_EU) {
            const int ct = r / I_EG; r -= ct * I_EG; const int e = r / 128; r -= e * 128; const int kb = r / 8, nb = r % 8;
            P0_PLAIN((ct == 0 ? F.in[22] : F.in[23]) + (size_t)e * 1024 * 256, 256, nb * 32, 1024, F.in[17], 1.0f, wsp<bf16>(F, W_E1), e * 512 + 256 * (nb >> 2) + 128 * ct + 32 * (nb & 3));
            continue; }
        r -= I_EG + I_EU;
        {
            const int e = r / 128; r -= e * 128; const int kb = r / 32, nb = r % 32;
            P0_PLAIN(F.in[24] + (size_t)e * 256 * 1024, 1024, nb * 32, 256, (const float*)nullptr, 1.0f, wsp<bf16>(F, W_E2), e * 1024 + nb * 32);
        }
    }
    { const float* wrg = F.in[18]; const float* wre = F.in[20]; const float* gm = F.in[17]; bf16* rt_ = wsp<bf16>(F, W_RT);
      for (int i = (F.vcu * NWAVES + F.wave) * 64 + F.lane; i < 36 * 1024; i += NGW * 64) { const int c = i >> 10, k = i & 1023;
          const float v = (c < 4 ? wrg[k * 4 + c] : wre[((size_t)((c - 4) >> 3) * 1024 + k) * 8 + ((c - 4) & 7)]) * gm[k]; rt_[(size_t)c * 1024 + k] = (bf16)f2bf(v); } }
    { const float* x = F.in[0]; bf16* xb = wsp<bf16>(F, WS_XB); float* rstd0 = wsp<float>(F, WS_RSTD0);
      for (int m0 = gw * 4; m0 < T + NBATCH * NMEM; m0 += NGW * 4) {
          f32x4 v[4][4]; float s[4];
#pragma unroll
          for (int q = 0; q < 4; ++q) { const int m = m0 + q; const bool ismem = m >= T; const int mm = ismem ? m - T : m;
              const GAS f32x4* xr = (const GAS f32x4*)((ismem ? F.in[1] : x) + (size_t)mm * DM) + F.lane;
#pragma unroll
              for (int j = 0; j < 4; ++j) v[q][j] = xr[64 * j]; }
#pragma unroll
          for (int q = 0; q < 4; ++q) { s[q] = 0.f;
#pragma unroll
              for (int j = 0; j < 4; ++j) s[q] += (v[q][j].x * v[q][j].x + v[q][j].y * v[q][j].y) + (v[q][j].z * v[q][j].z + v[q][j].w * v[q][j].w); }
#pragma unroll
          for (int o = 1; o < 64; o <<= 1) {
#pragma unroll
              for (int q = 0; q < 4; ++q) s[q] += __shfl_xor(s[q], o); }
#pragma unroll
          for (int q = 0; q < 4; ++q) { const int m = m0 + q; const bool ismem = m >= T; const int mm = ismem ? m - T : m;
              const float rs = 1.0f / sqrtf(s[q] * (1.0f / DM) + EPS);
              GAS unsigned long long* o8 = (GAS unsigned long long*)((ismem ? wsp<bf16>(F, WS_MEMB) : xb) + (size_t)mm * DM) + F.lane;
#pragma unroll
              for (int j = 0; j < 4; ++j) o8[64 * j] = (unsigned long long)pk2(v[q][j].x, v[q][j].y) | ((unsigned long long)pk2(v[q][j].z, v[q][j].w) << 32);
              if (F.lane == 0) { if (ismem) wsp<float>(F, WS_RSTDM)[mm] = rs; else rstd0[mm] = rs; } }
      } }
    { const int* pos = (const int*)F.in[2]; float* rope = wsp<float>(F, WS_ROPE);
      for (int i = (F.vcu * NWAVES + F.wave) * 64 + F.lane; i < T * 32; i += NGW * 64) { const int tok = i >> 5, fi = i & 31;
          double inv = 1.0; const double rr = 0.74989420933245582730;
          for (int q = 0; q < fi; ++q) inv *= rr;
          const float ang = (float)pos[tok] * (float)inv;
          const double a = (double)ang; const double kq = __builtin_rint(a * 0.63661977236758134308);
          const double rd = (a - kq * 1.57079632679489655800) - kq * 6.12323399573676603587e-17;
          const double r2 = rd * rd;
          double sn = rd * (1.0 + r2 * (-1.0 / 6 + r2 * (1.0 / 120 + r2 * (-1.0 / 5040 + r2 * (1.0 / 362880 + r2 * (-1.0 / 39916800 + r2 * (1.0 / 6227020800.0 + r2 * (-1.0 / 1307674368000.0))))))));
          double cs = 1.0 + r2 * (-0.5 + r2 * (1.0 / 24 + r2 * (-1.0 / 720 + r2 * (1.0 / 40320 + r2 * (-1.0 / 3628800 + r2 * (1.0 / 479001600.0 + r2 * (-1.0 / 87178291200.0 + r2 * (1.0 / 20922789888000.0))))))));
          const int qd = ((int)kq) & 3; double c_, s_;
          if (qd == 0) { c_ = cs; s_ = sn; } else if (qd == 1) { c_ = -sn; s_ = cs; } else if (qd == 2) { c_ = -cs; s_ = -sn; } else { c_ = sn; s_ = -cs; }
          rope[(size_t)tok * 64 + fi] = (float)c_; rope[(size_t)tok * 64 + 32 + fi] = (float)s_; } }
}

typedef float f32x16 __attribute__((ext_vector_type(16)));
__device__ __forceinline__ f32x16 mfma32(bf16x8 a, bf16x8 b, f32x16 c) { return __builtin_amdgcn_mfma_f32_32x32x16_bf16(a, b, c, 0, 0, 0); }
__device__ __forceinline__ f32x4 mfma16(bf16x8 a, bf16x8 b, f32x4 c) { return __builtin_amdgcn_mfma_f32_16x16x32_bf16(a, b, c, 0, 0, 0); }
__device__ __forceinline__ int crow32(int r, int hi) { return (r & 3) + 8 * (r >> 2) + 4 * hi; }
#define WG_SYNC() do { asm volatile("s_waitcnt vmcnt(0) lgkmcnt(0)" ::: "memory"); __builtin_amdgcn_s_barrier(); asm volatile("" ::: "memory"); } while (0)

__device__ __forceinline__ float wave_sum_dpp(float v) {
#define DPPF0(v_, ctrl_) __builtin_bit_cast(float, __builtin_amdgcn_update_dpp(0, __builtin_bit_cast(int, v_), ctrl_, 0xF, 0xF, true))
    v += DPPF0(v, 0xB1); v += DPPF0(v, 0x4E); v += DPPF0(v, 0x141); v += DPPF0(v, 0x140);
#undef DPPF0
    const float a = __builtin_bit_cast(float, __builtin_amdgcn_readlane(__builtin_bit_cast(int, v), 0)), b = __builtin_bit_cast(float, __builtin_amdgcn_readlane(__builtin_bit_cast(int, v), 16)),
                cc = __builtin_bit_cast(float, __builtin_amdgcn_readlane(__builtin_bit_cast(int, v), 32)), d = __builtin_bit_cast(float, __builtin_amdgcn_readlane(__builtin_bit_cast(int, v), 48));
    return (a + b) + (cc + d);
}
__device__ __forceinline__ void conv_phase(Frame& F) {
    const bf16* U = wsp<bf16>(F, WS_U); bf16* CA = wsp<bf16>(F, WS_CA);
    const float* cw = F.in[6]; const float* cb = F.in[7]; const float* lg = F.in[8]; const float* lb = F.in[9];
    LAS float* yy = (LAS float*)F.lds;
    const int lane = F.lane, wv = F.wave, c = wv * 64 + lane;
    float w[31];
#pragma unroll
    for (int j = 0; j < 31; ++j) w[j] = cw[j * 512 + c];
    const float bias = cb[c];
    const f32x4 g0 = *(const f32x4*)(lg + 8 * lane), g1 = *(const f32x4*)(lg + 8 * lane + 4), b0 = *(const f32x4*)(lb + 8 * lane), b1 = *(const f32x4*)(lb + 8 * lane + 4);
    for (int unit = F.vcu; unit < T / 128; unit += F.G) {
        const int tok0 = unit * 128, s0 = tok0 & (SEQ - 1);
        float in[62];
#pragma unroll
        for (int t = 0; t < 30; ++t) in[t] = (s0 - 30 + t >= 0) ? bf2f(U[(size_t)(tok0 - 30 + t) * 512 + c]) : 0.f;
        unsigned short nx[32];
#pragma unroll
        for (int t = 0; t < 32; ++t) nx[t] = U[(size_t)(tok0 + t) * 512 + c];
#pragma unroll 1
        for (int sb = 0; sb < 4; ++sb) {
#pragma unroll
            for (int t = 0; t < 32; ++t) in[30 + t] = bf2f(nx[t]);
            { const int sbn = sb < 3 ? sb + 1 : 3; const bf16* up = U + (size_t)(tok0 + 32 * sbn) * 512 + c;
#pragma unroll
              for (int t = 0; t < 32; ++t) nx[t] = up[(size_t)t * 512]; }
#pragma unroll
            for (int t = 0; t < 32; ++t) { float a = bias;
#pragma unroll
                for (int j = 0; j < 31; ++j) a = __builtin_fmaf(w[j], in[t + j], a);
                yy[t * 512 + c] = a; }
#pragma unroll
            for (int t = 0; t < 30; ++t) in[t] = in[32 + t];
            WG_SYNC();
            { f32x4 v0[4], v1[4]; float s[4];
#pragma unroll
              for (int q = 0; q < 4; ++q) { const int t = 4 * wv + q; v0[q] = *(const LAS f32x4*)(yy + t * 512 + 8 * lane); v1[q] = *(const LAS f32x4*)(yy + t * 512 + 8 * lane + 4);
                  s[q] = (v0[q][0] + v0[q][1]) + (v0[q][2] + v0[q][3]) + (v1[q][0] + v1[q][1]) + (v1[q][2] + v1[q][3]); }
#pragma unroll
              for (int q = 0; q < 4; ++q) s[q] = wave_sum_dpp(s[q]);
#pragma unroll
              for (int q = 0; q < 4; ++q) { const float mean = s[q] * (1.0f / 512.0f); v0[q] = v0[q] - mean; v1[q] = v1[q] - mean;
                  s[q] = (v0[q][0] * v0[q][0] + v0[q][1] * v0[q][1]) + (v0[q][2] * v0[q][2] + v0[q][3] * v0[q][3]) + (v1[q][0] * v1[q][0] + v1[q][1] * v1[q][1]) + (v1[q][2] * v1[q][2] + v1[q][3] * v1[q][3]); }
#pragma unroll
              for (int q = 0; q < 4; ++q) s[q] = wave_sum_dpp(s[q]);
#pragma unroll
              for (int q = 0; q < 4; ++q) { const int t = 4 * wv + q; const float rs = 1.0f / sqrtf(s[q] * (1.0f / 512.0f) + EPS);
                  f32x4 a = v0[q] * rs * g0 + b0, b = v1[q] * rs * g1 + b1;
                  a = a * pg8::sigmoid4(a); b = b * pg8::sigmoid4(b);
                  *(GAS pg8::u32x4*)(CA + (size_t)(tok0 + 32 * sb + t) * 512 + 8 * lane) = pg8::pack8(a, b); } }
            WG_SYNC();
        }
    }
}

#define DPPF(v_, ctrl_) __builtin_bit_cast(float, __builtin_amdgcn_update_dpp(0, __builtin_bit_cast(int, v_), ctrl_, 0xF, 0xF, true))
__device__ __forceinline__ float wave_min_dpp(float v) {
    v = fminf(v, DPPF(v, 0xB1)); v = fminf(v, DPPF(v, 0x4E)); v = fminf(v, DPPF(v, 0x141)); v = fminf(v, DPPF(v, 0x140));
    const float a = __builtin_bit_cast(float, __builtin_amdgcn_readlane(__builtin_bit_cast(int, v), 0)), b = __builtin_bit_cast(float, __builtin_amdgcn_readlane(__builtin_bit_cast(int, v), 16)),
                cc = __builtin_bit_cast(float, __builtin_amdgcn_readlane(__builtin_bit_cast(int, v), 32)), d = __builtin_bit_cast(float, __builtin_amdgcn_readlane(__builtin_bit_cast(int, v), 48));
    return fminf(fminf(a, b), fminf(cc, d));
}
__device__ __forceinline__ float wave_max_dpp(float v) {
    v = fmaxf(v, DPPF(v, 0xB1)); v = fmaxf(v, DPPF(v, 0x4E)); v = fmaxf(v, DPPF(v, 0x141)); v = fmaxf(v, DPPF(v, 0x140));
    const float a = __builtin_bit_cast(float, __builtin_amdgcn_readlane(__builtin_bit_cast(int, v), 0)), b = __builtin_bit_cast(float, __builtin_amdgcn_readlane(__builtin_bit_cast(int, v), 16)),
                cc = __builtin_bit_cast(float, __builtin_amdgcn_readlane(__builtin_bit_cast(int, v), 32)), d = __builtin_bit_cast(float, __builtin_amdgcn_readlane(__builtin_bit_cast(int, v), 48));
    return fmaxf(fmaxf(a, b), fmaxf(cc, d));
}
__device__ __forceinline__ unsigned wave_suffix_sum_dpp(unsigned v, int lane) {
#define DPPU(v_, ctrl_) ((unsigned)__builtin_amdgcn_update_dpp(0, (int)(v_), ctrl_, 0xF, 0xF, true))
    v += DPPU(v, 0x101); v += DPPU(v, 0x102); v += DPPU(v, 0x104); v += DPPU(v, 0x108);
    const unsigned t1 = (unsigned)__builtin_amdgcn_readlane((int)v, 16), t2 = (unsigned)__builtin_amdgcn_readlane((int)v, 32), t3 = (unsigned)__builtin_amdgcn_readlane((int)v, 48);
    const int r = lane >> 4; return v + (r == 0 ? t1 + t2 + t3 : (r == 1 ? t2 + t3 : (r == 2 ? t3 : 0u)));
#undef DPPU
}
__device__ __forceinline__ unsigned wave_prefix_sum_dpp(unsigned v, int lane) {
#define DPPU(v_, ctrl_) ((unsigned)__builtin_amdgcn_update_dpp(0, (int)(v_), ctrl_, 0xF, 0xF, true))
    v += DPPU(v, 0x111); v += DPPU(v, 0x112); v += DPPU(v, 0x114); v += DPPU(v, 0x118);
    const unsigned t0 = (unsigned)__builtin_amdgcn_readlane((int)v, 15), t1 = (unsigned)__builtin_amdgcn_readlane((int)v, 31), t2 = (unsigned)__builtin_amdgcn_readlane((int)v, 47);
    const int r = lane >> 4; return v + (r == 0 ? 0u : (r == 1 ? t0 : (r == 2 ? t0 + t1 : t0 + t1 + t2)));
#undef DPPU
}
__device__ __forceinline__ unsigned fkey(float f) { const unsigned u = __builtin_bit_cast(unsigned, f); return (u & 0x80000000u) ? ~u : (u | 0x80000000u); }
__device__ __forceinline__ int srow_addr(int k) { return (k >> 8) * 256 + (k & 63) * 4 + ((k >> 6) & 3); }
typedef _Float16 srow_t;
__device__ __forceinline__ void select_row_slow(const LAS srow_t* row, int nch, LAS unsigned long long* mw64, int lane) {
    unsigned tau = 0u; bool exact = false;
    for (int bit = 31; bit >= 0; --bit) { const unsigned cand = tau | (1u << bit); int cnt = 0;
        for (int c = 0; c < nch; ++c) cnt += __builtin_popcountll(__ballot(fkey((float)row[(c >> 2) * 256 + lane * 4 + (c & 3)]) >= cand));
        if (cnt >= 256) { tau = cand; if (cnt == 256) { exact = true; break; } } }
    int rem = 0;
    if (!exact) { int cgt = 0; for (int c = 0; c < nch; ++c) cgt += __builtin_popcountll(__ballot(fkey((float)row[(c >> 2) * 256 + lane * 4 + (c & 3)]) > tau)); rem = 256 - cgt; }
    for (int c = 0; c < 64; ++c) { unsigned long long sel = 0ull;
        if (c < nch) { const unsigned k = fkey((float)row[(c >> 2) * 256 + lane * 4 + (c & 3)]);
            if (exact) sel = __ballot(k >= tau);
            else { sel = __ballot(k > tau); unsigned long long eq = __ballot(k == tau);
                while (eq != 0ull && rem > 0) { const unsigned long long low = eq & (0ull - eq); sel |= low; eq ^= low; --rem; } } }
        if (lane == 0) mw64[c] = sel; }
}
#define SEL_B(BODY, i) BODY(i, 0) if (nch == 4 * (i) + 1) break; BODY(i, 1) if (nch == 4 * (i) + 2) break; BODY(i, 2) if (nch == 4 * (i) + 3) break; BODY(i, 3) if (nch == 4 * (i) + 4) break;
#define SEL_CHUNKS(BODY) do { SEL_B(BODY, 0) SEL_B(BODY, 1) SEL_B(BODY, 2) SEL_B(BODY, 3) SEL_B(BODY, 4) SEL_B(BODY, 5) SEL_B(BODY, 6) SEL_B(BODY, 7) SEL_B(BODY, 8) SEL_B(BODY, 9) SEL_B(BODY, 10) SEL_B(BODY, 11) SEL_B(BODY, 12) SEL_B(BODY, 13) SEL_B(BODY, 14) SEL_B(BODY, 15) } while (0)
__device__ __forceinline__ void select_row(const LAS srow_t* row, int nch_, LAS unsigned* hist, LAS unsigned short* clist, LAS unsigned long long* mw64, int lane, unsigned long long* mrow) {
    int nch = nch_; asm volatile("" : "+s"(nch));
    const int nb = (nch + 3) >> 2;
    float e[16][4];
#pragma unroll
    for (int i = 0; i < 16; ++i) if (i < nb) { typedef _Float16 h4_t __attribute__((ext_vector_type(4))); const h4_t v = *(const LAS h4_t*)(row + i * 256 + lane * 4); e[i][0] = (float)v[0]; e[i][1] = (float)v[1]; e[i][2] = (float)v[2]; e[i][3] = (float)v[3]; }
    float mn = INFINITY, mx = -INFINITY;
#define BODY_A(i, j) { mn = __builtin_amdgcn_fmed3f(mn, e[i][j], -INFINITY); mx = __builtin_amdgcn_fmed3f(mx, e[i][j], INFINITY); }
    SEL_CHUNKS(BODY_A);
#undef BODY_A
    mn = wave_min_dpp(mn); mx = wave_max_dpp(mx);
    const float scale = (mx - mn > 1e-30f) ? 256.0f / (mx - mn) : 0.f, off = -mn * scale;
    *(LAS v4u*)(hist + 4 * lane) = (v4u){0u, 0u, 0u, 0u};
#define BODY_B(i, j) { const float t = __builtin_fmaf(e[i][j], scale, off); e[i][j] = t; const unsigned bn = (unsigned)__builtin_amdgcn_fmed3f(t, 0.f, 255.f); \
        (void)__hip_atomic_fetch_add(hist + bn, 1u, __ATOMIC_RELAXED, __HIP_MEMORY_SCOPE_WORKGROUP); }
    SEL_CHUNKS(BODY_B);
#undef BODY_B
    asm volatile("s_waitcnt lgkmcnt(0)" ::: "memory");
    const v4u h = *(const LAS v4u*)(hist + 4 * lane);
    const unsigned s4 = h.x + h.y + h.z + h.w; const unsigned suf = wave_suffix_sum_dpp(s4, lane);
    const unsigned long long bm = __ballot(suf >= 256u);
    const int lstar = 63 - __builtin_clzll(bm);
    unsigned run = suf - s4, bl, ab, cn;
    if (run + h.w >= 256u) { bl = 3; ab = run; cn = h.w; } else { run += h.w;
        if (run + h.z >= 256u) { bl = 2; ab = run; cn = h.z; } else { run += h.z;
            if (run + h.y >= 256u) { bl = 1; ab = run; cn = h.y; } else { run += h.y; bl = 0; ab = run; cn = h.x; } } }
    const int bstar = 4 * lstar + __builtin_amdgcn_readlane((int)bl, lstar);
    const int above = __builtin_amdgcn_readlane((int)ab, lstar), cntb = __builtin_amdgcn_readlane((int)cn, lstar);
    const float T0 = bstar == 0 ? -INFINITY : (float)bstar, T1 = bstar == 255 ? INFINITY : (float)(bstar + 1);
    unsigned wlo = 0u, whi = 0u, clo = 0u, chi = 0u;
#define BODY_C(i, j) { const float t = e[i][j]; const unsigned long long sel = __ballot(t >= T1), cand = __ballot(t >= T0) & ~sel; \
        asm volatile("s_nop 1\n\tv_writelane_b32 %0, %2, %4\n\tv_writelane_b32 %1, %3, %4" : "+v"(wlo), "+v"(whi) : "s"((unsigned)sel), "s"((unsigned)(sel >> 32)), "n"(4 * (i) + (j)));     \
        asm volatile("v_writelane_b32 %0, %2, %4\n\tv_writelane_b32 %1, %3, %4" : "+v"(clo), "+v"(chi) : "s"((unsigned)cand), "s"((unsigned)(cand >> 32)), "n"(4 * (i) + (j))); }
    SEL_CHUNKS(BODY_C);
#undef BODY_C
    { unsigned long long cw = ((unsigned long long)chi << 32) | clo;
        const int npc = __builtin_popcountll(cw); int base = (int)wave_prefix_sum_dpp((unsigned)npc, lane) - npc;
        while (__ballot(cw != 0ull) != 0ull) {
            if (cw != 0ull) { const int bit = __builtin_ctzll(cw); if (base < 256) clist[base] = (unsigned short)(64 * lane + bit); cw &= cw - 1ull; ++base; } } }
    mw64[lane] = ((unsigned long long)whi << 32) | wlo;
    asm volatile("s_waitcnt lgkmcnt(0)" ::: "memory");
    const int need2 = 256 - above;
    LAS unsigned* mw32 = (LAS unsigned*)mw64;
    if (cntb > 256) { select_row_slow(row, nch, mw64, lane); }
    else if (cntb <= 64) {
        const bool valid = lane < cntb; const int idx = valid ? (int)clist[lane] : 0; const unsigned key = valid ? fkey((float)row[srow_addr(idx)]) : 0u;
        bool take = valid;
        if (cntb != need2) { int rank = 0;
            for (int i = 0; i < cntb; ++i) { const unsigned ki = (unsigned)__builtin_amdgcn_readlane((int)key, i); rank += (ki > key || (ki == key && i < lane)) ? 1 : 0; }
            take = valid && rank < need2; }
        if (take) (void)__hip_atomic_fetch_or(mw32 + (idx >> 5), 1u << (idx & 31), __ATOMIC_RELAXED, __HIP_MEMORY_SCOPE_WORKGROUP);
    }
    else {
        unsigned key[4]; int idx[4]; bool take[4];
#pragma unroll
        for (int s = 0; s < 4; ++s) { const int jj = lane + 64 * s; const bool valid = jj < cntb; idx[s] = valid ? (int)clist[jj] : 0; key[s] = valid ? fkey((float)row[srow_addr(idx[s])]) : 0u; take[s] = valid; }
        if (cntb != need2) {
            unsigned tau = 0u; bool exact = false;
            for (int bit = 31; bit >= 0; --bit) { const unsigned cand = tau | (1u << bit); int cnt = 0;
#pragma unroll
                for (int s = 0; s < 4; ++s) cnt += __builtin_popcountll(__ballot(key[s] >= cand));
                if (cnt >= need2) { tau = cand; if (cnt == need2) { exact = true; break; } } }
            if (exact) {
#pragma unroll
                for (int s = 0; s < 4; ++s) take[s] = key[s] >= tau; }
            else { int cgt = 0;
#pragma unroll
                for (int s = 0; s < 4; ++s) cgt += __builtin_popcountll(__ballot(key[s] > tau));
                int rem = need2 - cgt;
#pragma unroll
                for (int s = 0; s < 4; ++s) { const bool iseq = key[s] == tau; const unsigned long long eq = __ballot(iseq);
                    const int rk = (int)__builtin_amdgcn_mbcnt_hi((unsigned)(eq >> 32), __builtin_amdgcn_mbcnt_lo((unsigned)eq, 0u));
                    take[s] = (key[s] > tau) || (iseq && rk < rem); const int ne = __builtin_popcountll(eq); rem = rem > ne ? rem - ne : 0; } }
        }
#pragma unroll
        for (int s = 0; s < 4; ++s) if (take[s]) (void)__hip_atomic_fetch_or(mw32 + (idx[s] >> 5), 1u << (idx[s] & 31), __ATOMIC_RELAXED, __HIP_MEMORY_SCOPE_WORKGROUP);
    }
    asm volatile("s_waitcnt lgkmcnt(0)" ::: "memory");
    mrow[lane] = mw64[lane];
}
__device__ __forceinline__ void indexer_scores(const bf16* QI, const bf16* KI, const float* WI, int b, int tb, int g, int ntile, LAS srow_t* Sd, int wv, int lane) {
    const int c32 = lane & 31, hl = lane >> 5;
    bf16x8 qa[2][4]; float wq[2][16];
#pragma unroll
    for (int rt = 0; rt < 2; ++rt) {
        const int quad = c32 >> 2, qq = ((quad >> 2) << 1) | (quad & 1), head = ((quad >> 1) & 1) * 4 + (c32 & 3);
        const bf16* qp = QI + (size_t)(tb + 8 * g + 4 * rt + qq) * 512 + head * 64 + 8 * hl;
#pragma unroll
        for (int ks = 0; ks < 4; ++ks) qa[rt][ks] = *(const GAS bf16x8*)(qp + 16 * ks);
        const float* w0 = WI + (size_t)(tb + 8 * g + 4 * rt + hl) * 8; const float* w1 = w0 + 16;
#pragma unroll
        for (int h = 0; h < 8; ++h) { wq[rt][h] = w0[h]; wq[rt][8 + h] = w1[h]; }
    }
    const bf16* kbase = KI + (size_t)(b * SEQ) * 64 + lane * 8;
    const int ntw = (ntile - wv + NWAVES - 1) / NWAVES;
    bf16x8 k0[4], k1[4], k2[4];
#define IDX_LOAD(dst, pi_) do { const int pc_ = (pi_) < ntw ? (pi_) : ntw - 1; const bf16* kp_ = kbase + (size_t)(wv + NWAVES * pc_) * 2048; \
        _Pragma("unroll") for (int ks = 0; ks < 4; ++ks) dst[ks] = *(const GAS bf16x8*)(kp_ + 512 * ks); } while (0)
#define IDX_TILE(kt_, kb_) do { const int sa = ((kt_) >> 3) * 256 + (32 * ((kt_) & 1) + c32) * 4 + (((kt_) >> 1) & 3); \
        _Pragma("unroll") for (int rt = 0; rt < 2; ++rt) { f32x16 acc = {}; \
            _Pragma("unroll") for (int ks = 0; ks < 4; ++ks) acc = mfma32(qa[rt][ks], kb_[ks], acc); \
            float s0 = 0.f, s1 = 0.f; \
            _Pragma("unroll") for (int h = 0; h < 8; ++h) { s0 = __builtin_fmaf(wq[rt][h], __builtin_amdgcn_fmed3f(acc[h], 0.f, 3.0e38f), s0); s1 = __builtin_fmaf(wq[rt][8 + h], __builtin_amdgcn_fmed3f(acc[8 + h], 0.f, 3.0e38f), s1); } \
            Sd[(4 * rt + hl) * 4096 + sa] = (srow_t)__builtin_amdgcn_fmed3f(s0, -65504.f, 65504.f); Sd[(4 * rt + 2 + hl) * 4096 + sa] = (srow_t)__builtin_amdgcn_fmed3f(s1, -65504.f, 65504.f); } } while (0)
    IDX_LOAD(k0, 0); IDX_LOAD(k1, 1);
    int p0 = 0;
#pragma unroll 1
    for (; p0 + 3 <= ntw; p0 += 3) {
        IDX_LOAD(k2, p0 + 2); IDX_TILE(wv + NWAVES * p0, k0);
        IDX_LOAD(k0, p0 + 3); IDX_TILE(wv + NWAVES * (p0 + 1), k1);
        IDX_LOAD(k1, p0 + 4); IDX_TILE(wv + NWAVES * (p0 + 2), k2);
    }
    if (p0 < ntw) { IDX_TILE(wv + NWAVES * p0, k0); if (p0 + 1 < ntw) IDX_TILE(wv + NWAVES * (p0 + 1), k1); }
#undef IDX_LOAD
#undef IDX_TILE
}
__device__ __forceinline__ void indexer_block(Frame& F, int b, int n) {
    const bf16* QI = wsp<bf16>(F, WS_QI); const bf16* KI = wsp<bf16>(F, WS_KI); const float* WI = wsp<float>(F, WS_WI);
    unsigned long long* MASK = wsp<unsigned long long>(F, WS_MASK);
    const int tb = b * SEQ + 64 * n, L = 64 * (n + 1), nw = n + 1;
    int lane; asm volatile("v_mbcnt_lo_u32_b32 %0, -1, 0\n\tv_mbcnt_hi_u32_b32 %0, -1, %0" : "=v"(lane));
    const int wv = F.wave, tid = wv * 64 + lane;
    if (n < 4) {
        for (int i = tid; i < 64 * 4; i += NWAVES * 64) { const int q = i >> 2, wd = i & 3; MASK[(size_t)(tb + q) * 64 + wd] = wd < nw ? ~0ull : 0ull; }
        return;
    }
    LAS srow_t* S = (LAS srow_t*)F.lds;
    LAS unsigned* hist = (LAS unsigned*)(F.lds + 131072) + wv * 256;
    LAS unsigned short* clist = (LAS unsigned short*)(F.lds + 131072 + 8192) + wv * 256;
    LAS unsigned long long* mw64 = (LAS unsigned long long*)(F.lds + 131072 + 8192 + 4096) + wv * 64;
    const int ntile = L / 32;
    indexer_scores(QI, KI, WI, b, tb, 0, ntile, S, wv, lane);
    WG_SYNC();
#pragma unroll 1
    for (int g = 0; g < 8; ++g) {
        LAS srow_t* Sc = S + (g & 1) * (8 * 4096); LAS srow_t* Sn = S + ((g + 1) & 1) * (8 * 4096);
        if (wv < 4 && g + 1 < 8) indexer_scores(QI, KI, WI, b, tb, g + 1, ntile, Sn, wv, lane);
        select_row(Sc + wv * 4096, nw, hist, clist, mw64, lane, MASK + (size_t)(tb + 8 * g + wv) * 64);
        if (wv >= 4 && g + 1 < 8) indexer_scores(QI, KI, WI, b, tb, g + 1, ntile, Sn, wv, lane);
        WG_SYNC();
    }
}
__device__ __forceinline__ void indexer_phase(Frame& F) {
    for (int u = F.vcu; u < NBATCH * 32; u += F.G) { const int b = u >> 5, j = u & 31;
#pragma unroll 1
        for (int k = 0; k < 2; ++k) indexer_block(F, b, k ? j : 63 - j); }
}

__device__ __forceinline__ void xattn_phase(Frame& F) {
    const bf16* QX = wsp<bf16>(F, WS_K); const bf16* KX = wsp<bf16>(F, WS_KX); const bf16* VT = wsp<bf16>(F, WS_VT); bf16* OX = wsp<bf16>(F, WS_QI);
    const int wv = F.wave;
    LAS float* wsf = (LAS float*)(F.lds + 131072) + wv * 64;
    for (int ui = 0; ui < 2; ++ui) {
        int lane; asm volatile("v_mbcnt_lo_u32_b32 %0, -1, 0\n\tv_mbcnt_hi_u32_b32 %0, -1, %0" : "=v"(lane)); const int tid = wv * 64 + lane, r32 = lane & 31, hi = lane >> 5;
        const int u = F.vcu * 2 + ui; if (u >= NBATCH * 4 * 16) break;
        const int bh = u >> 4, qb = u & 15, b = bh >> 2, h = bh & 3;
        const int tok = b * SEQ + qb * 256 + wv * 32 + r32;
        const bf16* qp = QX + (size_t)tok * 1024 + h * 256 + 8 * hi;
        f32x16 O[8];
#pragma unroll
        for (int i = 0; i < 8; ++i) O[i] = f32x16{};
        float mrun = -INFINITY, lrun = 0.f;
        v4u preg[4];
#define XA_LOADK(t_) do { _Pragma("unroll") for (int i = 0; i < 4; ++i) { const int ci = tid + 512 * i, r = ci >> 5, c = ci & 31; preg[i] = *(const GAS v4u*)(KX + (size_t)(b * 256 + 64 * (t_) + r) * 1024 + h * 256 + c * 8); } } while (0)
#define XA_LOADV(t_) do { _Pragma("unroll") for (int i = 0; i < 4; ++i) { const int ci = tid + 512 * i, dv = ci >> 3, c = ci & 7; preg[i] = *(const GAS v4u*)(VT + ((size_t)(b * 4 + h) * 256 + dv) * 256 + 64 * (t_) + c * 8); } } while (0)
#define XA_STOREK(buf_) do { _Pragma("unroll") for (int i = 0; i < 4; ++i) { const int ci = tid + 512 * i, r = ci >> 5, c = ci & 31; *(LAS v4u*)(F.lds + (buf_) * 65536 + r * 512 + ((c ^ (r & 15)) << 4)) = preg[i]; } } while (0)
#define XA_STOREV(buf_) do { _Pragma("unroll") for (int i = 0; i < 4; ++i) { const int ci = tid + 512 * i, dv = ci >> 3, c = ci & 7; *(LAS v4u*)(F.lds + (buf_) * 65536 + 32768 + dv * 128 + ((c ^ (dv & 7)) << 4)) = preg[i]; } } while (0)
        WG_SYNC();
        XA_LOADK(0); XA_STOREK(0); XA_LOADV(0); XA_STOREV(0);
        WG_SYNC();
        for (int t = 0; t < 4; ++t) {
            LAS unsigned char* Kt = F.lds + (t & 1) * 65536; LAS unsigned char* Vt = Kt + 32768;
            if (t < 3) XA_LOADK(t + 1);
            f32x16 p0 = f32x16{}, p1 = f32x16{};
#pragma unroll 4
            for (int ks = 0; ks < 16; ++ks) { const bf16x8 qf = *(const GAS bf16x8*)(qp + 16 * ks);
                const int c = 2 * ks + hi;
                const bf16x8 k0 = *(const LAS bf16x8*)(Kt + r32 * 512 + ((c ^ (r32 & 15)) << 4));
                const bf16x8 k1 = *(const LAS bf16x8*)(Kt + (32 + r32) * 512 + ((c ^ (r32 & 15)) << 4));
                p0 = mfma32(k0, qf, p0); p1 = mfma32(k1, qf, p1); }
            if (t < 3) { XA_STOREK((t + 1) & 1); XA_LOADV(t + 1); }
            float rm = p0[0];
#pragma unroll
            for (int r = 1; r < 16; ++r) rm = fmaxf(rm, p0[r]);
#pragma unroll
            for (int r = 0; r < 16; ++r) rm = fmaxf(rm, p1[r]);
            rm = fmaxf(rm, __shfl_xor(rm, 32));
            const float mnew = fmaxf(mrun, rm), alpha = __builtin_amdgcn_exp2f(mrun - mnew); mrun = mnew;
            float ps = 0.f;
#pragma unroll
            for (int r = 0; r < 16; ++r) { p0[r] = __builtin_amdgcn_exp2f(p0[r] - mnew); p1[r] = __builtin_amdgcn_exp2f(p1[r] - mnew); ps += p0[r] + p1[r]; }
            lrun = lrun * alpha + ps;
            if (hi == 0) wsf[r32] = alpha;
            asm volatile("s_waitcnt lgkmcnt(0)" ::: "memory");
#pragma unroll
            for (int r = 0; r < 16; ++r) { const float a = wsf[crow32(r, hi)];
#pragma unroll
                for (int i = 0; i < 8; ++i) O[i][r] *= a; }
            pg8::u32x4 pw[4];
            pw[0] = pg8::pack8((f32x4){p0[0], p0[1], p0[2], p0[3]}, (f32x4){p0[4], p0[5], p0[6], p0[7]});
            pw[1] = pg8::pack8((f32x4){p0[8], p0[9], p0[10], p0[11]}, (f32x4){p0[12], p0[13], p0[14], p0[15]});
            pw[2] = pg8::pack8((f32x4){p1[0], p1[1], p1[2], p1[3]}, (f32x4){p1[4], p1[5], p1[6], p1[7]});
            pw[3] = pg8::pack8((f32x4){p1[8], p1[9], p1[10], p1[11]}, (f32x4){p1[12], p1[13], p1[14], p1[15]});
#pragma unroll
            for (int blk = 0; blk < 8; ++blk) { const int dv = 32 * blk + r32;
#pragma unroll
                for (int s = 0; s < 4; ++s) { const int c = 2 * s + hi;
                    const bf16x8 vf = *(const LAS bf16x8*)(Vt + dv * 128 + ((c ^ (dv & 7)) << 4));
                    O[blk] = mfma32(__builtin_bit_cast(bf16x8, pw[s]), vf, O[blk]); } }
            if (t < 3) XA_STOREV((t + 1) & 1);
            WG_SYNC();
        }
#undef XA_LOADK
#undef XA_LOADV
#undef XA_STOREK
#undef XA_STOREV
        lrun += __shfl_xor(lrun, 32);
        asm volatile("s_waitcnt lgkmcnt(0)" ::: "memory");
        if (hi == 0) wsf[r32] = 1.0f / lrun;
        asm volatile("s_waitcnt lgkmcnt(0)" ::: "memory");
        bf16* ob = OX + (size_t)(b * SEQ + qb * 256 + wv * 32) * 1024 + h * 256 + r32;
#pragma unroll
        for (int r = 0; r < 16; ++r) { const int q = crow32(r, hi); const float a = wsf[q];
#pragma unroll
            for (int i = 0; i < 8; ++i) ob[(size_t)q * 1024 + 32 * i] = (bf16)f2bf(O[i][r] * a);
            if (r & 1) asm volatile("" ::: "memory"); }
    }
    WG_SYNC();
}

__device__ __forceinline__ void router_phase(Frame& F) {
    const bf16* XB = wsp<bf16>(F, WS_Q); const bf16* RT = wsp<bf16>(F, W_RT);
    const float* rowsq = (const float*)(F.ctl + CW_ROWSQ2); const float* brg = F.in[19]; const float* bre = F.in[21];
    gu32* cnt = F.ctl + CW_CNT; int* list = wsp<int>(F, WS_LIST); float* cE = wsp<float>(F, WS_CE); unsigned* tokpos = wsp<unsigned>(F, WS_TOKC);
    const int lane = F.lane, wv = F.wave, fr = lane & 15, fq = lane >> 4;
    LAS unsigned char* WL = F.lds;
    LAS float* lg = (LAS float*)(F.lds + 98304) + wv * (16 * 48);
    LAS unsigned* lcnt = (LAS unsigned*)(F.lds + 122880); LAS unsigned* gbase = lcnt + 32;
    if (F.tid < 32) lcnt[F.tid] = 0u;
    { v4u wv_[12];
#pragma unroll
      for (int j = 0; j < 12; ++j) { const int i = F.tid + 512 * j, r = i >> 7, ch = i & 127; wv_[j] = *(const GAS v4u*)(RT + (size_t)r * 1024 + ch * 8); }
#pragma unroll
      for (int j = 0; j < 12; ++j) { const int i = F.tid + 512 * j, r = i >> 7, ch = i & 127; *(LAS v4u*)(WL + r * 2048 + ((ch ^ (r & 15)) << 4)) = wv_[j]; } }
    WG_SYNC();
    for (int unit = F.vcu; unit < T / 128; unit += F.G) {
        const int tok0 = unit * 128 + wv * 16;
        const bf16* ap = XB + (size_t)(tok0 + fr) * 1024 + 8 * fq;
        bf16x8 af[32];
#pragma unroll
        for (int ks = 0; ks < 32; ++ks) af[ks] = *(const GAS bf16x8*)(ap + 32 * ks);
        f32x4 acc[3] = {f32x4{}, f32x4{}, f32x4{}};
#pragma unroll
        for (int ks = 0; ks < 32; ++ks) { const int ch = 4 * ks + fq;
#pragma unroll
            for (int ct = 0; ct < 3; ++ct) { const int r = 16 * ct + fr; const bf16x8 bb = *(const LAS bf16x8*)(WL + r * 2048 + ((ch ^ (r & 15)) << 4)); acc[ct] = mfma16(af[ks], bb, acc[ct]); } }
#pragma unroll
        for (int ct = 0; ct < 3; ++ct)
#pragma unroll
            for (int r = 0; r < 4; ++r) lg[(4 * fq + r) * 48 + 16 * ct + fr] = acc[ct][r];
        asm volatile("s_waitcnt lgkmcnt(0)" ::: "memory");
        int e0 = 0, e1 = 0, r0 = 0, r1 = 0; float c0 = 0.f, c1 = 0.f;
        if (lane < 16) { const int tok = tok0 + lane; const LAS float* l = lg + lane * 48;
            const float rs = __builtin_amdgcn_rsqf(rowsq[tok] * (1.0f / 1024.0f) + EPS);
            float gl[4]; int gs = 0; float gm;
#pragma unroll
            for (int g = 0; g < 4; ++g) gl[g] = l[g] * rs + brg[g];
            gm = gl[0];
#pragma unroll
            for (int g = 1; g < 4; ++g) if (gl[g] > gm) { gm = gl[g]; gs = g; }
            float den = 0.f;
#pragma unroll
            for (int g = 0; g < 4; ++g) den += __expf(gl[g] - gm);
            const float ggate = 1.0f / den;
            float v1 = -INFINITY, v2 = -INFINITY; int i1 = 0, i2 = 0;
            for (int e = 0; e < 8; ++e) { const float v = l[4 + 8 * gs + e] * rs + bre[gs * 8 + e];
                if (v > v1) { v2 = v1; i2 = i1; v1 = v; i1 = e; } else if (v > v2) { v2 = v; i2 = e; } }
            const float e21 = __expf(v2 - v1), w1 = ggate / (1.0f + e21), w2 = ggate * e21 / (1.0f + e21);
            const int lo = i1 < i2 ? i1 : i2, hi_ = i1 < i2 ? i2 : i1; const float clo = i1 < i2 ? w1 : w2, chi = i1 < i2 ? w2 : w1;
            e0 = gs * 8 + lo; e1 = gs * 8 + hi_; c0 = clo; c1 = chi;
            r0 = (int)__hip_atomic_fetch_add(lcnt + e0, 1u, __ATOMIC_RELAXED, __HIP_MEMORY_SCOPE_WORKGROUP); r1 = (int)__hip_atomic_fetch_add(lcnt + e1, 1u, __ATOMIC_RELAXED, __HIP_MEMORY_SCOPE_WORKGROUP); }
        WG_SYNC();
        if (F.tid < 32) { const unsigned n = lcnt[F.tid]; gbase[F.tid] = n ? __hip_atomic_fetch_add(cnt + 64 * F.tid, n, RLX_AGENT) : 0u; lcnt[F.tid] = 0u; }
        WG_SYNC();
        if (lane < 16) { const int tok = tok0 + lane; const unsigned s0 = gbase[e0] + (unsigned)r0, s1 = gbase[e1] + (unsigned)r1;
            list[(size_t)e0 * T + s0] = tok; cE[(size_t)e0 * T + s0] = c0; list[(size_t)e1 * T + s1] = tok; cE[(size_t)e1 * T + s1] = c1;
            tokpos[2 * tok] = ((unsigned)e0 << 16) | s0; tokpos[2 * tok + 1] = ((unsigned)e1 << 16) | s1; }
        asm volatile("s_waitcnt lgkmcnt(0)" ::: "memory");
    }
    WG_SYNC();
}

#define FRESH_LANE(l_) asm volatile("v_mbcnt_lo_u32_b32 %0, -1, 0\n\tv_mbcnt_hi_u32_b32 %0, -1, %0" : "=v"(l_))
__device__ __forceinline__ void final_phase(Frame& F) {
    const bf16* XB = wsp<bf16>(F, WS_Q); const bf16* YS = wsp<bf16>(F, WS_YS); const unsigned* tokpos = wsp<unsigned>(F, WS_TOKC); const float* gfin = F.in[25]; float* out = F.out;
    LAS int* pre = (LAS int*)(F.lds + 131072);
    if (F.tid == 0) { int acc = 0; for (int c = 0; c < 32; ++c) { pre[c] = acc; const int n = (int)__hip_atomic_load(F.ctl + CW_CNT + 64 * c, RLX_AGENT); acc += (n + 255) >> 8; } pre[32] = acc; }
    WG_SYNC();
    const int lane = F.lane, gw = F.vcu * NWAVES + F.wave, NGW = F.G * NWAVES;
    f32x4 g[4];
#pragma unroll
    for (int j = 0; j < 4; ++j) g[j] = *(const f32x4*)(gfin + 256 * j + 4 * lane);
    typedef unsigned u32x2_t __attribute__((ext_vector_type(2)));
    for (int m0 = gw * 4; m0 < T; m0 += NGW * 4) {
        f32x4 v[4][4]; float s[4]; size_t r0[4], r1[4];
#pragma unroll
        for (int q = 0; q < 4; ++q) { const int tok = m0 + q; const unsigned p0 = tokpos[2 * tok], p1 = tokpos[2 * tok + 1];
            r0[q] = (size_t)pre[p0 >> 16] * 256 + (p0 & 0xffffu); r1[q] = (size_t)pre[p1 >> 16] * 256 + (p1 & 0xffffu); }
#pragma unroll
        for (int q = 0; q < 4; ++q) { const int tok = m0 + q; s[q] = 0.f;
#pragma unroll
            for (int j = 0; j < 4; ++j) { const int col = 256 * j + 4 * lane;
                const u32x2_t xa = *(const GAS u32x2_t*)(XB + (size_t)tok * 1024 + col), ya = *(const GAS u32x2_t*)(YS + r0[q] * 1024 + col), za = *(const GAS u32x2_t*)(YS + r1[q] * 1024 + col);
                f32x4 t;
                t[0] = __builtin_bit_cast(float, xa.x << 16) + (__builtin_bit_cast(float, ya.x << 16) + __builtin_bit_cast(float, za.x << 16));
                t[1] = __builtin_bit_cast(float, xa.x & 0xffff0000u) + (__builtin_bit_cast(float, ya.x & 0xffff0000u) + __builtin_bit_cast(float, za.x & 0xffff0000u));
                t[2] = __builtin_bit_cast(float, xa.y << 16) + (__builtin_bit_cast(float, ya.y << 16) + __builtin_bit_cast(float, za.y << 16));
                t[3] = __builtin_bit_cast(float, xa.y & 0xffff0000u) + (__builtin_bit_cast(float, ya.y & 0xffff0000u) + __builtin_bit_cast(float, za.y & 0xffff0000u));
                v[q][j] = t; s[q] += (t[0] * t[0] + t[1] * t[1]) + (t[2] * t[2] + t[3] * t[3]); } }
#pragma unroll
        for (int o = 1; o < 64; o <<= 1) { s[0] += __shfl_xor(s[0], o); s[1] += __shfl_xor(s[1], o); s[2] += __shfl_xor(s[2], o); s[3] += __shfl_xor(s[3], o); }
#pragma unroll
        for (int q = 0; q < 4; ++q) { const float rs = __builtin_amdgcn_rsqf(s[q] * (1.0f / 1024.0f) + EPS); float* op = out + (size_t)(m0 + q) * 1024 + 4 * lane;
#pragma unroll
            for (int j = 0; j < 4; ++j) *(GAS f32x4*)(op + 256 * j) = v[q][j] * rs * g[j]; }
    }
}

struct Args { const float* in[26]; float* out; unsigned char* ws; int ph_lo, ph_hi; };
__global__ void __launch_bounds__(NWAVES * 64, 2) fwd_kernel(Args args) {
    extern __shared__ __attribute__((aligned(16))) unsigned char lds[];
    Frame F;
    F.lds = (LAS unsigned char*)lds;
    F.MISC = (volatile LAS unsigned*)(F.lds + MISC_OFF);
    F.tid = threadIdx.x; F.lane = F.tid & 63; F.wave = __builtin_amdgcn_readfirstlane(F.tid >> 6);
    F.G = gridDim.x; { const int bx = blockIdx.x; F.vcu = (F.G % 8 == 0) ? (bx % 8) * (F.G / 8) + bx / 8 : bx; }
    F.ws = args.ws; F.ctl = (gu32*)(args.ws + WS_CTL); F.out = args.out;
    F.in = args.in;
    for (int u = F.tid; u < (LDS_BYTES - LDSCTL_OFF) / 4; u += NWAVES * 64) ((LAS unsigned*)(F.lds + LDSCTL_OFF))[u] = 0u;
    __syncthreads();
    const bool one = (args.ph_hi - args.ph_lo) > 1;
    XcdBarrier bar; bar.bar = (unsigned*)(F.ctl + CW_BAR); bar.x = 0; bar.st = nullptr; bar.wave = F.wave;
    if (one) bar = xcd_barrier_post((unsigned*)(F.ctl + CW_BAR), F.MISC + 8, F.wave);
    const int lo = args.ph_lo, hi = args.ph_hi;
#define REFRESH() do { int l_; asm volatile("v_mbcnt_lo_u32_b32 %0, -1, 0\n\tv_mbcnt_hi_u32_b32 %0, -1, %0" : "=v"(l_)); F.lane = l_; F.tid = F.wave * 64 + l_; } while (0)
#ifndef MK_REPEAT_MASK
#define MK_REPEAT_MASK 0
#endif
#define REP(k) ((MK_REPEAT_MASK >> (k)) & 1)
#ifndef MK_PHASE_MASK
#define MK_PHASE_MASK 0x3FFF
#endif
#define IN(k) (((MK_PHASE_MASK >> (k)) & 1) && lo <= (k) && (k) < hi)
#ifndef MK_PROBE_BLK
#define MK_PROBE_BLK 0
#endif
#ifndef MK_STAMP_A
#define MK_STAMP_A -1
#endif
#ifndef MK_STAMP_B
#define MK_STAMP_B -1
#endif
#define SEAM(k) do { if (IN(k) && IN((k) + 1)) xcd_barrier(bar); if (MK_STAMP_A >= 0 && blockIdx.x == MK_PROBE_BLK && F.tid == 0) { const unsigned long long t_ = rt(); F.MISC[32 + 2 * (k)] = (unsigned)t_; } } while (0)
    const float* rstd0 = wsp<float>(F, WS_RSTD0);
    const float* rope = wsp<float>(F, WS_ROPE);
    const int bx = (int)blockIdx.x;

    if (MK_STAMP_A >= 0 && blockIdx.x == MK_PROBE_BLK && F.tid == 0) F.MISC[30] = (unsigned)rt();
    if (IN(0)) { REFRESH(); p0_prologue(F); if (REP(0)) { WG_SYNC(); p0_prologue(F); } if (REP(13)) { for (int xb_ = 0; xb_ < 10; ++xb_) xcd_barrier(bar); } } SEAM(0);

    if (IN(1)) for (int rep1_ = 0; rep1_ < 1 + REP(1); ++rep1_) { REFRESH();
        const pg8::bf16_t* XB = wsp<pg8::bf16_t>(F, WS_XB);
        { static_assert(W_V == W_R + 1536 * 2048 && W_G == W_V + 512 * 2048 && W_X == W_G + 1024 * 2048 && WS_K - WS_Q == WS_QI - WS_K, "in-proj weight rows contiguous; Q, K, QI equally spaced");
          pg8::Gemm g{XB, wsp<pg8::bf16_t>(F, W_R), T, 3328, 1024}; pg8::StaticOrder S; S.init(T, 3328, F.G, bx);
          pg8::EpiInProj E{pg8::EpiRope{wsp<pg8::bf16_t>(F, WS_Q), (size_t)(WS_K - WS_Q) / 2, rstd0, rope}, pg8::EpiScale{wsp<pg8::bf16_t>(F, WS_V), 512, rstd0, nullptr, EPS},
                           pg8::EpiGlu{wsp<pg8::bf16_t>(F, WS_U), rstd0}, pg8::EpiKiWi{wsp<pg8::bf16_t>(F, WS_KI), wsp<float>(F, WS_WI), rstd0, rope}};
          pg8::gemm_phase<pg8::EpiInProj, pg8::StaticOrder, PG8_ALIGN, PG8_SP2>(F.lds, g, S, E, F.wave); }
        { pg8::Gemm g{wsp<pg8::bf16_t>(F, WS_MEMB), wsp<pg8::bf16_t>(F, W_KVX), NBATCH * NMEM, 2048, 1024}; pg8::StaticOrder S; S.init(NBATCH * NMEM, 2048, F.G, (bx + 128) % F.G);
          pg8::EpiMemKV E{wsp<pg8::bf16_t>(F, WS_KXH), wsp<pg8::bf16_t>(F, WS_VH), wsp<float>(F, WS_RSTDM)};
          pg8::gemm_phase<pg8::EpiMemKV, pg8::StaticOrder, PG8_ALIGN, PG8_SP2>(F.lds, g, S, E, F.wave); }
    } SEAM(1);

    if (IN(2)) { REFRESH(); indexer_phase(F); if (REP(2)) indexer_phase(F);
        if (MK_STAMP_A >= 0 && blockIdx.x == MK_PROBE_BLK && F.tid == 0) { const unsigned t_ = (unsigned)rt(); F.MISC[30 + 2 * 51] = t_; F.MISC[32 + 2 * 50] = t_; F.MISC[30 + 2 * 50] = F.MISC[32 + 2 * 1]; }
        conv_phase(F); if (REP(12)) conv_phase(F);
        if (MK_STAMP_A >= 0 && blockIdx.x == MK_PROBE_BLK && F.tid == 0) F.MISC[32 + 2 * 51] = (unsigned)rt();
        REFRESH();
        { pg8::Gemm g{wsp<pg8::bf16_t>(F, WS_KXH), wsp<pg8::bf16_t>(F, W_QH), 0, 0, 256}; pg8::WkOrder S{F.G, F.vcu};
          pg8::EpiWk E{wsp<pg8::bf16_t>(F, WS_WK)};
          pg8::gemm_phase<pg8::EpiWk, pg8::WkOrder, PG8_ALIGN, PG8_SP2>(F.lds, g, S, E, F.wave); }
        { pg8::Gemm g{wsp<pg8::bf16_t>(F, W_OH), wsp<pg8::bf16_t>(F, WS_VH), 0, 0, 256}; pg8::VwOrder S{F.G, (F.vcu + 128) % F.G};
          pg8::EpiVw E{wsp<pg8::bf16_t>(F, WS_VWT)};
          pg8::gemm_phase<pg8::EpiVw, pg8::VwOrder, PG8_ALIGN, PG8_SP2>(F.lds, g, S, E, F.wave); }
    } SEAM(2);

    if (IN(3)) { REFRESH();
        const attn_body::AttnTensors AT{(const attn_body::bf16*)wsp<bf16>(F, WS_Q), (const attn_body::bf16*)wsp<bf16>(F, WS_K), (const attn_body::bf16*)wsp<bf16>(F, WS_V), (attn_body::bf16*)wsp<bf16>(F, WS_Q), wsp<uint2>(F, WS_MASK)};
        const attn_body::StaticOrder S((int)F.G, bx);
        if (REP(3)) attn_body::attn_phase<attn_body::StaticOrder>((char*)lds, AT, S, F.wave, true);
        attn_body::attn_phase<attn_body::StaticOrder>((char*)lds, AT, S, F.wave);
    } SEAM(3);

    if (IN(4)) for (int rep4_ = 0; rep4_ < 1 + REP(4); ++rep4_) { REFRESH();
        { pg8::Gemm g{wsp<pg8::bf16_t>(F, WS_Q), wsp<pg8::bf16_t>(F, W_OA), T, 1024, 512}; pg8::StaticOrder S; S.init(T, 1024, F.G, bx);
          pg8::EpiScale E{wsp<pg8::bf16_t>(F, WS_K), 1024, nullptr, nullptr, EPS};
          pg8::gemm_phase<pg8::EpiScale, pg8::StaticOrder, PG8_ALIGN, PG8_SP2>(F.lds, g, S, E, F.wave); }
        { pg8::Gemm g{wsp<pg8::bf16_t>(F, WS_CA), wsp<pg8::bf16_t>(F, W_CO), T, 1024, 512}; pg8::StaticOrder S; S.init(T, 1024, F.G, bx);
          pg8::EpiScale E{wsp<pg8::bf16_t>(F, WS_QI), 1024, nullptr, nullptr, EPS};
          pg8::gemm_phase<pg8::EpiScale, pg8::StaticOrder, PG8_ALIGN, PG8_SP2>(F.lds, g, S, E, F.wave); }
    } SEAM(4);

    if (IN(5)) for (int rep5_ = 0; rep5_ < 1 + REP(5); ++rep5_) { REFRESH();
        pg8::Gemm g{wsp<pg8::bf16_t>(F, WS_XB), wsp<pg8::bf16_t>(F, W_GT), T, 2048, 1024}; pg8::StaticOrder S; S.init(T, 2048, F.G, bx);
        pg8::EpiMerge E{wsp<pg8::bf16_t>(F, WS_K), wsp<pg8::bf16_t>(F, WS_QI), wsp<pg8::bf16_t>(F, WS_Q), rstd0};
        pg8::gemm_phase<pg8::EpiMerge, pg8::StaticOrder, PG8_ALIGN, PG8_SP2>(F.lds, g, S, E, F.wave);
    } SEAM(5);

    if (IN(6)) { REFRESH();
        pg8::Gemm g{wsp<pg8::bf16_t>(F, WS_Q), wsp<pg8::bf16_t>(F, W_OUT), T, 1024, 1024}; pg8::StaticOrder S; S.init(T, 1024, F.G, bx);
        pg8::EpiResid E{wsp<pg8::bf16_t>(F, WS_XB), wsp<pg8::bf16_t>(F, WS_XB), (float*)(F.ctl + CW_ROWSQ1)};
        pg8::gemm_phase<pg8::EpiResid, pg8::StaticOrder, PG8_ALIGN, PG8_SP2>(F.lds, g, S, E, F.wave);
    } SEAM(6);

    if (IN(7)) { REFRESH();
        static_assert(PG8_ALIGN, "EpiSoftmax takes workgroup barriers inside the epilogue: both half-workgroups must run it together");
        pg8::Gemm g{wsp<pg8::bf16_t>(F, WS_XB), wsp<pg8::bf16_t>(F, WS_WK), T, 1024, 1024}; pg8::BatchOrder S; S.init(T, 1024, F.G, bx);
        pg8::EpiSoftmax E{wsp<pg8::bf16_t>(F, WS_K), (const float*)(F.ctl + CW_ROWSQ1), EPS, (PG8_LAS float*)(F.lds + 131072 + 4096)};
        pg8::gemm_phase<pg8::EpiSoftmax, pg8::BatchOrder, PG8_ALIGN, PG8_SP2>(F.lds, g, S, E, F.wave);
    } SEAM(7);


    if (IN(9)) { REFRESH();
        pg8::Gemm g{wsp<pg8::bf16_t>(F, WS_K), wsp<pg8::bf16_t>(F, WS_VWT), T, 1024, 1024}; pg8::BatchOrder S; S.init(T, 1024, F.G, bx);
        pg8::EpiResid E{wsp<pg8::bf16_t>(F, WS_XB), wsp<pg8::bf16_t>(F, WS_Q), (float*)(F.ctl + CW_ROWSQ2)};
        pg8::gemm_phase<pg8::EpiResid, pg8::BatchOrder, PG8_ALIGN, PG8_SP2>(F.lds, g, S, E, F.wave);
    } SEAM(9);

    if (IN(10)) { REFRESH(); router_phase(F); } SEAM(10);

    if (IN(11) || IN(12)) {
        REFRESH();
        LAS int* pre = (LAS int*)(F.lds + 131072); LAS int* cntl = pre + 64; LAS unsigned char* t2e = (LAS unsigned char*)(pre + 128);
        if (F.tid == 0) { int acc = 0; for (int c = 0; c < 32; ++c) { pre[c] = acc; const int n = (int)__hip_atomic_load(F.ctl + CW_CNT + 64 * c, RLX_AGENT); cntl[c] = n; const int nt_ = (n + 255) >> 8; for (int q = 0; q < nt_; ++q) t2e[acc + q] = (unsigned char)c; acc += nt_; } pre[32] = acc;
            const int G_ = F.G, U1 = 2 * acc, U2 = 4 * acc, al = U1 / G_, H = U1 % G_;
            int Tt = 15 * al + 3 * (U2 / G_), nl = 0, nh = 0, f = 0;
            for (;; ++Tt) { nl = (Tt - 15 * al) / 3; nh = (Tt - 15 * (al + 1)) / 3; nl = nl > 0 ? nl : 0; nh = nh > 0 ? nh : 0; f = H * nh + (G_ - H) * nl; if (f >= U2) break; }
            const int X = f - U2, Xl = nl > 0 ? (X < G_ - H ? X : G_ - H) : 0, Xh = X - Xl;
            const int g0 = (F.vcu >> 5) << 5, g1 = g0 + 32 < G_ ? g0 + 32 : G_;
            int se[2];
            for (int q = 0; q < 2; ++q) { const int c_ = q ? g1 : g0;
                if (c_ <= H) { const int d = c_ - (H - Xh); se[q] = c_ * nh - (d > 0 ? d : 0); }
                else { const int d = c_ - (G_ - Xl); se[q] = H * nh - Xh + (c_ - H) * nl - (d > 0 ? d : 0); } }
            pre[96] = se[0]; pre[97] = se[1]; pre[98] = (int)0xFFFE0000u; pre[99] = F.vcu - g0; pre[100] = g1 - g0; }
        WG_SYNC();
        if (MK_STAMP_A >= 0 && blockIdx.x == MK_PROBE_BLK && F.tid == 0) F.MISC[230] = (unsigned)rt();
        if (IN(11)) {
            const int U1_ = 2 * pre[32], al_ = U1_ / (int)F.G;
#pragma unroll 1
            for (int call = 0; call < 2; ++call) { const int r0 = call ? al_ : 0, r1 = call ? al_ + 1 : al_;
                REFRESH();
                pg8::MoeOrderT<1> S{pre, cntl, t2e, wsp<int>(F, WS_LIST), F.G, F.vcu, T, r0, r1};
                pg8::Gemm g{wsp<pg8::bf16_t>(F, WS_Q), wsp<pg8::bf16_t>(F, W_E1), 0, 0, 1024};
                pg8::EpiMoeH E{wsp<pg8::bf16_t>(F, WS_HS), (const float*)(F.ctl + CW_ROWSQ2), wsp<float>(F, WS_CE), EPS, S};
                pg8::gemm_phase<pg8::EpiMoeH, pg8::MoeOrderT<1>, PG8_ALIGN, PG8_SP2, true>(F.lds, g, S, E, F.wave);
                if (r0 * (int)F.G + F.vcu >= U1_ || r0 >= r1) { if (MK_STAMP_A >= 0 && blockIdx.x == MK_PROBE_BLK && F.tid == 0) F.MISC[232 + 2 * call] = (unsigned)rt(); continue; }
                asm volatile("s_waitcnt vmcnt(0)" ::: "memory"); WG_SYNC(); REFRESH();
                if (F.tid == 0) { __builtin_amdgcn_fence(__ATOMIC_RELEASE, "agent"); asm volatile("s_waitcnt vmcnt(0)" ::: "memory");
                    unsigned n_ = 0u;
                    for (int r = r0; r < r1; ++r) { const int L = r * (int)F.G + F.vcu; if (L < U1_) { (void)__hip_atomic_fetch_add(F.ctl + CW_RDY + 64 * (L >> 1), 1u, RLX_AGENT); ++n_; } }
                    (void)__hip_atomic_fetch_add(F.ctl + CW_RDYTOT + 64 * call, n_, RLX_AGENT); }
                if (MK_STAMP_A >= 0 && blockIdx.x == MK_PROBE_BLK && F.tid == 0) F.MISC[232 + 2 * call] = (unsigned)rt();
            }
        }
        if (MK_STAMP_A >= 0 && blockIdx.x == MK_PROBE_BLK && F.tid == 0) { const unsigned long long t_ = rt(); F.MISC[32 + 2 * 11] = (unsigned)t_; }
#ifdef MK_DEP_BARRIER
        xcd_barrier(bar);
#endif
        if (IN(12)) {
            WG_SYNC();
            REFRESH();
            const int U1_ = 2 * pre[32], fu_ = (U1_ / (int)F.G) * (int)F.G;
            pg8::MoeOrder2 S{pre, t2e, (LAS unsigned*)(pre + 98), F.ctl + CW_RDY, F.ctl + CW_RDYTOT, pre[96], pre[97], pre[99], pre[100], F.wave, fu_ >> 1, (unsigned)fu_, (unsigned)U1_};
            pg8::Gemm g{wsp<pg8::bf16_t>(F, WS_HS), wsp<pg8::bf16_t>(F, W_E2), 0, 0, 256};
            pg8::EpiMoeY E{wsp<pg8::bf16_t>(F, WS_YS)};
            pg8::gemm_phase<pg8::EpiMoeY, pg8::MoeOrder2, PG8_ALIGN, PG8_SP2, false>(F.lds, g, S, E, F.wave);
            if (MK_STAMP_A >= 0 && blockIdx.x == MK_PROBE_BLK && F.tid == 0) F.MISC[236] = (unsigned)rt();
        }
    } SEAM(12);
    if (MK_STAMP_A >= 0 && blockIdx.x == MK_PROBE_BLK && F.tid == 0) { const unsigned t_ = (unsigned)rt(); F.MISC[238] = t_; F.MISC[242] = t_; F.MISC[240] = F.MISC[230]; }

    if (IN(13)) { REFRESH(); final_phase(F); if (REP(14)) final_phase(F); }
    if (MK_STAMP_A >= 0) {
        xcd_barrier(bar);
        if (blockIdx.x == MK_PROBE_BLK) { if (F.tid == 0) { F.MISC[32 + 2 * 13] = (unsigned)rt();
                const unsigned a0_ = F.MISC[30 + 2 * MK_STAMP_A], a1_ = F.MISC[32 + 2 * MK_STAMP_A]; F.out[0] = (float)(a1_ - a0_) * 0.01f * (MK_STAMP_A >= 100 ? 1.0f : 0.25f);
                const unsigned b0_ = F.MISC[30 + 2 * (MK_STAMP_B < 0 ? 0 : MK_STAMP_B)], b1_ = F.MISC[32 + 2 * (MK_STAMP_B < 0 ? 0 : MK_STAMP_B)]; F.MISC[29] = __builtin_bit_cast(unsigned, (MK_STAMP_B >= 100 ? 0.032f : 0.008f) * sqrtf((float)(b1_ - b0_) * 0.01f)); }
            __syncthreads();
            if (MK_STAMP_B >= 0) { const float dd_ = __builtin_bit_cast(float, (unsigned)F.MISC[29]); for (int i = F.tid; i < (1 << 20); i += 512) F.out[(1 << 20) + i] += dd_; } }
    }
#undef IN
#undef SEAM
#undef REFRESH
}

constexpr int N_PHASES = 14;
#ifndef MK_ONE_LAUNCH
#define MK_ONE_LAUNCH 1
#endif
extern "C" void kernel_launch(void* const* d_in, const int* in_sizes, int n_in, void* d_out, int out_size, void* d_ws, size_t ws_size, hipStream_t stream) {
    static int grid = 0;
    if (grid == 0) {
        if (n_in != 26 || in_sizes[0] != T * DM || out_size != T * DM || ws_size < WS_END) { fprintf(stderr, "kernel_launch: unexpected shapes (n_in %d, in0 %d, out %d, ws %zu); nothing launched\n", n_in, n_in > 0 ? in_sizes[0] : -1, out_size, ws_size); grid = -1; return; }
        int dev = 0, cus = 0, per_cu = 0;
        if (hipGetDevice(&dev) != hipSuccess || hipDeviceGetAttribute(&cus, hipDeviceAttributeMultiprocessorCount, dev) != hipSuccess) { grid = -1; return; }
        if (hipFuncSetAttribute((const void*)fwd_kernel, hipFuncAttributeMaxDynamicSharedMemorySize, LDS_BYTES) != hipSuccess) { fprintf(stderr, "kernel_launch: hipFuncSetAttribute failed\n"); grid = -1; return; }
        if (hipOccupancyMaxActiveBlocksPerMultiprocessor(&per_cu, (const void*)fwd_kernel, NWAVES * 64, LDS_BYTES) != hipSuccess || per_cu < 1) { fprintf(stderr, "kernel_launch: occupancy query says %d blocks per CU\n", per_cu); }
        (void)hipGetLastError();
        grid = cus;
    }
    if (grid < 0) return;
    if (hipMemsetAsync((char*)d_ws + WS_CTL, 0, CTL_ZERO_BYTES, stream) != hipSuccess) return;
    Args a{};
    for (int i = 0; i < 26; ++i) a.in[i] = (const float*)d_in[i];
    a.out = (float*)d_out; a.ws = (unsigned char*)d_ws;
#if MK_ONE_LAUNCH
    a.ph_lo = 0; a.ph_hi = N_PHASES;
    hipLaunchKernelGGL(fwd_kernel, dim3(grid), dim3(NWAVES * 64), LDS_BYTES, stream, a);
#else
    for (int p = 0; p < N_PHASES; ++p) { a.ph_lo = p; a.ph_hi = p + 1; hipLaunchKernelGGL(fwd_kernel, dim3(grid), dim3(NWAVES * 64), LDS_BYTES, stream, a); }
#endif
}
```

```cpp
#include <hip/hip_runtime.h>
#include <hip/hip_bf16.h>
#include <cstdio>
#include <cstdint>
#include <cmath>
namespace pg8 {
#define PG8_LAS __attribute__((address_space(3)))
typedef unsigned short bf16_t;
typedef short bf16x8 __attribute__((ext_vector_type(8)));
typedef float f32x4 __attribute__((ext_vector_type(4)));
typedef unsigned u32x4 __attribute__((ext_vector_type(4)));
typedef int i32x4 __attribute__((ext_vector_type(4)));
constexpr int BM = 256, BK = 64, HALF = 128, HTB = HALF * BK * 2  , STAGE_BYTES = 8 * HTB, NXCD = 8, WGM = 8;

__host__ __device__ __forceinline__ int lds_byte(int r, int c) { const int st = (r >> 4) * 2 + (c >> 5), rr = r & 15, cc = c & 31, ob = rr * 64 + cc * 2; return st * 1024 + (ob ^ (((ob >> 9) & 1) << 5)); }
__host__ __device__ __forceinline__ void stage_rc(int b, int& R, int& C) { const int st = b / 1024, sb = b % 1024, swz = sb ^ (((sb >> 9) & 1) << 5); R = (st >> 1) * 16 + swz / 64; C = (st & 1) * 32 + (swz % 64) / 2; }
__host__ __device__ __forceinline__ int perm32(int rho) { const int n = rho >> 4, i = rho & 15; return 8 * (i >> 2) + 4 * n + (i & 3); }

struct Unit { int pm, pn; };
struct Gemm { const bf16_t* A; const bf16_t* Bt; int M, N, K; };

struct StaticOrder {
    int nM, nN, nwg, G, c;
    __host__ __device__ void init(int M, int N, int G_, int c_) { nM = M / BM; nN = N / BM; nwg = nM * nN; G = G_; c = c_; }
    __host__ __device__ bool next(int i, Unit& u) const {
        const long L = (long)i * G + c; if (L >= nwg) return false;
        int wgid = (int)L; { const int q = nwg / NXCD, r = nwg % NXCD, xcd = wgid % NXCD, off = wgid / NXCD; wgid = (xcd < r ? xcd * (q + 1) : r * (q + 1) + (xcd - r) * q) + off; }
        const int nig = WGM * nN, gid = wgid / nig, fm = gid * WGM, gsz = (nM - fm) < WGM ? (nM - fm) : WGM;
        u.pm = fm + ((wgid % nig) % gsz); u.pn = (wgid % nig) / gsz; return true;
    }
    __device__ __forceinline__ void a_ready(const Unit&) const {}
    __device__ __forceinline__ void done(const Unit&) const {}
};

__device__ __forceinline__ unsigned cvt_pk_bf16(float lo, float hi) { unsigned r; asm volatile("v_cvt_pk_bf16_f32 %0, %1, %2" : "=v"(r) : "v"(lo), "v"(hi)); return r; }
typedef float f32x2 __attribute__((ext_vector_type(2)));
__device__ __forceinline__ f32x2 gelu_pk(f32x2 v) {
    const f32x2 av = __builtin_elementwise_abs(v), d = av * 0.2316418882f + 1.0f;
    f32x2 t; t.x = __builtin_amdgcn_rcpf(d.x); t.y = __builtin_amdgcn_rcpf(d.y);
    f32x2 q = t * 0.5307027145f + (-0.7265760135f); q = q * t + 0.7107068705f; q = q * t + (-0.142248368f); q = q * t + 0.127414796f; q = q * t;
    const f32x2 s = (v * v) * (-0.72134752044f);
    f32x2 e; e.x = __builtin_amdgcn_exp2f(s.x); e.y = __builtin_amdgcn_exp2f(s.y);
    const f32x2 m = v * (q * e), r = v - m;
    f32x2 o; o.x = v.x < 0.f ? m.x : r.x; o.y = v.y < 0.f ? m.y : r.y; return o;
}

template <int ACT  > struct EpiBf16 {
    static constexpr bool PERM = true, AFTER_DRAIN = false; static_assert(ACT == 0 || ACT == 1, "EpiBf16: ACT is 0 (none) or 1 (gelu_pk)");
    bf16_t* O; int ldc; const float* bias; int split_cols; size_t split_stride; float scale0;
    __device__ __forceinline__ void operator()(const f32x4 (&acc)[2][2][4][2], const Unit& u, int wr, int wc, int fr, int fq) const {
        const int row0 = u.pm * BM + wr * 64 + fr; int colt = u.pn * BM; bf16_t* base = O;
        float sc = 1.f; if (split_cols) { const int t = colt / split_cols; base += (size_t)t * split_stride; colt -= t * split_cols; if (t == 0) sc = scale0; }
        const int col0 = colt + wc * 32 + 8 * fq, bcol0 = u.pn * BM + wc * 32 + 8 * fq;
        f32x4 bv[2][2];
#pragma unroll
        for (int bj = 0; bj < 2; ++bj)
#pragma unroll
            for (int n = 0; n < 2; ++n) bv[bj][n] = bias ? *(const f32x4*)(bias + bcol0 + bj * HALF + 4 * n) : (f32x4){0.f, 0.f, 0.f, 0.f};
#pragma unroll
        for (int ai = 0; ai < 2; ++ai)
#pragma unroll
            for (int m = 0; m < 4; ++m) { bf16_t* rowp = base + (size_t)(row0 + ai * HALF + m * 16) * ldc + col0;
#pragma unroll
                for (int bj = 0; bj < 2; ++bj) { f32x4 v0 = acc[ai][bj][m][0] + bv[bj][0], v1 = acc[ai][bj][m][1] + bv[bj][1];
                    if (ACT == 1) { f32x2 a = gelu_pk((f32x2){v0[0], v0[1]}), b = gelu_pk((f32x2){v0[2], v0[3]}), c = gelu_pk((f32x2){v1[0], v1[1]}), d = gelu_pk((f32x2){v1[2], v1[3]});
                        v0 = (f32x4){a.x, a.y, b.x, b.y}; v1 = (f32x4){c.x, c.y, d.x, d.y}; }
                    v0 = v0 * sc; v1 = v1 * sc; u32x4 w; w.x = cvt_pk_bf16(v0[0], v0[1]); w.y = cvt_pk_bf16(v0[2], v0[3]); w.z = cvt_pk_bf16(v1[0], v1[1]); w.w = cvt_pk_bf16(v1[2], v1[3]);
                    *(u32x4*)(rowp + bj * HALF) = w; } }
    }
};
__device__ __forceinline__ u32x4 pack8(const f32x4& a, const f32x4& b) { u32x4 w; w.x = cvt_pk_bf16(a[0], a[1]); w.y = cvt_pk_bf16(a[2], a[3]); w.z = cvt_pk_bf16(b[0], b[1]); w.w = cvt_pk_bf16(b[2], b[3]); return w; }
__device__ __forceinline__ unsigned short f2bf_rne(float f) { unsigned u = __builtin_bit_cast(unsigned, f); return (unsigned short)((u + 0x7fffu + ((u >> 16) & 1u)) >> 16); }
__device__ __forceinline__ f32x4 bf_lo4(const u32x4& w) { return (f32x4){__builtin_bit_cast(float, w.x << 16), __builtin_bit_cast(float, w.x & 0xffff0000u), __builtin_bit_cast(float, w.y << 16), __builtin_bit_cast(float, w.y & 0xffff0000u)}; }
__device__ __forceinline__ f32x4 bf_hi4(const u32x4& w) { return (f32x4){__builtin_bit_cast(float, w.z << 16), __builtin_bit_cast(float, w.z & 0xffff0000u), __builtin_bit_cast(float, w.w << 16), __builtin_bit_cast(float, w.w & 0xffff0000u)}; }
__device__ __forceinline__ f32x4 sigmoid4(const f32x4& v) { f32x4 r;
#pragma unroll
    for (int i = 0; i < 4; ++i) r[i] = __builtin_amdgcn_rcpf(1.0f + __builtin_amdgcn_exp2f(-1.4426950408889634f * v[i]));
    return r; }

struct EpiRope {
    static constexpr bool PERM = true, AFTER_DRAIN = false;
    bf16_t* O0; size_t tstride; const float* rstd; const float* rope;
    __device__ __forceinline__ void operator()(const f32x4 (&acc)[2][2][4][2], const Unit& u, int wr, int wc, int fr, int fq) const {
        bf16_t* base = O0 + (size_t)(u.pn >> 1) * tstride + (((u.pn & 1) * 4 + wc) * 64 + 8 * fq);
        const int row0 = u.pm * BM + wr * 64 + fr;
#pragma unroll
        for (int ai = 0; ai < 2; ++ai)
#pragma unroll
            for (int m = 0; m < 4; ++m) {
                const int row = row0 + ai * HALF + m * 16; const float rs = rstd[row];
                const float* rp = rope + (size_t)row * 64 + 8 * fq;
                const f32x4 c0 = *(const f32x4*)rp, c1 = *(const f32x4*)(rp + 4), s0 = *(const f32x4*)(rp + 32), s1 = *(const f32x4*)(rp + 36);
                const f32x4 x1a = acc[ai][0][m][0] * rs, x1b = acc[ai][0][m][1] * rs, x2a = acc[ai][1][m][0] * rs, x2b = acc[ai][1][m][1] * rs;
                bf16_t* op = base + (size_t)row * 512;
                *(u32x4*)op = pack8(x1a * c0 - x2a * s0, x1b * c1 - x2b * s1);
                *(u32x4*)(op + 32) = pack8(x2a * c0 + x1a * s0, x2b * c1 + x1b * s1);
            }
    }
};
struct EpiScale {
    static constexpr bool PERM = true, AFTER_DRAIN = false;
    bf16_t* O; int ldc; const float* rstd; const float* rowsq; float eps; unsigned* rmax = nullptr;
    __device__ __forceinline__ void operator()(const f32x4 (&acc)[2][2][4][2], const Unit& u, int wr, int wc, int fr, int fq) const {
        const int row0 = u.pm * BM + wr * 64 + fr, col0 = u.pn * BM + wc * 32 + 8 * fq;
#pragma unroll
        for (int ai = 0; ai < 2; ++ai)
#pragma unroll
            for (int m = 0; m < 4; ++m) {
                const int row = row0 + ai * HALF + m * 16;
                const float rs = rstd ? rstd[row] : (rowsq ? __builtin_amdgcn_rsqf(rowsq[row] * (1.0f / 1024.0f) + eps) : 1.0f);
                bf16_t* op = O + (size_t)row * ldc + col0;
#pragma unroll
                for (int bj = 0; bj < 2; ++bj) *(u32x4*)(op + bj * HALF) = pack8(acc[ai][bj][m][0] * rs, acc[ai][bj][m][1] * rs);
                if (rmax) { float mx = 0.f;
#pragma unroll
                    for (int bj = 0; bj < 2; ++bj)
#pragma unroll
                        for (int n = 0; n < 2; ++n)
#pragma unroll
                            for (int j = 0; j < 4; ++j) mx = __builtin_amdgcn_fmed3f(mx, __builtin_fabsf(acc[ai][bj][m][n][j]), INFINITY);
                    mx *= __builtin_fabsf(rs); mx = fmaxf(mx, __shfl_xor(mx, 16)); mx = fmaxf(mx, __shfl_xor(mx, 32));
                    if (fq == 0) atomicMax(rmax + row, __builtin_bit_cast(unsigned, mx * 1.01f)); }
            }
    }
};
struct EpiMemKV {
    static constexpr bool PERM = true, AFTER_DRAIN = false;
    bf16_t* KXH; bf16_t* VH; const float* rstd;
    __device__ __forceinline__ void operator()(const f32x4 (&acc)[2][2][4][2], const Unit& u, int wr, int wc, int fr, int fq) const {
        const int row0 = u.pm * BM + wr * 64 + fr, col0 = (u.pn & 3) * BM + wc * 32 + 8 * fq; bf16_t* base = u.pn < 4 ? KXH : VH;
#pragma unroll
        for (int ai = 0; ai < 2; ++ai)
#pragma unroll
            for (int m = 0; m < 4; ++m) {
                const int row = row0 + ai * HALF + m * 16; const float rs = rstd[row]; const int b = row >> 8, key = row & 255;
#pragma unroll
                for (int bj = 0; bj < 2; ++bj) { const int col = col0 + bj * HALF, h = col >> 8, d = col & 255;
                    *(u32x4*)(base + ((size_t)(b * 4 + h) * 256 + key) * 256 + d) = pack8(acc[ai][bj][m][0] * rs, acc[ai][bj][m][1] * rs); }
            }
    }
};
struct EpiGlu {
    static constexpr bool PERM = true, AFTER_DRAIN = false;
    bf16_t* U; const float* rstd;
    __device__ __forceinline__ void operator()(const f32x4 (&acc)[2][2][4][2], const Unit& u, int wr, int wc, int fr, int fq) const {
        const int row0 = u.pm * BM + wr * 64 + fr, col0 = u.pn * HALF + wc * 32 + 8 * fq;
#pragma unroll
        for (int ai = 0; ai < 2; ++ai)
#pragma unroll
            for (int m = 0; m < 4; ++m) {
                const int row = row0 + ai * HALF + m * 16; const float rs = rstd[row];
                const f32x4 a0 = acc[ai][0][m][0] * rs, a1 = acc[ai][0][m][1] * rs, b0 = acc[ai][1][m][0] * rs, b1 = acc[ai][1][m][1] * rs;
                *(u32x4*)(U + (size_t)row * 512 + col0) = pack8(a0 * sigmoid4(b0), a1 * sigmoid4(b1));
            }
    }
};
struct EpiKiWi {
    static constexpr bool PERM = true, AFTER_DRAIN = false;
    bf16_t* KI; float* WI; const float* rstd; const float* rope;
    __device__ __forceinline__ void operator()(const f32x4 (&acc)[2][2][4][2], const Unit& u, int wr, int wc, int fr, int fq) const {
        const int row0 = u.pm * BM + wr * 64 + fr;
        if (wc == 0) {
#pragma unroll
            for (int ai = 0; ai < 2; ++ai)
#pragma unroll
                for (int m = 0; m < 4; ++m) {
                    const int row = row0 + ai * HALF + m * 16; const float rs = rstd[row];
                    const float* rp = rope + (size_t)row * 64 + 8 * fq;
                    const f32x4 c0 = *(const f32x4*)rp, c1 = *(const f32x4*)(rp + 4), s0 = *(const f32x4*)(rp + 32), s1 = *(const f32x4*)(rp + 36);
                    const f32x4 x1a = acc[ai][0][m][0] * rs, x1b = acc[ai][0][m][1] * rs, x2a = acc[ai][1][m][0] * rs, x2b = acc[ai][1][m][1] * rs;
                    bf16_t* op = KI + (((size_t)(row >> 5) * 4 + (fq >> 1)) * 64 + (fq & 1) * 32 + (row & 31)) * 8;
                    *(u32x4*)op = pack8(x1a * c0 - x2a * s0, x1b * c1 - x2b * s1);
                    *(u32x4*)(op + 2 * 64 * 8) = pack8(x2a * c0 + x1a * s0, x2b * c1 + x1b * s1);
                }
        } else if (wc == 1 && fq == 0) {
#pragma unroll
            for (int ai = 0; ai < 2; ++ai)
#pragma unroll
                for (int m = 0; m < 4; ++m) {
                    const int row = row0 + ai * HALF + m * 16; const float rs = rstd[row];
                    float* op = WI + (size_t)row * 8;
                    *(f32x4*)op = acc[ai][0][m][0] * rs; *(f32x4*)(op + 4) = acc[ai][0][m][1] * rs;
                }
        }
    }
};
struct EpiMerge {
    static constexpr bool PERM = true, AFTER_DRAIN = false;
    const bf16_t* YA; const bf16_t* YC; signed char* MG; const float* rstd; const float* rmaxA; const float* rmaxC;
    __device__ __forceinline__ void operator()(const f32x4 (&acc)[2][2][4][2], const Unit& u, int wr, int wc, int fr, int fq) const {
        const int row0 = u.pm * BM + wr * 64 + fr, col0 = u.pn * HALF + wc * 32 + 8 * fq;
#pragma unroll
        for (int ai = 0; ai < 2; ++ai)
#pragma unroll
            for (int m = 0; m < 4; ++m) {
                const int row = row0 + ai * HALF + m * 16; const float rs = rstd[row]; const size_t off = (size_t)row * 1024 + col0;
                const u32x4 ya = *(const u32x4*)(YA + off), yc = *(const u32x4*)(YC + off);
                const f32x4 o0 = sigmoid4(acc[ai][0][m][0] * rs) * bf_lo4(ya) + sigmoid4(acc[ai][1][m][0] * rs) * bf_lo4(yc);
                const f32x4 o1 = sigmoid4(acc[ai][0][m][1] * rs) * bf_hi4(ya) + sigmoid4(acc[ai][1][m][1] * rs) * bf_hi4(yc);
                const float bnd = rmaxA[row] + rmaxC[row], inv = bnd > 0.f ? 127.0f / bnd : 0.f;
                const unsigned lo = (unsigned)((int)__builtin_rintf(o0[0] * inv) & 255) | ((unsigned)((int)__builtin_rintf(o0[1] * inv) & 255) << 8) | ((unsigned)((int)__builtin_rintf(o0[2] * inv) & 255) << 16) | ((unsigned)((int)__builtin_rintf(o0[3] * inv) & 255) << 24);
                const unsigned hi = (unsigned)((int)__builtin_rintf(o1[0] * inv) & 255) | ((unsigned)((int)__builtin_rintf(o1[1] * inv) & 255) << 8) | ((unsigned)((int)__builtin_rintf(o1[2] * inv) & 255) << 16) | ((unsigned)((int)__builtin_rintf(o1[3] * inv) & 255) << 24);
                *(unsigned long long*)(MG + off) = (unsigned long long)lo | ((unsigned long long)hi << 32);
            }
    }
};
struct EpiResid {
    static constexpr bool PERM = true, AFTER_DRAIN = false;
    const bf16_t* resid; bf16_t* xb; float* rowsq;
    __device__ __forceinline__ void operator()(const f32x4 (&acc)[2][2][4][2], const Unit& u, int wr, int wc, int fr, int fq) const {
        const int row0 = u.pm * BM + wr * 64 + fr, col0 = (u.pn & 3) * BM + wc * 32 + 8 * fq;
#pragma unroll
        for (int ai = 0; ai < 2; ++ai)
#pragma unroll
            for (int m = 0; m < 4; ++m) {
                const int row = row0 + ai * HALF + m * 16; float ss = 0.f;
#pragma unroll
                for (int bj = 0; bj < 2; ++bj) { const size_t off = (size_t)row * 1024 + col0 + bj * HALF;
                    const u32x4 rw = *(const u32x4*)(resid + off);
                    const f32x4 v0 = bf_lo4(rw) + acc[ai][bj][m][0], v1 = bf_hi4(rw) + acc[ai][bj][m][1];
                    *(u32x4*)(xb + off) = pack8(v0, v1);
                    ss += (v0[0] * v0[0] + v0[1] * v0[1]) + (v0[2] * v0[2] + v0[3] * v0[3]) + (v1[0] * v1[0] + v1[1] * v1[1]) + (v1[2] * v1[2] + v1[3] * v1[3]); }
                ss += __shfl_xor(ss, 16); ss += __shfl_xor(ss, 32);
                if (fq == 0) atomicAdd(rowsq + row, ss);
            }
    }
};
struct EpiResidX {
    static constexpr bool PERM = true, AFTER_DRAIN = false;
    const float* resid; bf16_t* xb; float* rowsq; const float* rmaxA; const float* rmaxC;
    __device__ __forceinline__ void operator()(const f32x4 (&acc)[2][2][4][2], const Unit& u, int wr, int wc, int fr, int fq) const {
        const int row0 = u.pm * BM + wr * 64 + fr, col0 = (u.pn & 3) * BM + wc * 32 + 8 * fq;
#pragma unroll
        for (int ai = 0; ai < 2; ++ai)
#pragma unroll
            for (int m = 0; m < 4; ++m) {
                const int row = row0 + ai * HALF + m * 16; float ss = 0.f; const float rsc = (rmaxA[row] + rmaxC[row]) * (1.0f / 127.0f);
#pragma unroll
                for (int bj = 0; bj < 2; ++bj) { const size_t off = (size_t)row * 1024 + col0 + bj * HALF;
                    const f32x4 r0 = *(const f32x4*)(resid + off), r1 = *(const f32x4*)(resid + off + 4);
                    const f32x4 v0 = r0 + acc[ai][bj][m][0] * rsc, v1 = r1 + acc[ai][bj][m][1] * rsc;
                    *(u32x4*)(xb + off) = pack8(v0, v1);
                    ss += (v0[0] * v0[0] + v0[1] * v0[1]) + (v0[2] * v0[2] + v0[3] * v0[3]) + (v1[0] * v1[0] + v1[1] * v1[1]) + (v1[2] * v1[2] + v1[3] * v1[3]); }
                ss += __shfl_xor(ss, 16); ss += __shfl_xor(ss, 32);
                if (fq == 0) atomicAdd(rowsq + row, ss);
            }
    }
};
struct EpiInProj {
    static constexpr bool PERM = true, AFTER_DRAIN = false;
    EpiRope rope; EpiScale v; EpiGlu glu; EpiKiWi kw;
    __device__ __forceinline__ void operator()(const f32x4 (&acc)[2][2][4][2], const Unit& u, int wr, int wc, int fr, int fq) const {
        if (u.pn < 6) rope(acc, u, wr, wc, fr, fq);
        else if (u.pn < 8) { Unit u2 = u; u2.pn -= 6; v(acc, u2, wr, wc, fr, fq); }
        else if (u.pn < 12) { Unit u2 = u; u2.pn -= 8; glu(acc, u2, wr, wc, fr, fq); }
        else { Unit u2 = u; u2.pn = 0; kw(acc, u2, wr, wc, fr, fq); }
    }
};
template <int LOGN> struct MoeOrderT {
    const PG8_LAS int* pre; const PG8_LAS int* cnt; const PG8_LAS unsigned char* t2e; const int* list; int G, c, Tcap, r0, r1;
    __device__ __forceinline__ bool next(int i, Unit& u) const {
        if (i + r0 >= r1) return false;
        const long L = (long)(i + r0) * G + c; const int ntiles = pre[32]; if (L >= ((long)ntiles << LOGN)) return false;
        const int t = (int)(L >> LOGN), n = (int)(L & ((1 << LOGN) - 1)); const int e = t2e[t];
        u.pm = t; u.pn = (e << LOGN) + n; return true;
    }
    __device__ __forceinline__ unsigned arow(const Unit& u, int r) const {
        const int e = u.pn >> LOGN, slot = (u.pm - pre[e]) * 256 + r; return (unsigned)list[(size_t)e * Tcap + (slot < cnt[e] ? slot : 0)];
    }
    __device__ __forceinline__ void a_ready(const Unit&) const {}
    __device__ __forceinline__ void done(const Unit&) const {}
};
typedef MoeOrderT<1> MoeOrder;
typedef __attribute__((address_space(1))) unsigned moe_gu32;
struct MoeOrder2 {
    const PG8_LAS int* pre; const PG8_LAS unsigned char* t2e; PG8_LAS unsigned* dflag; moe_gu32* ready; moe_gu32* tot; int gs, ge, j, gstr, wave, late; unsigned fullu, allu;
    __device__ __forceinline__ bool next(int i, Unit& u) const {
        const int L = gs + i * gstr + j; if (L >= ge) return false;
        const int t = L >> 2, n = L & 3, e = t2e[t]; u.pm = t; u.pn = (e << 2) + n; wait_tile(u, (unsigned)i); return true;
    }
    __device__ __forceinline__ unsigned arow(const Unit&, int) const { return 0u; }
    __device__ __forceinline__ void a_ready(const Unit&) const {}
    __device__ __forceinline__ void wait_tile(const Unit& u, unsigned i) const {
        const unsigned df = (unsigned)__builtin_amdgcn_readfirstlane((int)*dflag), st = df >> 16;
        const bool islate = u.pm >= late;
        if ((st == 0xFFFFu || (st == 0xFFFDu && !islate) || st == (unsigned)u.pm) && (df & 0xFFFFu) <= i) return;
        if (wave == 0) {
            unsigned polls = 0;
            if (islate) { while ((unsigned)__builtin_amdgcn_readfirstlane((int)__hip_atomic_load(ready + 64 * u.pm, __ATOMIC_RELAXED, __HIP_MEMORY_SCOPE_AGENT)) < 2u && ++polls < (1u << 21)) __builtin_amdgcn_s_sleep(2); }
            else { while ((unsigned)__builtin_amdgcn_readfirstlane((int)__hip_atomic_load(tot, __ATOMIC_RELAXED, __HIP_MEMORY_SCOPE_AGENT)) < fullu && ++polls < (1u << 21)) __builtin_amdgcn_s_sleep(2); }
            const unsigned tt = (unsigned)__builtin_amdgcn_readfirstlane((int)__hip_atomic_load(tot, __ATOMIC_RELAXED, __HIP_MEMORY_SCOPE_AGENT))
                              + (unsigned)__builtin_amdgcn_readfirstlane((int)__hip_atomic_load(tot + 64, __ATOMIC_RELAXED, __HIP_MEMORY_SCOPE_AGENT));
            __builtin_amdgcn_fence(__ATOMIC_ACQUIRE, "agent");
            asm volatile("s_waitcnt vmcnt(0)" ::: "memory");
            *dflag = ((tt >= allu ? 0xFFFFu : (islate ? (unsigned)u.pm : 0xFFFDu)) << 16) | (i + 1u);
            asm volatile("s_waitcnt lgkmcnt(0)" ::: "memory");
        }
        asm volatile("" ::: "memory"); __builtin_amdgcn_s_barrier(); asm volatile("" ::: "memory");
    }
    __device__ __forceinline__ void done(const Unit&) const {}
};
struct EpiMoeH {
    static constexpr bool PERM = true, AFTER_DRAIN = false;
    bf16_t* HS; const float* rowsq; const float* cE; float eps; MoeOrder S;
    __device__ __forceinline__ void operator()(const f32x4 (&acc)[2][2][4][2], const Unit& u, int wr, int wc, int fr_, int fq_) const {
        int fr = fr_, fq = fq_; asm volatile("" : "+v"(fr), "+v"(fq));
        const int e = u.pn >> 1, nt = u.pn & 1, slot0 = (u.pm - S.pre[e]) * 256, ne = S.cnt[e];
#pragma unroll
        for (int ai = 0; ai < 2; ++ai)
#pragma unroll
            for (int m = 0; m < 4; ++m) {
                const int r = ai * HALF + wr * 64 + m * 16 + fr, slot = slot0 + r; const bool live = slot < ne;
                const int tok = S.list[(size_t)e * S.Tcap + (live ? slot : 0)];
                const float rs = rowsq[(size_t)e * S.Tcap + (live ? slot : 0)], cw = live ? cE[(size_t)e * S.Tcap + slot] : 0.f;
                const f32x4 g0 = acc[ai][0][m][0] * rs, g1 = acc[ai][0][m][1] * rs, u0 = acc[ai][1][m][0] * (rs * cw), u1 = acc[ai][1][m][1] * (rs * cw);
                *(u32x4*)(HS + ((size_t)u.pm * 256 + r) * 256 + nt * HALF + wc * 32 + 8 * fq) = pack8(g0 * sigmoid4(g0) * u0, g1 * sigmoid4(g1) * u1);
            }
    }
};
struct EpiMoeY {
    static constexpr bool PERM = true, AFTER_DRAIN = false;
    bf16_t* YS;
    __device__ __forceinline__ void operator()(const f32x4 (&acc)[2][2][4][2], const Unit& u, int wr, int wc, int fr_, int fq_) const {
        int fr = fr_, fq = fq_; asm volatile("" : "+v"(fr), "+v"(fq));
        const int col0 = (u.pn & 3) * BM + wc * 32 + 8 * fq;
#pragma unroll
        for (int ai = 0; ai < 2; ++ai)
#pragma unroll
            for (int m = 0; m < 4; ++m) { bf16_t* op = YS + ((size_t)u.pm * 256 + ai * HALF + wr * 64 + m * 16 + fr) * 1024 + col0;
#pragma unroll
                for (int bj = 0; bj < 2; ++bj) *(u32x4*)(op + bj * HALF) = pack8(acc[ai][bj][m][0], acc[ai][bj][m][1]); }
    }
};
struct BatchOrder : StaticOrder {
    __device__ __forceinline__ bool next(int i, Unit& u) const { if (!StaticOrder::next(i, u)) return false; u.pn += (u.pm >> 4) * 4; return true; }
};
struct WkOrder { int G, c;
    __device__ __forceinline__ bool next(int i, Unit& u) const { const int L = i * G + c; if (L >= 128) return false; u.pm = L >> 2; u.pn = ((L >> 2) & 3) * 4 + (L & 3); return true; }
    __device__ __forceinline__ void a_ready(const Unit&) const {} __device__ __forceinline__ void done(const Unit&) const {} };
struct VwOrder { int G, c;
    __device__ __forceinline__ bool next(int i, Unit& u) const { const int L = i * G + c; if (L >= 128) return false; const int b = L >> 4, h = (L >> 2) & 3, mt = L & 3; u.pm = h * 4 + mt; u.pn = b * 4 + h; return true; }
    __device__ __forceinline__ void a_ready(const Unit&) const {} __device__ __forceinline__ void done(const Unit&) const {} };
struct EpiWk {
    static constexpr bool PERM = true, AFTER_DRAIN = false;
    bf16_t* O;
    __device__ __forceinline__ void operator()(const f32x4 (&acc)[2][2][4][2], const Unit& u, int wr, int wc, int fr, int fq) const {
        const int col0 = (u.pn & 3) * BM + wc * 32 + 8 * fq;
#pragma unroll
        for (int ai = 0; ai < 2; ++ai)
#pragma unroll
            for (int m = 0; m < 4; ++m) { bf16_t* op = O + ((size_t)u.pm * 256 + ai * HALF + wr * 64 + m * 16 + fr) * 1024 + col0;
#pragma unroll
                for (int bj = 0; bj < 2; ++bj) *(u32x4*)(op + bj * HALF) = pack8(acc[ai][bj][m][0], acc[ai][bj][m][1]); }
    }
};
struct EpiVw {
    static constexpr bool PERM = true, AFTER_DRAIN = false;
    bf16_t* O;
    __device__ __forceinline__ void operator()(const f32x4 (&acc)[2][2][4][2], const Unit& u, int wr, int wc, int fr, int fq) const {
        const int b = u.pn >> 2, h = u.pn & 3, mt = u.pm & 3, col0 = h * BM + wc * 32 + 8 * fq;
#pragma unroll
        for (int ai = 0; ai < 2; ++ai)
#pragma unroll
            for (int m = 0; m < 4; ++m) { bf16_t* op = O + ((size_t)b * 1024 + mt * 256 + ai * HALF + wr * 64 + m * 16 + fr) * 1024 + col0;
#pragma unroll
                for (int bj = 0; bj < 2; ++bj) *(u32x4*)(op + bj * HALF) = pack8(acc[ai][bj][m][0], acc[ai][bj][m][1]); }
    }
};
struct EpiSoftmax {
    static constexpr bool PERM = true, AFTER_DRAIN = false;
    bf16_t* P; const float* rowsq; float eps; PG8_LAS float* X;
    __device__ __forceinline__ void operator()(const f32x4 (&acc)[2][2][4][2], const Unit& u, int wr, int wc, int fr_, int fq_) const {
        int fr = fr_, fq = fq_; asm volatile("" : "+v"(fr), "+v"(fq));
#pragma unroll
        for (int ai = 0; ai < 2; ++ai)
#pragma unroll
            for (int m = 0; m < 4; ++m) { const int rl = ai * HALF + wr * 64 + m * 16 + fr; const float rs = __builtin_amdgcn_rsqf(rowsq[u.pm * BM + rl] * (1.0f / 1024.0f) + eps);
                float mx = -3.0e38f;
#pragma unroll
                for (int bj = 0; bj < 2; ++bj)
#pragma unroll
                    for (int n = 0; n < 2; ++n)
#pragma unroll
                        for (int j = 0; j < 4; ++j) mx = fmaxf(mx, acc[ai][bj][m][n][j] * rs);
                mx = fmaxf(mx, __shfl_xor(mx, 16)); mx = fmaxf(mx, __shfl_xor(mx, 32));
                float s = 0.f;
#pragma unroll
                for (int bj = 0; bj < 2; ++bj)
#pragma unroll
                    for (int n = 0; n < 2; ++n)
#pragma unroll
                        for (int j = 0; j < 4; ++j) s += __builtin_amdgcn_exp2f(acc[ai][bj][m][n][j] * rs - mx);
                s += __shfl_xor(s, 16); s += __shfl_xor(s, 32);
                if (fq == 0) { X[(rl * 4 + wc) * 2] = mx; X[(rl * 4 + wc) * 2 + 1] = s; } }
        asm volatile("s_waitcnt lgkmcnt(0)" ::: "memory"); __builtin_amdgcn_s_barrier(); asm volatile("" ::: "memory");
        const int col0 = (u.pn & 3) * BM + wc * 32 + 8 * fq;
#pragma unroll
        for (int ai = 0; ai < 2; ++ai)
#pragma unroll
            for (int m = 0; m < 4; ++m) { const int rl = ai * HALF + wr * 64 + m * 16 + fr; const float rs = __builtin_amdgcn_rsqf(rowsq[u.pm * BM + rl] * (1.0f / 1024.0f) + eps);
                const f32x4 xa = *(const PG8_LAS f32x4*)(X + rl * 8), xb = *(const PG8_LAS f32x4*)(X + rl * 8 + 4);
                const float M = fmaxf(fmaxf(xa[0], xa[2]), fmaxf(xb[0], xb[2]));
                const float S = xa[1] * __builtin_amdgcn_exp2f(xa[0] - M) + xa[3] * __builtin_amdgcn_exp2f(xa[2] - M) + xb[1] * __builtin_amdgcn_exp2f(xb[0] - M) + xb[3] * __builtin_amdgcn_exp2f(xb[2] - M);
                const float inv = __builtin_amdgcn_rcpf(S); bf16_t* op = P + (size_t)(u.pm * BM + rl) * 1024 + col0;
#pragma unroll
                for (int bj = 0; bj < 2; ++bj) { f32x4 p0, p1;
#pragma unroll
                    for (int j = 0; j < 4; ++j) { p0[j] = __builtin_amdgcn_exp2f(acc[ai][bj][m][0][j] * rs - M) * inv; p1[j] = __builtin_amdgcn_exp2f(acc[ai][bj][m][1][j] * rs - M) * inv; }
                    *(u32x4*)(op + bj * HALF) = pack8(p0, p1); } }
        asm volatile("s_waitcnt lgkmcnt(0)" ::: "memory"); __builtin_amdgcn_s_barrier(); asm volatile("" ::: "memory");
    }
};
template <class Epi, class Sched, bool ALIGN_EPI = false, bool SP2 = false, bool GATHER = false, bool I8 = false>
__device__ __forceinline__ void gemm_phase(PG8_LAS unsigned char* lds, const Gemm g, const Sched& S, const Epi& E, int wave_, const float* colscale = nullptr) {
    int lane; asm volatile("v_mbcnt_lo_u32_b32 %0, -1, 0\n\tv_mbcnt_hi_u32_b32 %0, -1, %0" : "=v"(lane));
    const int wid = __builtin_amdgcn_readfirstlane(wave_), tid = wid * 64 + lane, wr = wid >> 2, wc = wid & 3, fr = lane & 15, fq = lane >> 4;
    const int K = g.K, nt = K / BK;
    unsigned voffA[2], voffB[2];
#pragma unroll
    for (int i = 0; i < 2; ++i) { int R, C; stage_rc(tid * 16 + i * 8192, R, C); const int Rb = Epi::PERM ? ((R & ~31) + perm32(R & 31)) : R;
        voffA[i] = (unsigned)(R * K + C) * 2u; voffB[i] = (unsigned)(Rb * K + C) * 2u; }
    unsigned cvo[2][2];
    PG8_LAS unsigned* gsl = (PG8_LAS unsigned*)(lds + STAGE_BYTES + 1024) + tid * 4;
#define PG8_GOFF(dst, un) do { _Pragma("unroll") for (int _h = 0; _h < 2; ++_h) _Pragma("unroll") for (int _i = 0; _i < 2; ++_i) { int R_, C_; stage_rc(tid * 16 + _i * 8192, R_, C_); \
        dst[_h][_i] = (unsigned)(S.arow(un, 128 * _h + R_) * K + C_) * 2u; } } while (0)
#define PG8_STAGE_A(bufoff, base, h, nsel) do { if constexpr (GATHER) { PG8_STAGE(bufoff, base, cvo[h]); } else { PG8_STAGE(bufoff, (base) + (h) * hstep, voffA); } } while (0)
    const size_t kstep = (size_t)(BK * 2);
    const size_t hstep = (size_t)HALF * K * 2;
    const size_t tstep = 2 * hstep;
    const unsigned ldsw = (unsigned)wid * 1024u;
    const int aoff = lds_byte(wr * 64 + fr, fq * 8), boff = lds_byte(wc * 32 + fr, fq * 8);
#define PG8_SA(b, h) (((b) * 2 + (h)) * HTB)
#define PG8_SB(b, h) ((4 + (b) * 2 + (h)) * HTB)
#define PG8_STAGE(bufoff, gbase, voff) do { _Pragma("unroll") for (int _i = 0; _i < 2; ++_i) \
        __builtin_amdgcn_global_load_lds((const unsigned*)((const char*)(gbase) + (voff)[_i]), (PG8_LAS unsigned*)(lds + (bufoff) + ldsw + _i * 8192), 16, 0, 0); } while (0)
#define PG8_LDA(dst, b, h) do { _Pragma("unroll") for (int m = 0; m < 4; ++m) _Pragma("unroll") for (int k = 0; k < 2; ++k) dst[m][k] = *(const PG8_LAS bf16x8*)(lds + PG8_SA(b, h) + aoff + m * 2048 + k * 1024); } while (0)
#define PG8_LDB(dst, b, h) do { _Pragma("unroll") for (int n = 0; n < 2; ++n) _Pragma("unroll") for (int k = 0; k < 2; ++k) dst[n][k] = *(const PG8_LAS bf16x8*)(lds + PG8_SB(b, h) + boff + n * 2048 + k * 1024); } while (0)
#define PG8_MMA(ai, bj, At, Bt) do { __builtin_amdgcn_s_setprio(1); _Pragma("unroll") for (int m = 0; m < 4; ++m) _Pragma("unroll") for (int n = 0; n < 2; ++n) _Pragma("unroll") for (int k = 0; k < 2; ++k) { \
        if constexpr (I8) acc[ai][bj][m][n] = __builtin_bit_cast(f32x4, __builtin_amdgcn_mfma_i32_16x16x64_i8(__builtin_bit_cast(i32x4, Bt[n][k]), __builtin_bit_cast(i32x4, At[m][k]), __builtin_bit_cast(i32x4, acc[ai][bj][m][n]), 0, 0, 0)); \
        else acc[ai][bj][m][n] = __builtin_amdgcn_mfma_f32_16x16x32_bf16(Bt[n][k], At[m][k], acc[ai][bj][m][n], 0, 0, 0); } __builtin_amdgcn_s_setprio(0); } while (0)
#define PG8_WAIT_V(n) asm volatile("s_waitcnt vmcnt(" #n ")" ::: "memory")
#define PG8_WAIT_L(n) asm volatile("s_waitcnt lgkmcnt(" #n ")" ::: "memory")
#define PG8_BAR __builtin_amdgcn_s_barrier()
#define PG8_SCHED __builtin_amdgcn_sched_barrier(0)
    Unit cur, nxt; int ui = 0;
    if (!S.next(0, cur)) return;
    f32x4 acc[2][2][4][2];
#pragma unroll
    for (int a = 0; a < 2; ++a)
#pragma unroll
        for (int b = 0; b < 2; ++b)
#pragma unroll
            for (int m = 0; m < 4; ++m)
#pragma unroll
                for (int n = 0; n < 2; ++n) acc[a][b][m][n] = (f32x4){0.f, 0.f, 0.f, 0.f};
    bf16x8 At[4][2], B0[2][2], B1[2][2];
    const char* cA = (const char*)g.A + (GATHER ? (size_t)0 : (size_t)cur.pm * tstep); const char* cB = (const char*)g.Bt + (size_t)cur.pn * tstep;
    if constexpr (GATHER) { PG8_GOFF(cvo, cur); }
    S.a_ready(cur);
    if constexpr (SP2) {
        PG8_STAGE(PG8_SB(0, 0), cB, voffB); PG8_STAGE(PG8_SB(0, 1), cB + hstep, voffB); PG8_STAGE_A(PG8_SA(0, 0), cA, 0, false); PG8_STAGE_A(PG8_SA(0, 1), cA, 1, false);
        if (wr == 1) PG8_BAR;
        PG8_WAIT_V(2); PG8_BAR;
        PG8_STAGE(PG8_SB(1, 0), cB + kstep, voffB); PG8_STAGE_A(PG8_SA(1, 0), cA + kstep, 0, false); PG8_STAGE(PG8_SB(1, 1), cB + hstep + kstep, voffB);
        PG8_WAIT_V(6); PG8_BAR;
    } else {
        PG8_STAGE(PG8_SB(0, 0), cB, voffB); PG8_STAGE(PG8_SA(0, 0), cA, voffA); PG8_STAGE(PG8_SB(0, 1), cB + hstep, voffB); PG8_STAGE(PG8_SA(0, 1), cA + hstep, voffA);
        if (wr == 1) PG8_BAR;
        PG8_WAIT_V(4); PG8_BAR;
        PG8_STAGE(PG8_SB(1, 0), cB + kstep, voffB); PG8_STAGE(PG8_SA(1, 0), cA + kstep, voffA); PG8_STAGE(PG8_SB(1, 1), cB + hstep + kstep, voffB);
        PG8_WAIT_V(6); PG8_BAR;
    }
    for (;;) {
        const bool has_next = S.next(ui + 1, nxt);
        if constexpr (GATHER) { unsigned nvo_[2][2]; if (has_next) { PG8_GOFF(nvo_, nxt); } else { _Pragma("unroll") for (int _h = 0; _h < 2; ++_h) _Pragma("unroll") for (int _i = 0; _i < 2; ++_i) nvo_[_h][_i] = cvo[_h][_i]; }
            *(PG8_LAS u32x4*)gsl = (u32x4){nvo_[0][0], nvo_[0][1], nvo_[1][0], nvo_[1][1]}; }
        const char* nA = GATHER ? cA : (has_next ? (const char*)g.A + (size_t)nxt.pm * tstep : cA); const char* nB = has_next ? (const char*)g.Bt + (size_t)nxt.pn * tstep : cB;
        for (int t = 0; t < nt; t += 2) {
            const bool last = (t == nt - 2);
            const char* a1 = cA + (size_t)(t + 1) * kstep;
            const char* a2 = last ? nA : cA + (size_t)(t + 2) * kstep; const char* b2 = last ? nB : cB + (size_t)(t + 2) * kstep;
            const char* a3 = a2 + kstep; const char* b3 = b2 + kstep;
            if (last && has_next) S.a_ready(nxt);
            if constexpr (SP2) {
            PG8_LDB(B0, 0, 0); PG8_LDB(B1, 0, 1); PG8_SCHED; PG8_LDA(At, 0, 0); PG8_STAGE_A(PG8_SA(1, 1), a1, 1, false);
            if constexpr (GATHER) { if (last) { const u32x4 nv_ = *(const PG8_LAS u32x4*)gsl; cvo[0][0] = nv_.x; cvo[0][1] = nv_.y; cvo[1][0] = nv_.z; cvo[1][1] = nv_.w; } }
            PG8_WAIT_V(8); PG8_WAIT_L(0); PG8_BAR; PG8_MMA(0, 0, At, B0); PG8_MMA(0, 1, At, B1); PG8_BAR; PG8_SCHED;
            PG8_LDA(At, 0, 1); PG8_STAGE(PG8_SB(0, 0), b2, voffB); PG8_STAGE(PG8_SB(0, 1), b2 + hstep, voffB); PG8_STAGE_A(PG8_SA(0, 0), a2, 0, last);
            PG8_WAIT_V(8); PG8_WAIT_L(0); PG8_BAR; PG8_MMA(1, 0, At, B0); PG8_MMA(1, 1, At, B1); PG8_BAR; PG8_SCHED;
            PG8_LDB(B0, 1, 0); PG8_LDB(B1, 1, 1); PG8_SCHED; PG8_LDA(At, 1, 0); PG8_STAGE_A(PG8_SA(0, 1), a2, 1, last);
            PG8_WAIT_V(8); PG8_WAIT_L(0); PG8_BAR; PG8_MMA(0, 0, At, B0); PG8_MMA(0, 1, At, B1); PG8_BAR; PG8_SCHED;
            PG8_LDA(At, 1, 1); PG8_STAGE(PG8_SB(1, 0), b3, voffB); PG8_STAGE(PG8_SB(1, 1), b3 + hstep, voffB); PG8_STAGE_A(PG8_SA(1, 0), a3, 0, last);
            PG8_WAIT_V(8); PG8_WAIT_L(0); PG8_BAR; PG8_MMA(1, 0, At, B0); PG8_MMA(1, 1, At, B1); PG8_BAR; PG8_SCHED;
            } else {
            PG8_LDB(B0, 0, 0); PG8_SCHED; PG8_LDA(At, 0, 0); PG8_STAGE(PG8_SA(1, 1), a1 + hstep, voffA);
            PG8_WAIT_L(8); PG8_BAR; PG8_WAIT_L(0); PG8_MMA(0, 0, At, B0); PG8_BAR; PG8_SCHED;
            PG8_LDB(B1, 0, 1); PG8_STAGE(PG8_SB(0, 0), b2, voffB);
            PG8_BAR; PG8_WAIT_L(0); PG8_MMA(0, 1, At, B1); PG8_BAR;
            PG8_LDA(At, 0, 1); PG8_STAGE(PG8_SA(0, 0), a2, voffA);
            PG8_BAR; PG8_WAIT_L(0); PG8_MMA(1, 0, At, B0); PG8_BAR; PG8_SCHED;
            PG8_STAGE(PG8_SB(0, 1), b2 + hstep, voffB);
            PG8_WAIT_V(6); PG8_BAR; PG8_MMA(1, 1, At, B1); PG8_BAR;
            PG8_LDB(B0, 1, 0); PG8_SCHED; PG8_LDA(At, 1, 0); PG8_STAGE(PG8_SA(0, 1), a2 + hstep, voffA);
            PG8_WAIT_L(8); PG8_BAR; PG8_WAIT_L(0); PG8_MMA(0, 0, At, B0); PG8_BAR; PG8_SCHED;
            PG8_LDB(B1, 1, 1); PG8_STAGE(PG8_SB(1, 0), b3, voffB);
            PG8_BAR; PG8_WAIT_L(0); PG8_MMA(0, 1, At, B1); PG8_BAR;
            PG8_LDA(At, 1, 1); PG8_STAGE(PG8_SA(1, 0), a3, voffA);
            PG8_BAR; PG8_WAIT_L(0); PG8_MMA(1, 0, At, B0); PG8_BAR; PG8_SCHED;
            PG8_STAGE(PG8_SB(1, 1), b3 + hstep, voffB);
            PG8_WAIT_V(6); PG8_BAR; PG8_MMA(1, 1, At, B1); PG8_BAR;
            }
        }
        if constexpr (ALIGN_EPI) { if (wr == 0) PG8_BAR; }
        if constexpr (I8) { int l8_; asm volatile("v_mbcnt_lo_u32_b32 %0, -1, 0\n\tv_mbcnt_hi_u32_b32 %0, -1, %0" : "=v"(l8_));
            _Pragma("unroll") for (int bj = 0; bj < 2; ++bj) _Pragma("unroll") for (int n = 0; n < 2; ++n) { const f32x4 cs_ = *(const f32x4*)(colscale + (size_t)cur.pn * BM + bj * HALF + wc * 32 + 8 * (l8_ >> 4) + 4 * n);
                _Pragma("unroll") for (int ai = 0; ai < 2; ++ai) _Pragma("unroll") for (int m = 0; m < 4; ++m) { const i32x4 iv_ = __builtin_bit_cast(i32x4, acc[ai][bj][m][n]);
                    acc[ai][bj][m][n] = (f32x4){(float)iv_.x * cs_.x, (float)iv_.y * cs_.y, (float)iv_.z * cs_.z, (float)iv_.w * cs_.w}; } } }
        if constexpr (!Epi::AFTER_DRAIN) { int ln_; asm volatile("v_mbcnt_lo_u32_b32 %0, -1, 0\n\tv_mbcnt_hi_u32_b32 %0, -1, %0" : "=v"(ln_)); E(acc, cur, wr, wc, ln_ & 15, ln_ >> 4); S.done(cur); }
        if (!has_next) break;
#pragma unroll
        for (int a = 0; a < 2; ++a)
#pragma unroll
            for (int b = 0; b < 2; ++b)
#pragma unroll
                for (int m = 0; m < 4; ++m)
#pragma unroll
                    for (int n = 0; n < 2; ++n) acc[a][b][m][n] = (f32x4){0.f, 0.f, 0.f, 0.f};
        cur = nxt; cA = nA; cB = nB; ++ui;

        if constexpr (ALIGN_EPI) { if (wr == 1) PG8_BAR; }
    }
    PG8_WAIT_V(0);
    if constexpr (!ALIGN_EPI) { if (wr == 0) PG8_BAR; }
    PG8_BAR;
    if constexpr (Epi::AFTER_DRAIN) { E.fused(acc, cur, wr, wc, fr, fq, lds, wid, lane); S.done(cur); }
#undef PG8_SA
#undef PG8_SB
#undef PG8_STAGE
#undef PG8_STAGE_A
#undef PG8_GOFF
#undef PG8_LDA
#undef PG8_LDB
#undef PG8_MMA
#undef PG8_WAIT_V
#undef PG8_WAIT_L
#undef PG8_BAR
#undef PG8_SCHED
}
}
#ifndef PG8_SP2
#define PG8_SP2 true
#endif
#ifndef PG8_ALIGN
#define PG8_ALIGN true
#endif
template <int BIT> __device__ __forceinline__ unsigned mbfe(unsigned mw) { unsigned m; asm("v_bfe_i32 %0, %1, %2, 1" : "=v"(m) : "v"(mw), "n"(BIT)); return m; }
namespace attn_body {
using bf16=__hip_bfloat16;
using bf16x8=__attribute__((ext_vector_type(8)))short;
using s16x4=__attribute__((ext_vector_type(4)))short;
using f32x16=__attribute__((ext_vector_type(16)))float;
using u32x4=__attribute__((ext_vector_type(4)))unsigned;
constexpr int BATCH=8,NHEAD=8,SEQ=4096,D=64,DM=NHEAD*D;
constexpr int NW=8,QBLK=32,QB=QBLK*NW,KVBLK=64,NQB=SEQ/QB;
constexpr int ATTN_PITCH=DM, ATTN_UNIT_ROWS=QB;
__device__ __forceinline__ int crow(int r,int hi){return (r&3)+8*(r>>2)+4*hi;}
#define SBAR() __builtin_amdgcn_sched_barrier(0)
__device__ __forceinline__ void cmask(f32x16&p0,f32x16&p1,int jb,int qrel,int hi){
  const float NEG=-INFINITY; int kb=64*jb+4*hi;
  #pragma unroll
  for(int r=0;r<16;++r){int kv=kb+(r&3)+8*(r>>2); if(kv>qrel)p0[r]=NEG; if(kv+32>qrel)p1[r]=NEG;}
}

constexpr int NSLOT=3, SLOTB=8192;
constexpr int LDS_K=0, LDS_V=NSLOT*SLOTB, LDS_WS=2*NSLOT*SLOTB, LDS_OST=LDS_WS+NW*64*4, LDS_BYTES=LDS_OST+NW*4096;
constexpr float C2=0.125f*1.4426950408889634f;
__device__ __forceinline__ void glds16(const void*gsrc,unsigned lds_dst){unsigned keep;
  asm volatile("s_mov_b32 %0, m0\n\ts_mov_b32 m0, %2\n\ts_nop 0\n\tglobal_load_lds_dwordx4 %1, off\n\ts_mov_b32 m0, %0":"=&s"(keep):"v"(gsrc),"s"(lds_dst):"memory");}
__device__ __forceinline__ float max3f(float a,float b,float c){float r;asm("v_max3_f32 %0, %1, %2, %3":"=v"(r):"v"(a),"v"(b),"v"(c));return r;}
__device__ __forceinline__ float max2f(float a,float b){float r;asm("v_max_f32_e32 %0, %1, %2":"=v"(r):"v"(a),"v"(b));return r;}
__device__ __forceinline__ float fadd_s(float a,float b){float r;asm("v_add_f32_e32 %0, %1, %2":"=v"(r):"v"(a),"v"(b));return r;}
__device__ __forceinline__ float fsub_s(float a,float b){float r;asm("v_sub_f32_e32 %0, %1, %2":"=v"(r):"v"(a),"v"(b));return r;}
typedef float f32x2_t __attribute__((ext_vector_type(2))); typedef __bf16 bf16x2_t __attribute__((ext_vector_type(2)));
__device__ __forceinline__ unsigned cvtpk_s(float lo,float hi){f32x2_t v={lo,hi};bf16x2_t b=__builtin_convertvector(v,bf16x2_t);return __builtin_bit_cast(unsigned,b);}
#define WAIT_BAR(N) asm volatile("s_waitcnt vmcnt(" #N ") lgkmcnt(0)\n\ts_barrier":::"memory")

__device__ __forceinline__ void qkt(f32x16&p0,f32x16&p1,const char*Kslot,const bf16x8*qr,const f32x16&negm,int r32,int hi){
  const char*kb=Kslot+hi*1024+r32*16;
  #pragma unroll
  for(int d0=0;d0<4;++d0){
    const bf16x8 b0=*reinterpret_cast<const bf16x8*>(kb+d0*2048);
    const bf16x8 b1=*reinterpret_cast<const bf16x8*>(kb+d0*2048+512);
    if(d0==0){p0=__builtin_amdgcn_mfma_f32_32x32x16_bf16(b0,qr[0],negm,0,0,0);p1=__builtin_amdgcn_mfma_f32_32x32x16_bf16(b1,qr[0],negm,0,0,0);}
    else{p0=__builtin_amdgcn_mfma_f32_32x32x16_bf16(b0,qr[d0],p0,0,0,0);p1=__builtin_amdgcn_mfma_f32_32x32x16_bf16(b1,qr[d0],p1,0,0,0);}}
}
typedef __attribute__((address_space(3))) const char* lds_cptr;
typedef short v4i16_t __attribute__((ext_vector_type(4)));
__device__ __forceinline__ void kload8(bf16x8*kf,lds_cptr kp){
  kf[0]=*(const __attribute__((address_space(3))) bf16x8*)(kp);      kf[1]=*(const __attribute__((address_space(3))) bf16x8*)(kp+512);
  kf[2]=*(const __attribute__((address_space(3))) bf16x8*)(kp+2048); kf[3]=*(const __attribute__((address_space(3))) bf16x8*)(kp+2560);
  kf[4]=*(const __attribute__((address_space(3))) bf16x8*)(kp+4096); kf[5]=*(const __attribute__((address_space(3))) bf16x8*)(kp+4608);
  kf[6]=*(const __attribute__((address_space(3))) bf16x8*)(kp+6144); kf[7]=*(const __attribute__((address_space(3))) bf16x8*)(kp+6656);
}
__device__ __forceinline__ void kload2(bf16x8*kf,lds_cptr kp,int j){ kf[2*j]=*(const __attribute__((address_space(3))) bf16x8*)(kp+j*2048); kf[2*j+1]=*(const __attribute__((address_space(3))) bf16x8*)(kp+j*2048+512); }
__device__ __forceinline__ s16x4 vtr(lds_cptr p){ return __builtin_bit_cast(s16x4,__builtin_amdgcn_ds_read_tr16_b64_v4i16((__attribute__((address_space(3))) v4i16_t*)p)); }
__device__ __forceinline__ float rowmax(const f32x16&p0,const f32x16&p1){
  float a=max3f(p0[0],p0[1],p1[0]),b=max3f(p0[2],p0[3],p1[1]);a=max3f(a,p1[2],p1[3]);
  #pragma unroll
  for(int r=4;r<16;r+=4){a=max3f(a,p0[r],p0[r+1]);b=max3f(b,p0[r+2],p0[r+3]);a=max3f(a,p1[r],p1[r+1]);b=max3f(b,p1[r+2],p1[r+3]);}
  const float m=max2f(a,b);
  auto rr=__builtin_amdgcn_permlane32_swap(__float_as_uint(m),__float_as_uint(m),false,false);
  return max2f(__uint_as_float(rr[0]),__uint_as_float(rr[1]));
}
__device__ __forceinline__ void pv(f32x16*o,int vb,bf16x8 pa0,bf16x8 pa1,bf16x8 pa2,bf16x8 pa3){
  #pragma unroll
  for(int d0=0;d0<2;++d0){s16x4 lo[4],hi[4];
    #pragma unroll
    for(int ks=0;ks<4;++ks){
      asm volatile("ds_read_b64_tr_b16 %0,%1 offset:%c2":"=&v"(lo[ks]):"v"(vb),"i"(d0*4096+ks*1024):"memory");
      asm volatile("ds_read_b64_tr_b16 %0,%1 offset:%c2":"=&v"(hi[ks]):"v"(vb),"i"(d0*4096+ks*1024+512):"memory");}
    asm volatile("s_waitcnt lgkmcnt(0)":::"memory");SBAR();
    #define PK(k) (bf16x8){lo[k][0],lo[k][1],lo[k][2],lo[k][3],hi[k][0],hi[k][1],hi[k][2],hi[k][3]}
    o[d0]=__builtin_amdgcn_mfma_f32_32x32x16_bf16(pa0,PK(0),o[d0],0,0,0);
    o[d0]=__builtin_amdgcn_mfma_f32_32x32x16_bf16(pa1,PK(1),o[d0],0,0,0);
    o[d0]=__builtin_amdgcn_mfma_f32_32x32x16_bf16(pa2,PK(2),o[d0],0,0,0);
    o[d0]=__builtin_amdgcn_mfma_f32_32x32x16_bf16(pa3,PK(3),o[d0],0,0,0);
    #undef PK
  }
}

#ifndef ATTN_STORE16
#define ATTN_STORE16(p,v) do{ if(!dry) *(u32x4*)(p)=(v); }while(0)
#endif
template<int THRL> __device__ __forceinline__ void attn_unit(int b,int h,int qb,const bf16*Q,const bf16*__restrict__ K,const bf16*__restrict__ V,bf16*O,const uint2*MaskBase,char*shm,bool dry,int wave_){
  int lane; asm volatile("v_mbcnt_lo_u32_b32 %0, -1, 0\n\tv_mbcnt_hi_u32_b32 %0, -1, %0" : "=v"(lane)); const int wid=__builtin_amdgcn_readfirstlane(wave_),tid=wid*64+lane,r32=lane&31,hi=lane>>5;
  const long rowbase=(long)b*SEQ; const int q0=qb*QB;
  const bf16*Qw=Q+(rowbase+q0+wid*QBLK)*DM+h*D;
  const bf16*Kh=K+rowbase*DM+h*D,*Vh=V+rowbase*DM+h*D;
  const unsigned lds0=(unsigned)(uintptr_t)shm;
  float*wsf=(float*)(shm+LDS_WS)+wid*64;
  const bf16*ksrc=Kh+(long)lane*DM+wid*8;
  const bf16*vsrc=Vh+(long)(16*(wid&3)+(lane>>2))*DM+(wid>>2)*32+(lane&3)*8;
  const unsigned kdst=lds0+LDS_K+wid*1024, vdst=lds0+LDS_V+wid*1024;
  #define DMA_K(t,slot) glds16(ksrc+(long)(t)*KVBLK*DM,(unsigned)__builtin_amdgcn_readfirstlane(kdst+(slot)))
  #define DMA_V(t,slot) glds16(vsrc+(long)(t)*KVBLK*DM,(unsigned)__builtin_amdgcn_readfirstlane(vdst+(slot)))
  const int vb0=(int)(lds0+LDS_V)+((lane>>4)&1)*32+(lane&3)*8+(4*hi+((lane&15)>>2))*64;
  const char*Kbase=shm+LDS_K; bf16x8 kf[8];
  const lds_cptr shm3=(lds_cptr)shm; const lds_cptr kp0=shm3+LDS_K+hi*1024+r32*16; const lds_cptr vp0=shm3+LDS_V+((lane>>4)&1)*32+(lane&3)*8+(4*hi+((lane&15)>>2))*64;
  const int NT=(q0+QB)/KVBLK;
  DMA_K(0,0);DMA_V(0,0);DMA_K(1,SLOTB);
  bf16x8 qr[4];
  #pragma unroll
  for(int d0=0;d0<4;++d0)qr[d0]=*reinterpret_cast<const bf16x8*>(&Qw[(long)r32*DM+d0*16+hi*8]);
  float mhat=0.f,l_reg=0.f;f32x16 o[2];o[0]=f32x16{};o[1]=f32x16{};f32x16 negm=f32x16{};asm volatile("":"+v"(negm));
  const int qrel=wid*QBLK+r32;
  const uint2*mrow=MaskBase+((size_t)(rowbase+q0+qrel))*64;
  const int sh4=4*hi; uint2 mraw=mrow[0]; unsigned mw0=mraw.x>>sh4, mw1=mraw.y>>sh4; mraw=mrow[1]; unsigned mwc0=mraw.x>>sh4, mwc1=mraw.y>>sh4, mwn0=mwc0, mwn1=mwc1;
  #define MSKB(v,mw,bit) __uint_as_float(__float_as_uint(v)&mbfe<(bit)>(mw))
  #define MSKV(v,mw,bit) __uint_as_float(__float_as_uint(v)&(unsigned)(((int)((mw)<<(31-(bit))))>>31))
  #define MBIT(r) (((r)&3)+8*((r)>>2))
  #define MCONV() do{ asm volatile("" : "+v"(mraw)); mwc0=mraw.x>>sh4; mwc1=mraw.y>>sh4; }while(0)
  #define CMASK(P0,P1,t) do{}while(0)
  bool resc=false;
  #define START(P0,P1) do{ const float rm=rowmax(P0,P1); resc=false; \
    { const float dl=rm; mhat=fadd_s(mhat,dl); \
      _Pragma("unroll") for(int r=0;r<16;++r){P0[r]=fsub_s(P0[r],dl);P1[r]=fsub_s(P1[r],dl);} \
      _Pragma("unroll") for(int r=0;r<16;++r)negm[r]=-mhat; asm volatile("":"+v"(negm)); } \
    _Pragma("unroll") for(int r=0;r<16;++r)P0[r]=MSKV(__builtin_amdgcn_exp2f(P0[r]),mw0,MBIT(r)); }while(0)
  #define RESC() do{ if(resc){ asm volatile("s_waitcnt lgkmcnt(0)":::"memory"); \
      _Pragma("unroll") for(int d_=0;d_<2;++d_) _Pragma("unroll") for(int r=0;r<16;++r)o[d_][r]*=wsf[crow(r,hi)]; } }while(0)
  f32x16 pA0,pA1,pB0,pB1;
  int sl_prev=0,sl_cur=0,sl_next=SLOTB;
  #define ROT() do{sl_prev=sl_cur;sl_cur=sl_next;sl_next=(sl_next==(NSLOT-1)*SLOTB)?0:sl_next+SLOTB;}while(0)
  DMA_K(2,2*SLOTB);
  WAIT_BAR(3);
  qkt(pA0,pA1,Kbase,qr,negm,r32,hi);asm volatile("s_nop 15\n\ts_nop 7":"+v"(pA0),"+v"(pA1));CMASK(pA0,pA1,0);
  START(pA0,pA1);
  _Pragma("unroll") for(int r=0;r<16;++r)pA1[r]=MSKV(__builtin_amdgcn_exp2f(pA1[r]),mw1,MBIT(r));
  WAIT_BAR(0);
  DMA_K(3,0);DMA_V(1,SLOTB);
  ROT();
  kload8(kf,kp0+sl_cur);
  WAIT_BAR(2);
  s16x4 vlo[8],vhi[8]; u32x4 pw0,pw1,pw2,pw3;
  #define PKW(P,B) cvtpk_s(P[B],P[B+1])
  #define PAF(k) __builtin_bit_cast(bf16x8,pw##k)
  #define VFR(i) (bf16x8){vlo[i][0],vlo[i][1],vlo[i][2],vlo[i][3],vhi[i][0],vhi[i][1],vhi[i][2],vhi[i][3]}
  #define PIN(x) asm volatile("":"+v"(x))
  #define MX3(a,b,c) __builtin_fmaxf(__builtin_fmaxf((a),(b)),(c))
  #define GAPA(MF,A0,A1,A2,A3,W0,W1,PW) do{ MF; sacc+=A0; sacc+=A1; sacc+=A2; sacc+=A3; PIN(sacc); W0; W1; PIN(PW); SBAR(); }while(0)
  #define EX(v) __builtin_amdgcn_exp2f(v)
  #define GAPB(MF,X,B,MW) do{ MF; X[B]=MSKB(EX(X[B]),MW,2*(B)); X[B+1]=MSKB(EX(X[B+1]),MW,2*(B)+1); X[B+2]=MSKB(EX(X[B+2]),MW,2*(B)+2); X[B+3]=MSKB(EX(X[B+3]),MW,2*(B)+3); PIN(X); SBAR(); }while(0)
  #define VRD(i) do{ vlo[i]=vtr(vp_+(((i)>>2)*4096+((i)&3)*1024)); vhi[i]=vtr(vp_+(((i)>>2)*4096+((i)&3)*1024+512)); }while(0)
  #define KRD(G,j) do{ if(G){ kload2(kf,kp0+sl_next,j); SBAR(); } }while(0)
  #define STEP(C0,C1,P0,P1,t,GK,GV,GL,ML) do{ SBAR(); if(ML){ asm volatile("global_load_dwordx2 %0, %1, off" : "=v"(mraw) : "v"(mrow+(t)+1) : "memory"); } \
    const lds_cptr vp_=vp0+sl_prev; \
    VRD(0); SBAR(); float sacc=(P0[0]+P0[1]); \
    GAPA(C0=__builtin_amdgcn_mfma_f32_32x32x16_bf16(kf[0],qr[0],negm,0,0,0), P0[2],P0[3],P0[4],P0[5],     pw0[0]=PKW(P0,0), pw0[1]=PKW(P0,2), pw0); \
    VRD(4); SBAR(); GAPA(C1=__builtin_amdgcn_mfma_f32_32x32x16_bf16(kf[1],qr[0],negm,0,0,0), P0[6],P0[7],P0[8],P0[9],     pw0[2]=PKW(P0,4), pw0[3]=PKW(P0,6), pw0); \
    VRD(1); SBAR(); GAPA(C0=__builtin_amdgcn_mfma_f32_32x32x16_bf16(kf[2],qr[1],C0,0,0,0),   P0[10],P0[11],P0[12],P0[13], pw1[0]=PKW(P0,8), pw1[1]=PKW(P0,10), pw1); \
    VRD(5); SBAR(); GAPA(C1=__builtin_amdgcn_mfma_f32_32x32x16_bf16(kf[3],qr[1],C1,0,0,0),   P0[14],P0[15],P1[0],P1[1],   pw1[2]=PKW(P0,12),pw1[3]=PKW(P0,14), pw1); \
    VRD(2); SBAR(); GAPA(C0=__builtin_amdgcn_mfma_f32_32x32x16_bf16(kf[4],qr[2],C0,0,0,0),   P1[2],P1[3],P1[4],P1[5],     pw2[0]=PKW(P1,0), pw2[1]=PKW(P1,2), pw2); \
    VRD(6); SBAR(); GAPA(C1=__builtin_amdgcn_mfma_f32_32x32x16_bf16(kf[5],qr[2],C1,0,0,0),   P1[6],P1[7],P1[8],P1[9],     pw2[2]=PKW(P1,4), pw2[3]=PKW(P1,6), pw2); \
    VRD(3); SBAR(); GAPA(C0=__builtin_amdgcn_mfma_f32_32x32x16_bf16(kf[6],qr[3],C0,0,0,0),   P1[10],P1[11],P1[12],P1[13], pw3[0]=PKW(P1,8), pw3[1]=PKW(P1,10), pw3); \
    VRD(7); SBAR(); GAPA(C1=__builtin_amdgcn_mfma_f32_32x32x16_bf16(kf[7],qr[3],C1,0,0,0),   P1[14],P1[15],0.f,0.f,       pw3[2]=PKW(P1,12),pw3[3]=PKW(P1,14), pw3); \
    l_reg+=sacc; \
    if(GK){DMA_K((t)+3,sl_cur);} if(GV){DMA_V((t)+1,sl_next);} \
    CMASK(C0,C1,t); \
    { float a=MX3(C0[0],C0[1],C1[0]),b=MX3(C0[2],C0[3],C1[1]); a=MX3(a,C1[2],C1[3]); \
      _Pragma("unroll") for(int r=4;r<16;r+=4){a=MX3(a,C0[r],C0[r+1]);b=MX3(b,C0[r+2],C0[r+3]);a=MX3(a,C1[r],C1[r+1]);b=MX3(b,C1[r+2],C1[r+3]);} \
      float rm=__builtin_fmaxf(a,b); { auto rr=__builtin_amdgcn_permlane32_swap(__float_as_uint(rm),__float_as_uint(rm),false,false); rm=__builtin_fmaxf(__uint_as_float(rr[0]),__uint_as_float(rr[1])); } \
      resc=false; \
      if(__builtin_expect(__any(rm>(float)THRL),0)){ const float dl=__builtin_fmaxf(rm,0.f); mhat+=dl; \
        _Pragma("unroll") for(int r=0;r<16;++r){C0[r]-=dl;C1[r]-=dl;} \
        _Pragma("unroll") for(int r=0;r<16;++r)negm[r]=-mhat; asm volatile("":"+v"(negm)); \
        const float f=__builtin_amdgcn_exp2f(-dl); l_reg*=f; if(hi==0)wsf[r32]=f; resc=true; } } \
    SBAR(); \
    GAPB(o[0]=__builtin_amdgcn_mfma_f32_32x32x16_bf16(PAF(0),VFR(0),o[0],0,0,0), C0,0,mwc0); \
    GAPB(o[1]=__builtin_amdgcn_mfma_f32_32x32x16_bf16(PAF(0),VFR(4),o[1],0,0,0), C0,4,mwc0); \
    KRD(GL,0); GAPB(o[0]=__builtin_amdgcn_mfma_f32_32x32x16_bf16(PAF(1),VFR(1),o[0],0,0,0), C0,8,mwc0); \
    KRD(GL,1); GAPB(o[1]=__builtin_amdgcn_mfma_f32_32x32x16_bf16(PAF(1),VFR(5),o[1],0,0,0), C0,12,mwc0); \
    KRD(GL,2); GAPB(o[0]=__builtin_amdgcn_mfma_f32_32x32x16_bf16(PAF(2),VFR(2),o[0],0,0,0), C1,0,mwc1); \
    KRD(GL,3); GAPB(o[1]=__builtin_amdgcn_mfma_f32_32x32x16_bf16(PAF(2),VFR(6),o[1],0,0,0), C1,4,mwc1); \
    GAPB(o[0]=__builtin_amdgcn_mfma_f32_32x32x16_bf16(PAF(3),VFR(3),o[0],0,0,0), C1,8,mwc1); \
    GAPB(o[1]=__builtin_amdgcn_mfma_f32_32x32x16_bf16(PAF(3),VFR(7),o[1],0,0,0), C1,12,mwc1); \
    }while(0)
  int t=1;
  #undef CMASK
  #define CMASK(P0,P1,t) do{}while(0)
  for(;t+5<NT;t+=2){
    STEP(pB0,pB1,pA0,pA1,t,true,true,true,true);     WAIT_BAR(2); MCONV(); RESC(); ROT();
    STEP(pA0,pA1,pB0,pB1,t+1,true,true,true,true);   WAIT_BAR(2); MCONV(); RESC(); ROT();
  }
  #undef CMASK
  #define CMASK(P0,P1,t) do{}while(0)
  #define ENDW(tt) do{ if((tt)+3<NT){WAIT_BAR(2);} else if((tt)+2<NT){WAIT_BAR(1);} else {WAIT_BAR(0);} }while(0)
  for(;t+1<NT;t+=2){
    STEP(pB0,pB1,pA0,pA1,t,(t+3<NT),(t+1<NT),(t+1<NT),(t+1<NT));       ENDW(t); if(t+1<NT){MCONV();}   RESC(); ROT();
    STEP(pA0,pA1,pB0,pB1,t+1,(t+4<NT),(t+2<NT),(t+2<NT),(t+2<NT));     ENDW(t+1); if(t+2<NT){MCONV();} RESC(); ROT();
  }
  STEP(pB0,pB1,pA0,pA1,NT-1,false,false,false,false); RESC();
  { float sacc=pB0[0]+pB0[1]; _Pragma("unroll") for(int r=2;r<16;++r)sacc+=pB0[r]; _Pragma("unroll") for(int r=0;r<16;++r)sacc+=pB1[r]; l_reg+=sacc;
    pw0=(u32x4){PKW(pB0,0),PKW(pB0,2),PKW(pB0,4),PKW(pB0,6)};pw1=(u32x4){PKW(pB0,8),PKW(pB0,10),PKW(pB0,12),PKW(pB0,14)};pw2=(u32x4){PKW(pB1,0),PKW(pB1,2),PKW(pB1,4),PKW(pB1,6)};pw3=(u32x4){PKW(pB1,8),PKW(pB1,10),PKW(pB1,12),PKW(pB1,14)};
    SBAR(); pv(o,vb0+sl_cur,PAF(0),PAF(1),PAF(2),PAF(3)); }
  #undef PKW
  #undef PAF
  #undef VFR
  #undef PIN
  #undef MX3
  #undef GAPA
  #undef GAPB
  #undef EX
  #undef VRD
  #undef KRD
  #undef STEP
  #undef ENDW
  {auto rr=__builtin_amdgcn_permlane32_swap(__float_as_uint(l_reg),__float_as_uint(l_reg),false,false);l_reg=__uint_as_float(rr[0])+__uint_as_float(rr[1]);}
  if(hi==0)wsf[32+r32]=l_reg;asm volatile("s_waitcnt lgkmcnt(0)":::"memory");
  float rli[16];
  #pragma unroll
  for(int r=0;r<16;++r)rli[r]=__builtin_amdgcn_rcpf(wsf[32+crow(r,hi)]);
  bf16*Ow=O+(rowbase+q0+wid*QBLK)*DM+h*D;
  { bf16*stg=(bf16*)(shm+LDS_OST)+wid*2048;
    #pragma unroll
    for(int r=0;r<16;++r){const int orow=crow(r,hi);
      #pragma unroll
      for(int d0=0;d0<2;++d0)stg[orow*64+d0*32+r32]=__float2bfloat16(o[d0][r]*rli[r]);}
    asm volatile("s_waitcnt lgkmcnt(0)":::"memory");
    #pragma unroll
    for(int i=0;i<4;++i){const int row=i*8+(lane>>3),ch=lane&7; const u32x4 v=*(const u32x4*)(stg+row*64+ch*8); ATTN_STORE16(Ow+(long)row*DM+ch*8,v);} }
  asm volatile("s_waitcnt lgkmcnt(0)\n\ts_barrier":::"memory");
  #undef DMA_K
  #undef DMA_V
  #undef CMASK
  #undef MSKB
  #undef MSKV
  #undef MBIT
  #undef MCONV
  #undef START
  #undef RESC
  #undef ROT
}
constexpr int ATTN_LDS_BYTES=LDS_BYTES;
struct AttnTensors { const bf16* Q; const bf16* K; const bf16* V; bf16* O; const uint2* Mask; };
struct AttnUnit { int bh; int qb; };
struct StaticOrder {
  int vcu;
  __device__ __forceinline__ explicit StaticOrder(int grid,int block):vcu((block%8)*(grid/8)+block/8){}
  __device__ __forceinline__ bool next(int i,AttnUnit&u)const{ if(i>=4)return false; const int s=vcu&3; u.bh=vcu>>2; u.qb=(i==0)?s:(i==1)?7-s:(i==2)?8+s:15-s; return true; }
  __device__ __forceinline__ void a_ready(const AttnUnit&)const{}
  __device__ __forceinline__ void done(const AttnUnit&)const{}
};
template<class Sched,int THRL=8> __device__ __forceinline__ void attn_phase(char*lds,const AttnTensors&T,const Sched&S,int wave_,bool dry=false){
  AttnUnit u;
  for(int i=0;S.next(i,u);++i){ S.a_ready(u); attn_unit<THRL>(u.bh/NHEAD,u.bh%NHEAD,u.qb,T.Q,T.K,T.V,T.O,T.Mask,lds,dry,wave_); S.done(u); }
}
#undef SBAR
#undef WAIT_BAR
}
#define GAS __attribute__((address_space(1)))
#define LAS __attribute__((address_space(3)))
typedef unsigned short bf16;
typedef unsigned v4u __attribute__((ext_vector_type(4)));
typedef float f32x4 __attribute__((ext_vector_type(4)));
typedef short bf16x8 __attribute__((ext_vector_type(8)));
typedef GAS unsigned gu32;
typedef GAS unsigned long long gu64;
#define RLX_AGENT __ATOMIC_RELAXED, __HIP_MEMORY_SCOPE_AGENT
#define LDS_WAIT() asm volatile("s_waitcnt lgkmcnt(0)" ::: "memory")
#define VM_WAIT() asm volatile("s_waitcnt vmcnt(0)" ::: "memory")
__device__ __forceinline__ unsigned long long rt() { return __builtin_amdgcn_s_memrealtime(); }
__device__ __forceinline__ unsigned f2bf(float f) { unsigned u = __builtin_bit_cast(unsigned, f); return (u + 0x7fffu + ((u >> 16) & 1u)) >> 16; }
__device__ __forceinline__ unsigned pk2(float lo, float hi) { return f2bf(lo) | (f2bf(hi) << 16); }

#define XB_TMO      128
#define XB_XCNT(j)  (256  + 64 * (j))
#define XB_XSUB(j)  (1280 + 64 * (j))
#define XB_XGEN(j)  (2304 + 64 * (j))
#define XB_TOP      3328
#define XB_TOPGEN   3392
#define XCD_BAR_WORDS 3456
#define XB_SPIN_CAP (1u << 18)

__device__ __forceinline__ unsigned xb_ld(unsigned* p)              { return __hip_atomic_load(p, __ATOMIC_RELAXED, __HIP_MEMORY_SCOPE_AGENT); }
__device__ __forceinline__ unsigned xb_add(unsigned* p, unsigned v) { return __hip_atomic_fetch_add(p, v, __ATOMIC_RELAXED, __HIP_MEMORY_SCOPE_AGENT); }
__device__ __forceinline__ unsigned xb_xcc_id() { return (unsigned)__builtin_amdgcn_s_getreg((3 << 11) | 20) & 0xFu; }
#define XB_SPIN(cond, bar) do { unsigned _sp = 0; while (cond) { __builtin_amdgcn_s_sleep(1); \
    if ((++_sp & 255u) == 0u) { if (xb_ld(&(bar)[XB_TMO])) break; if (_sp > XB_SPIN_CAP) { atomicAdd(&(bar)[XB_TMO], 1u); break; } } } } while (0)

struct XcdBarrier {
    unsigned* bar; unsigned x; int wave;
    volatile LAS unsigned* st;
};

__device__ __forceinline__ XcdBarrier xcd_barrier_post(unsigned* bar, volatile LAS unsigned* st, int wave) {
    XcdBarrier b; b.bar = bar; b.x = xb_xcc_id(); b.st = st; b.wave = wave;
    if (threadIdx.x == 0) (void)xb_add(&bar[XB_XCNT(b.x)], 1u);
    return b;
}
__device__ __forceinline__ void xcd_barrier_complete(unsigned* bar, unsigned x, unsigned& nloc, unsigned& nx) {
    const unsigned G = gridDim.x * gridDim.y * gridDim.z;
    unsigned sum, cnt, mine, sp = 0u;
    for (;;) {
        sum = 0u; cnt = 0u; mine = 0u;
#pragma unroll
        for (unsigned j = 0; j < 16; ++j) { const unsigned c = xb_ld(&bar[XB_XCNT(j)]); sum += c; cnt += (c > 0u) ? 1u : 0u; mine = (j == x) ? c : mine; }
        if (sum == G) break;
        __builtin_amdgcn_s_sleep(1);
        if ((++sp & 255u) == 0u) { if (xb_ld(&bar[XB_TMO])) break; if (sp > XB_SPIN_CAP) { atomicAdd(&bar[XB_TMO], 1u); break; } }
    }
    nloc = mine > 0u ? mine : 1u; nx = cnt > 0u ? cnt : 1u;
}

__device__ __forceinline__ void xcd_barrier(const XcdBarrier& b) {
    asm volatile("s_waitcnt vmcnt(0)" ::: "memory");
    __syncthreads();
    int xl_; asm volatile("v_mbcnt_lo_u32_b32 %0, -1, 0\n\tv_mbcnt_hi_u32_b32 %0, -1, %0" : "=v"(xl_));
    if (b.wave == 0 && xl_ == 0) {
        unsigned* bar = b.bar;
        __builtin_amdgcn_s_waitcnt(0);
        unsigned nloc = b.st[0], nx = b.st[1];
        if (nloc == 0u) { xcd_barrier_complete(bar, b.x, nloc, nx); b.st[0] = nloc; b.st[1] = nx; }
        const unsigned old = xb_add(&bar[XB_XSUB(b.x)], 1u);
        const unsigned gen = old / nloc;
        if (old + 1u == (gen + 1u) * nloc) {
            __builtin_amdgcn_fence(__ATOMIC_RELEASE, "agent");
            asm volatile("s_waitcnt vmcnt(0)" ::: "memory");
            const unsigned og = xb_add(&bar[XB_TOP], 1u);
            const unsigned tg = og / nx;
            if (og + 1u == (tg + 1u) * nx) xb_add(&bar[XB_TOPGEN], 1u);
            else XB_SPIN(xb_ld(&bar[XB_TOPGEN]) == tg, bar);
            __builtin_amdgcn_fence(__ATOMIC_ACQUIRE, "agent");
            xb_add(&bar[XB_XGEN(b.x)], 1u);
            asm volatile("s_waitcnt vmcnt(0)" ::: "memory");
        } else {
            XB_SPIN(xb_ld(&bar[XB_XGEN(b.x)]) == gen, bar);
            __builtin_amdgcn_fence(__ATOMIC_ACQUIRE, "agent");
            asm volatile("s_waitcnt vmcnt(0)" ::: "memory");
        }
    }
    __syncthreads();
}

constexpr int NWAVES = 8;
constexpr int T = 32768, DM = 1024, SEQ = 4096, NBATCH = 8, NMEM = 256;
constexpr float EPS = 1e-6f;
constexpr int IN_W = 5192;
constexpr int NCLS = 112;
constexpr size_t MiB = 1u << 20;
constexpr size_t WS_CTL = 0, CTL_ZERO_BYTES = 1 * MiB;
constexpr size_t WS_RSTD0 = 1 * MiB, WS_RSTDM = WS_RSTD0 + 131072, WS_TOKC = WS_RSTD0 + 262144;
constexpr size_t WS_ROPE = 3 * MiB;
constexpr size_t WS_W = 11 * MiB;
constexpr size_t W_R = WS_W, W_V = W_R + 3 * MiB, W_G = W_V + 1 * MiB, W_X = W_G + 2 * MiB, W_GT = W_X + MiB / 2, W_OA = W_GT + 4 * MiB, W_CO = W_OA + 1 * MiB,
                 W_OUT = W_CO + 1 * MiB, W_QX = W_OUT + 2 * MiB, W_KVX = W_QX + 2 * MiB, W_OX = W_KVX + 4 * MiB, W_RT = W_OX + 2 * MiB, W_E1 = W_RT + MiB / 2, W_E2 = W_E1 + 32 * MiB, W_END = W_E2 + 16 * MiB;
static_assert(W_END == 82 * MiB, "weights map");
constexpr size_t WS_XB = 82 * MiB;
constexpr size_t WS_Q = 146 * MiB, WS_CA = 178 * MiB;
constexpr size_t WS_K = 210 * MiB, WS_V = 242 * MiB, WS_QI = 274 * MiB, WS_U = 306 * MiB;
constexpr size_t WS_KI = 338 * MiB, WS_WI = 342 * MiB, WS_MASK = 343 * MiB, WS_KX = 359 * MiB, WS_VT = 363 * MiB, WS_MEMB = 367 * MiB, WS_LIST = 371 * MiB, WS_CE = 375 * MiB;
constexpr size_t W_QH = 385 * MiB, W_OH = 387 * MiB;
constexpr size_t WS_KXH = 389 * MiB, WS_VH = 393 * MiB;
constexpr size_t WS_WK = 397 * MiB, WS_VWT = 413 * MiB;
constexpr size_t WS_X8 = 430 * MiB, WS_W8 = 462 * MiB, WS_CS = 470 * MiB + 512 * 1024;
constexpr size_t WS_M8 = 471 * MiB, WS_CA8 = 473 * MiB, WS_WCO8 = 489 * MiB, WS_CAS = 490 * MiB, WS_END = 507 * MiB;
constexpr int NW8 = 3328 + 2048 + 2048 + 1024, NW8C = 1024,     NW8E = 32 * 512, QE0 = NW8 + NW8C;
constexpr size_t WS_CR = 379 * MiB;
constexpr size_t WS_RMAXA = 490 * MiB + 256 * 1024, WS_RMAXC = WS_RMAXA + 128 * 1024;
constexpr size_t WS_W8E = 491 * MiB;
constexpr size_t WS_HS = 82 * MiB;
constexpr size_t WS_YS = 210 * MiB;
constexpr int CW_TMO = 0, CW_CODE = 1, CW_BAR = 4096, CW_ROWSQ1 = 32768, CW_ROWSQ2 = 65536, CW_CNT = 98304;
constexpr int CW_CMAX = 204800;
constexpr int CW_RDY = 131072, CW_RDYTOT = 196608;
static_assert((CW_CNT + 64 * NCLS) <= CW_RDY && CW_RDY + 64 * 288 <= CW_RDYTOT && (CW_RDYTOT + 128) <= CW_CMAX && (CW_CMAX + QE0 + NW8E) * 4 <= (int)CTL_ZERO_BYTES, "CTL words inside the memset region");
constexpr int SCR_BYTES = 147456;
constexpr int LDSCTL_OFF = SCR_BYTES, MISC_OFF = LDSCTL_OFF + 320, LDS_BYTES = SCR_BYTES + 4096;


struct Frame {
    LAS unsigned char* lds;
    volatile LAS unsigned* MISC;
    gu32* ctl;
    unsigned char* ws;
    int tid, lane, wave, vcu, G;
    const float* const* in;
    float* out;
};
template <class TT> __device__ __forceinline__ TT* wsp(const Frame& F, size_t off) { return (TT*)(F.ws + off); }
__device__ __forceinline__ float wave_sum(float v) {
#pragma unroll
    for (int o = 1; o < 64; o <<= 1) v += __shfl_xor(v, o);
    return v;
}
__device__ __forceinline__ float bf2f(unsigned short h) { return __builtin_bit_cast(float, (unsigned)h << 16); }

template <class DstFn>
__device__ __forceinline__ void p0_item(const float* W, int N, int n0, int k0, const float* gain, float scale, DstFn dst, LAS float* scr, int lane, gu32* cmax = nullptr) {
    f32x4 v[8];
#pragma unroll
    for (int i = 0; i < 8; ++i) v[i] = *(const GAS f32x4*)(W + (size_t)(k0 + 8 * i + (lane >> 3)) * N + n0 + 4 * (lane & 7));
#pragma unroll
    for (int i = 0; i < 8; ++i) { const int kk = 8 * i + (lane >> 3); const float g = gain ? gain[k0 + kk] * scale : scale; LAS float* sp = scr + kk * 33 + 4 * (lane & 7);
        sp[0] = v[i][0] * g; sp[1] = v[i][1] * g; sp[2] = v[i][2] * g; sp[3] = v[i][3] * g; }
    LDS_WAIT(); asm volatile("" ::: "memory");
    const int c = lane & 7;
#pragma unroll
    for (int j = 0; j < 4; ++j) { const int n = (lane >> 3) + 8 * j; const LAS float* s = scr + (8 * c) * 33 + n;
        v4u o; o.x = pk2(s[0 * 33], s[1 * 33]); o.y = pk2(s[2 * 33], s[3 * 33]); o.z = pk2(s[4 * 33], s[5 * 33]); o.w = pk2(s[6 * 33], s[7 * 33]);
        *(GAS v4u*)dst(n, c) = o;
        if (cmax) { float m = fmaxf(fmaxf(fmaxf(fabsf(s[0 * 33]), fabsf(s[1 * 33])), fmaxf(fabsf(s[2 * 33]), fabsf(s[3 * 33]))), fmaxf(fmaxf(fabsf(s[4 * 33]), fabsf(s[5 * 33])), fmaxf(fabsf(s[6 * 33]), fabsf(s[7 * 33]))));
            m = fmaxf(m, __shfl_xor(m, 1)); m = fmaxf(m, __shfl_xor(m, 2)); m = fmaxf(m, __shfl_xor(m, 4));
            if (c == 0) (void)__hip_atomic_fetch_max(cmax + n, __builtin_bit_cast(unsigned, m), RLX_AGENT); } }
    LDS_WAIT(); asm volatile("" ::: "memory");
}
#define P0_PLAIN(Wsrc, Nsrc, n0src, Kdim, gainp, scl, WT, row0) do { const int k0_ = 64 * kb; bf16* wt_ = (WT); const int r0_ = (row0); const int Kd_ = (Kdim); \
    p0_item((Wsrc), (Nsrc), (n0src), k0_, (gainp), (scl), [=](int n, int c) { return wt_ + (size_t)(r0_ + n) * Kd_ + k0_ + 8 * c; }, scr, F.lane); } while (0)
#define P0_PLAINQ(Wsrc, Nsrc, n0src, Kdim, gainp, scl, WT, row0, q8row0) do { const int k0_ = 64 * kb; bf16* wt_ = (WT); const int r0_ = (row0); const int Kd_ = (Kdim); \
    p0_item((Wsrc), (Nsrc), (n0src), k0_, (gainp), (scl), [=](int n, int c) { return wt_ + (size_t)(r0_ + n) * Kd_ + k0_ + 8 * c; }, scr, F.lane, F.ctl + CW_CMAX + (q8row0) + r0_); } while (0)

__device__ __forceinline__ void p0_prologue(Frame& F) {
    LAS float* scr = (LAS float*)(F.lds + F.wave * 16384);
    const int gw = F.vcu * NWAVES + F.wave, NGW = F.G * NWAVES;
    const float* w_in = F.in[4]; const float* g_mix = F.in[3];
    constexpr int I_QKQ = 16 * 16, I_V = 16 * 16, I_GLU = 16 * 32, I_X = 16 * 3, I_GT = 16 * 64, I_OA = 8 * 32, I_CO = 8 * 32, I_OUT = 16 * 32, I_QX = 16 * 32, I_KVX = 16 * 64, I_OX = 16 * 32,
                  I_EG = 32 * 16 * 8, I_EU = I_EG, I_ED = 32 * 4 * 32;
    constexpr int NITEMS = 3 * I_QKQ + I_V + I_GLU + I_X + I_GT + I_OA + I_CO + I_OUT + I_QX + I_KVX + I_OX + I_EG + I_EU + I_ED;
    constexpr float C2 = 0.125f * 1.4426950408889634f;
    constexpr float CX = 0.0625f * 1.4426950408889634f;
    for (int it = gw; it < NITEMS; it += NGW) {
        int r = it;
        if (r < 3 * I_QKQ) {
            const int t = r / I_QKQ; r -= t * I_QKQ; const int kb = r / 16, nb = r % 16, H = nb >> 1, s = nb & 1;
            const int srcc = (t == 0 ? 0 : (t == 1 ? 512 : 1536)) + nb * 32;
            P0_PLAINQ(w_in, IN_W, srcc, 1024, g_mix, (t == 0 ? C2 : 1.0f), wsp<bf16>(F, W_R), t * 512 + 256 * (H >> 2) + 128 * s + 32 * (H & 3), 0); continue; }
        r -= 3 * I_QKQ;
        if (r < I_V) { const int kb = r / 16, nb = r % 16; P0_PLAINQ(w_in, IN_W, 1024 + nb * 32, 1024, g_mix, 1.0f, wsp<bf16>(F, W_V), nb * 32, 1536); continue; }
        r -= I_V;
        if (r < I_GLU) { const int kb = r / 32, nb = r % 32, half = nb >> 4, cb = nb & 15;
            P0_PLAINQ(w_in, IN_W, 2120 + nb * 32, 1024, g_mix, 1.0f, wsp<bf16>(F, W_G), 256 * (cb >> 2) + 128 * half + 32 * (cb & 3), 2048); continue; }
        r -= I_GLU;
        if (r < I_X) { const int kb = r / 3, nb = r % 3;
            P0_PLAINQ(w_in, IN_W, (nb == 0 ? 2048 : (nb == 1 ? 2080 : 2112)), 1024, g_mix, 1.0f, wsp<bf16>(F, W_X), (nb == 0 ? 0 : (nb == 1 ? 128 : 32)), 3072); continue; }
        r -= I_X;
        if (r < I_GT) { const int kb = r / 64, nb = r % 64, br = nb >> 5, cb = nb & 31;
            P0_PLAINQ(w_in, IN_W, 3144 + nb * 32, 1024, g_mix, 1.0f, wsp<bf16>(F, W_GT), 256 * (cb >> 2) + 128 * br + 32 * (cb & 3), 3328); continue; }
        r -= I_GT;
        if (r < I_OA) { const int kb = r / 32, nb = r % 32; P0_PLAIN(F.in[5], 1024, nb * 32, 512, (const float*)nullptr, 1.0f, wsp<bf16>(F, W_OA), nb * 32); continue; }
        r -= I_OA;
        if (r < I_CO) { const int kb = r / 32, nb = r % 32; P0_PLAINQ(F.in[10], 1024, nb * 32, 512, (const float*)nullptr, 1.0f, wsp<bf16>(F, W_CO), nb * 32, NW8); continue; }
        r -= I_CO;
        if (r < I_OUT) { const int kb = r / 32, nb = r % 32; P0_PLAINQ(F.in[11], 1024, nb * 32, 1024, (const float*)nullptr, 1.0f, wsp<bf16>(F, W_OUT), nb * 32, 7424); continue; }
        r -= I_OUT;
        if (r < I_QX) {
            const int kb = r / 32, nb = r % 32, hh = nb >> 3, d0 = (nb & 7) * 32; const float* src = F.in[14]; const float* gx = F.in[12]; bf16* dst = wsp<bf16>(F, W_QH);
            for (int q = 0; q < 4; ++q) { const int k = 64 * kb + 16 * q + (F.lane >> 2), dd = d0 + 8 * (F.lane & 3); const float gsc = gx[k] * CX;
                const f32x4 v0 = *(const GAS f32x4*)(src + (size_t)k * 1024 + hh * 256 + dd), v1 = *(const GAS f32x4*)(src + (size_t)k * 1024 + hh * 256 + dd + 4);
                v4u o; o.x = pk2(v0.x * gsc, v0.y * gsc); o.y = pk2(v0.z * gsc, v0.w * gsc); o.z = pk2(v1.x * gsc, v1.y * gsc); o.w = pk2(v1.z * gsc, v1.w * gsc);
                *(GAS v4u*)(dst + ((size_t)hh * 1024 + k) * 256 + dd) = o; }
            continue; }
        r -= I_QX;
        if (r < I_KVX) { const int kb = r / 64, nb = r % 64; P0_PLAINQ(F.in[15], 2048, nb * 32, 1024, F.in[13], 1.0f, wsp<bf16>(F, W_KVX), nb * 32, 5376); continue; }
        r -= I_KVX;
        if (r < I_OX) {
            const int hh = r / 128, r2 = r % 128, kb = r2 / 32, nb = r2 % 32;
            P0_PLAIN(F.in[16] + (size_t)hh * 256 * 1024, 1024, nb * 32, 256, (const float*)nullptr, 1.0f, wsp<bf16>(F, W_OH) + (size_t)hh * 1024 * 256, nb * 32); continue; }
        r -= I_OX;
        if (r < I_EG + I_EU) {
            const int ct = r / I_EG; r -= ct * I_EG; const int e = r / 128; r -= e * 128; const int kb = r / 8, nb = r % 8;
            P0_PLAINQ((ct == 0 ? F.in[22] : F.in[23]) + (size_t)e * 1024 * 256, 256, nb * 32, 1024, F.in[17], 1.0f, wsp<bf16>(F, W_E1), e * 512 + 256 * (nb >> 2) + 128 * ct + 32 * (nb & 3), QE0);
            continue; }
        r -= I_EG + I_EU;
        {
            const int e = r / 128; r -= e * 128; const int kb = r / 32, nb = r % 32;
            P0_PLAIN(F.in[24] + (size_t)e * 256 * 1024, 1024, nb * 32, 256, (const float*)nullptr, 1.0f, wsp<bf16>(F, W_E2), e * 1024 + nb * 32);
        }
    }
}
__device__ __forceinline__ void p0_rest(Frame& F) {
    const int gw = F.vcu * NWAVES + F.wave, NGW = F.G * NWAVES;
    { const bf16* wsrc0 = wsp<bf16>(F, W_R); const bf16* wsrc1 = wsp<bf16>(F, W_GT); signed char* w8 = wsp<signed char>(F, WS_W8); float* cs = wsp<float>(F, WS_CS);
      for (int rb = gw; rb < NW8 + NW8E; rb += 4 * NGW) {
          v4u a[4], b[4]; float am[4]; int ci[4];
#pragma unroll
          for (int u = 0; u < 4; ++u) { const int r = rb + u * NGW < NW8 + NW8E ? rb + u * NGW : rb; const bool ex = r >= NW8; const int re = r - NW8;
              const bf16* src = (ex ? wsp<bf16>(F, W_E1) + (size_t)re * 1024 : (r < 3328 ? wsrc0 + (size_t)r * 1024 : (r < 5376 ? wsrc1 + (size_t)(r - 3328) * 1024 : (r < 7424 ? wsp<bf16>(F, W_KVX) + (size_t)(r - 5376) * 1024 : wsp<bf16>(F, W_OUT) + (size_t)(r - 7424) * 1024)))) + 16 * F.lane;
              a[u] = *(const GAS v4u*)src; b[u] = *(const GAS v4u*)(src + 8); ci[u] = ex ? QE0 + re : r;
              am[u] = __builtin_bit_cast(float, __hip_atomic_load(F.ctl + CW_CMAX + ci[u], RLX_AGENT)); }
#pragma unroll
          for (int u = 0; u < 4; ++u) { const int r = rb + u * NGW; if (r >= NW8 + NW8E) break; const bool ex = r >= NW8; const int re = r - NW8;
              const float inv = am[u] > 0.f ? 127.0f / am[u] : 0.f;
              const unsigned wv_[8] = {a[u].x, a[u].y, a[u].z, a[u].w, b[u].x, b[u].y, b[u].z, b[u].w}; unsigned o[4];
#pragma unroll
              for (int i = 0; i < 4; ++i) { unsigned pk = 0u;
#pragma unroll
                  for (int j = 0; j < 4; ++j) { const unsigned w2 = wv_[2 * i + (j >> 1)]; const float f = __builtin_bit_cast(float, (j & 1) ? (w2 & 0xFFFF0000u) : (w2 << 16));
                      int q = (int)__builtin_rintf(f * inv); q = q > 127 ? 127 : (q < -127 ? -127 : q); pk |= (unsigned)(q & 255) << (8 * j); }
                  o[i] = pk; }
              *(GAS v4u*)((ex ? wsp<signed char>(F, WS_W8E) + (size_t)re * 1024 : w8 + (size_t)r * 1024) + 16 * F.lane) = (v4u){o[0], o[1], o[2], o[3]};
              if (F.lane == 0) cs[ci[u]] = am[u] * (1.0f / 127.0f); } }
      { const bf16* wco = wsp<bf16>(F, W_CO); signed char* w8c = wsp<signed char>(F, WS_WCO8);
        for (int r2 = gw; r2 < NW8C / 2; r2 += NGW) { const int r = 2 * r2 + (F.lane >> 5), kk = 16 * (F.lane & 31);
          const bf16* src = wco + (size_t)r * 512 + kk;
          const v4u a = *(const GAS v4u*)src, b = *(const GAS v4u*)(src + 8);
          const float am = __builtin_bit_cast(float, __hip_atomic_load(F.ctl + CW_CMAX + NW8 + r, RLX_AGENT)), inv = am > 0.f ? 127.0f / am : 0.f;
          const unsigned wv_[8] = {a.x, a.y, a.z, a.w, b.x, b.y, b.z, b.w}; unsigned o[4];
#pragma unroll
          for (int i = 0; i < 4; ++i) { unsigned pk = 0u;
#pragma unroll
              for (int j = 0; j < 4; ++j) { const unsigned w2 = wv_[2 * i + (j >> 1)]; const float f = __builtin_bit_cast(float, (j & 1) ? (w2 & 0xFFFF0000u) : (w2 << 16));
                  int q = (int)__builtin_rintf(f * inv); q = q > 127 ? 127 : (q < -127 ? -127 : q); pk |= (unsigned)(q & 255) << (8 * j); }
              o[i] = pk; }
          *(GAS v4u*)(w8c + (size_t)r * 512 + kk) = (v4u){o[0], o[1], o[2], o[3]};
          if ((F.lane & 31) == 0) cs[NW8 + r] = am * (1.0f / 127.0f); } } }
    { const float* wrg = F.in[18]; const float* wre = F.in[20]; const float* gm = F.in[17]; bf16* rt_ = wsp<bf16>(F, W_RT);
      for (int i = (F.vcu * NWAVES + F.wave) * 64 + F.lane; i < 36 * 1024; i += NGW * 64) { const int c = i >> 10, k = i & 1023;
          const float v = (c < 4 ? wrg[k * 4 + c] : wre[((size_t)((c - 4) >> 3) * 1024 + k) * 8 + ((c - 4) & 7)]) * gm[k]; rt_[(size_t)c * 1024 + k] = (bf16)f2bf(v); } }
    { const float* x = F.in[0]; bf16* xb = wsp<bf16>(F, WS_XB); float* rstd0 = wsp<float>(F, WS_RSTD0);
      for (int m0 = gw * 4; m0 < T + NBATCH * NMEM; m0 += NGW * 4) {
          f32x4 v[4][4]; float s[4], am[4];
#pragma unroll
          for (int q = 0; q < 4; ++q) { const int m = m0 + q; const bool ismem = m >= T; const int mm = ismem ? m - T : m;
              const GAS f32x4* xr = (const GAS f32x4*)((ismem ? F.in[1] : x) + (size_t)mm * DM) + F.lane;
#pragma unroll
              for (int j = 0; j < 4; ++j) v[q][j] = xr[64 * j]; }
#pragma unroll
          for (int q = 0; q < 4; ++q) { s[q] = 0.f; am[q] = 0.f;
#pragma unroll
              for (int j = 0; j < 4; ++j) { s[q] += (v[q][j].x * v[q][j].x + v[q][j].y * v[q][j].y) + (v[q][j].z * v[q][j].z + v[q][j].w * v[q][j].w);
                  am[q] = fmaxf(am[q], fmaxf(fmaxf(fabsf(v[q][j].x), fabsf(v[q][j].y)), fmaxf(fabsf(v[q][j].z), fabsf(v[q][j].w)))); } }
#pragma unroll
          for (int o = 1; o < 64; o <<= 1) {
#pragma unroll
              for (int q = 0; q < 4; ++q) { s[q] += __shfl_xor(s[q], o); am[q] = fmaxf(am[q], __shfl_xor(am[q], o)); } }
#pragma unroll
          for (int q = 0; q < 4; ++q) { const int m = m0 + q; const bool ismem = m >= T; const int mm = ismem ? m - T : m;
              const float rs = 1.0f / sqrtf(s[q] * (1.0f / DM) + EPS);
              {
                  const float inv = am[q] > 0.f ? 127.0f / am[q] : 0.f; GAS unsigned* o4 = (GAS unsigned*)(wsp<signed char>(F, ismem ? WS_M8 : WS_X8) + (size_t)mm * DM) + F.lane;
#pragma unroll
                  for (int j = 0; j < 4; ++j) { const int q0 = (int)__builtin_rintf(v[q][j].x * inv), q1 = (int)__builtin_rintf(v[q][j].y * inv), q2 = (int)__builtin_rintf(v[q][j].z * inv), q3 = (int)__builtin_rintf(v[q][j].w * inv);
                      o4[64 * j] = (unsigned)(q0 & 255) | ((unsigned)(q1 & 255) << 8) | ((unsigned)(q2 & 255) << 16) | ((unsigned)(q3 & 255) << 24); } }
              if (F.lane == 0) { const float rq = rs * (am[q] * (1.0f / 127.0f)); if (ismem) wsp<float>(F, WS_RSTDM)[mm] = rq; else { rstd0[mm] = rq; wsp<unsigned>(F, WS_RMAXA)[mm] = 0u; wsp<unsigned>(F, WS_RMAXC)[mm] = 0u; } } }
      } }
    { const int* pos = (const int*)F.in[2]; float* rope = wsp<float>(F, WS_ROPE);
      for (int i = (F.vcu * NWAVES + F.wave) * 64 + F.lane; i < T * 32; i += NGW * 64) { const int tok = i >> 5, fi = i & 31;
          double inv = 1.0; const double rr = 0.74989420933245582730;
          for (int q = 0; q < fi; ++q) inv *= rr;
          const float ang = (float)pos[tok] * (float)inv;
          const double a = (double)ang; const double kq = __builtin_rint(a * 0.63661977236758134308);
          const double rd = (a - kq * 1.57079632679489655800) - kq * 6.12323399573676603587e-17;
          const double r2 = rd * rd;
          double sn = rd * (1.0 + r2 * (-1.0 / 6 + r2 * (1.0 / 120 + r2 * (-1.0 / 5040 + r2 * (1.0 / 362880 + r2 * (-1.0 / 39916800 + r2 * (1.0 / 6227020800.0 + r2 * (-1.0 / 1307674368000.0))))))));
          double cs = 1.0 + r2 * (-0.5 + r2 * (1.0 / 24 + r2 * (-1.0 / 720 + r2 * (1.0 / 40320 + r2 * (-1.0 / 3628800 + r2 * (1.0 / 479001600.0 + r2 * (-1.0 / 87178291200.0 + r2 * (1.0 / 20922789888000.0))))))));
          const int qd = ((int)kq) & 3; double c_, s_;
          if (qd == 0) { c_ = cs; s_ = sn; } else if (qd == 1) { c_ = -sn; s_ = cs; } else if (qd == 2) { c_ = -cs; s_ = -sn; } else { c_ = sn; s_ = -cs; }
          rope[(size_t)tok * 64 + fi] = (float)c_; rope[(size_t)tok * 64 + 32 + fi] = (float)s_; } }
}

typedef float f32x16 __attribute__((ext_vector_type(16)));
__device__ __forceinline__ f32x16 mfma32(bf16x8 a, bf16x8 b, f32x16 c) { return __builtin_amdgcn_mfma_f32_32x32x16_bf16(a, b, c, 0, 0, 0); }
__device__ __forceinline__ f32x4 mfma16(bf16x8 a, bf16x8 b, f32x4 c) { return __builtin_amdgcn_mfma_f32_16x16x32_bf16(a, b, c, 0, 0, 0); }
__device__ __forceinline__ int crow32(int r, int hi) { return (r & 3) + 8 * (r >> 2) + 4 * hi; }
#define WG_SYNC() do { asm volatile("s_waitcnt vmcnt(0) lgkmcnt(0)" ::: "memory"); __builtin_amdgcn_s_barrier(); asm volatile("" ::: "memory"); } while (0)

__device__ __forceinline__ float wave_sum_dpp(float v) {
#define DPPF0(v_, ctrl_) __builtin_bit_cast(float, __builtin_amdgcn_update_dpp(0, __builtin_bit_cast(int, v_), ctrl_, 0xF, 0xF, true))
    v += DPPF0(v, 0xB1); v += DPPF0(v, 0x4E); v += DPPF0(v, 0x141); v += DPPF0(v, 0x140);
#undef DPPF0
    const float a = __builtin_bit_cast(float, __builtin_amdgcn_readlane(__builtin_bit_cast(int, v), 0)), b = __builtin_bit_cast(float, __builtin_amdgcn_readlane(__builtin_bit_cast(int, v), 16)),
                cc = __builtin_bit_cast(float, __builtin_amdgcn_readlane(__builtin_bit_cast(int, v), 32)), d = __builtin_bit_cast(float, __builtin_amdgcn_readlane(__builtin_bit_cast(int, v), 48));
    return (a + b) + (cc + d);
}
__device__ __forceinline__ float wave_max_dpp(float v);
#define LDS_SYNC() do { asm volatile("s_waitcnt lgkmcnt(0)" ::: "memory"); __builtin_amdgcn_s_barrier(); asm volatile("" ::: "memory"); } while (0)
__device__ __forceinline__ void conv_phase(Frame& F) {
    const bf16* U = wsp<bf16>(F, WS_U); signed char* CA8 = wsp<signed char>(F, WS_CA8); float* CAS = wsp<float>(F, WS_CAS);
    const float* cw = F.in[6]; const float* cb = F.in[7]; const float* lg = F.in[8]; const float* lb = F.in[9];
    LAS float* yy = (LAS float*)F.lds;
    const int lane = F.lane, wv = F.wave, c = wv * 64 + lane;
    float w[31];
#pragma unroll
    for (int j = 0; j < 31; ++j) w[j] = cw[j * 512 + c];
    const float bias = cb[c];
    const f32x4 g0 = *(const f32x4*)(lg + 8 * lane), g1 = *(const f32x4*)(lg + 8 * lane + 4), b0 = *(const f32x4*)(lb + 8 * lane), b1 = *(const f32x4*)(lb + 8 * lane + 4);
    for (int unit = F.vcu; unit < T / 128; unit += F.G) {
        const int tok0 = unit * 128, s0 = tok0 & (SEQ - 1);
        float in[62];
#pragma unroll
        for (int t = 0; t < 30; ++t) in[t] = (s0 - 30 + t >= 0) ? bf2f(U[(size_t)(tok0 - 30 + t) * 512 + c]) : 0.f;
        unsigned short nx[32];
#pragma unroll
        for (int t = 0; t < 32; ++t) nx[t] = U[(size_t)(tok0 + t) * 512 + c];
#pragma unroll 1
        for (int sb = 0; sb < 4; ++sb) {
#pragma unroll
            for (int t = 0; t < 32; ++t) in[30 + t] = bf2f(nx[t]);
            { const int sbn = sb < 3 ? sb + 1 : 3; const bf16* up = U + (size_t)(tok0 + 32 * sbn) * 512 + c;
#pragma unroll
              for (int t = 0; t < 32; ++t) nx[t] = up[(size_t)t * 512]; }
#pragma unroll
            for (int t = 0; t < 32; ++t) { float a = bias;
#pragma unroll
                for (int j = 0; j < 31; ++j) a = __builtin_fmaf(w[j], in[t + j], a);
                yy[t * 512 + c] = a; }
#pragma unroll
            for (int t = 0; t < 30; ++t) in[t] = in[32 + t];
            LDS_SYNC();
            { f32x4 v0[4], v1[4]; float s[4];
#pragma unroll
              for (int q = 0; q < 4; ++q) { const int t = 4 * wv + q; v0[q] = *(const LAS f32x4*)(yy + t * 512 + 8 * lane); v1[q] = *(const LAS f32x4*)(yy + t * 512 + 8 * lane + 4);
                  s[q] = (v0[q][0] + v0[q][1]) + (v0[q][2] + v0[q][3]) + (v1[q][0] + v1[q][1]) + (v1[q][2] + v1[q][3]); }
#pragma unroll
              for (int q = 0; q < 4; ++q) s[q] = wave_sum_dpp(s[q]);
#pragma unroll
              for (int q = 0; q < 4; ++q) { const float mean = s[q] * (1.0f / 512.0f); v0[q] = v0[q] - mean; v1[q] = v1[q] - mean;
                  s[q] = (v0[q][0] * v0[q][0] + v0[q][1] * v0[q][1]) + (v0[q][2] * v0[q][2] + v0[q][3] * v0[q][3]) + (v1[q][0] * v1[q][0] + v1[q][1] * v1[q][1]) + (v1[q][2] * v1[q][2] + v1[q][3] * v1[q][3]); }
#pragma unroll
              for (int q = 0; q < 4; ++q) s[q] = wave_sum_dpp(s[q]);
#pragma unroll
              for (int q = 0; q < 4; ++q) { const int t = 4 * wv + q; const float rs = 1.0f / sqrtf(s[q] * (1.0f / 512.0f) + EPS);
                  f32x4 a = v0[q] * rs * g0 + b0, b = v1[q] * rs * g1 + b1;
                  a = a * pg8::sigmoid4(a); b = b * pg8::sigmoid4(b);
                  const float am = wave_max_dpp(fmaxf(fmaxf(fmaxf(fabsf(a.x), fabsf(a.y)), fmaxf(fabsf(a.z), fabsf(a.w))), fmaxf(fmaxf(fabsf(b.x), fabsf(b.y)), fmaxf(fabsf(b.z), fabsf(b.w)))));
                  const float inv = am > 0.f ? 127.0f / am : 0.f;
                  const unsigned lo = (unsigned)((int)__builtin_rintf(a.x * inv) & 255) | ((unsigned)((int)__builtin_rintf(a.y * inv) & 255) << 8) | ((unsigned)((int)__builtin_rintf(a.z * inv) & 255) << 16) | ((unsigned)((int)__builtin_rintf(a.w * inv) & 255) << 24);
                  const unsigned hi = (unsigned)((int)__builtin_rintf(b.x * inv) & 255) | ((unsigned)((int)__builtin_rintf(b.y * inv) & 255) << 8) | ((unsigned)((int)__builtin_rintf(b.z * inv) & 255) << 16) | ((unsigned)((int)__builtin_rintf(b.w * inv) & 255) << 24);
                  *(GAS unsigned long long*)(CA8 + (size_t)(tok0 + 32 * sb + t) * 512 + 8 * lane) = (unsigned long long)lo | ((unsigned long long)hi << 32);
                  if (lane == 0) CAS[tok0 + 32 * sb + t] = am * (1.0f / 127.0f); } }
            LDS_SYNC();
        }
    }
}

#define DPPF(v_, ctrl_) __builtin_bit_cast(float, __builtin_amdgcn_update_dpp(0, __builtin_bit_cast(int, v_), ctrl_, 0xF, 0xF, true))
__device__ __forceinline__ float wave_min_dpp(float v) {
    v = fminf(v, DPPF(v, 0xB1)); v = fminf(v, DPPF(v, 0x4E)); v = fminf(v, DPPF(v, 0x141)); v = fminf(v, DPPF(v, 0x140));
    const float a = __builtin_bit_cast(float, __builtin_amdgcn_readlane(__builtin_bit_cast(int, v), 0)), b = __builtin_bit_cast(float, __builtin_amdgcn_readlane(__builtin_bit_cast(int, v), 16)),
                cc = __builtin_bit_cast(float, __builtin_amdgcn_readlane(__builtin_bit_cast(int, v), 32)), d = __builtin_bit_cast(float, __builtin_amdgcn_readlane(__builtin_bit_cast(int, v), 48));
    return fminf(fminf(a, b), fminf(cc, d));
}
__device__ __forceinline__ float wave_max_dpp(float v) {
    v = fmaxf(v, DPPF(v, 0xB1)); v = fmaxf(v, DPPF(v, 0x4E)); v = fmaxf(v, DPPF(v, 0x141)); v = fmaxf(v, DPPF(v, 0x140));
    const float a = __builtin_bit_cast(float, __builtin_amdgcn_readlane(__builtin_bit_cast(int, v), 0)), b = __builtin_bit_cast(float, __builtin_amdgcn_readlane(__builtin_bit_cast(int, v), 16)),
                cc = __builtin_bit_cast(float, __builtin_amdgcn_readlane(__builtin_bit_cast(int, v), 32)), d = __builtin_bit_cast(float, __builtin_amdgcn_readlane(__builtin_bit_cast(int, v), 48));
    return fmaxf(fmaxf(a, b), fmaxf(cc, d));
}
__device__ __forceinline__ unsigned wave_suffix_sum_dpp(unsigned v, int lane) {
#define DPPU(v_, ctrl_) ((unsigned)__builtin_amdgcn_update_dpp(0, (int)(v_), ctrl_, 0xF, 0xF, true))
    v += DPPU(v, 0x101); v += DPPU(v, 0x102); v += DPPU(v, 0x104); v += DPPU(v, 0x108);
    const unsigned t1 = (unsigned)__builtin_amdgcn_readlane((int)v, 16), t2 = (unsigned)__builtin_amdgcn_readlane((int)v, 32), t3 = (unsigned)__builtin_amdgcn_readlane((int)v, 48);
    const int r = lane >> 4; return v + (r == 0 ? t1 + t2 + t3 : (r == 1 ? t2 + t3 : (r == 2 ? t3 : 0u)));
#undef DPPU
}
__device__ __forceinline__ unsigned wave_prefix_sum_dpp(unsigned v, int lane) {
#define DPPU(v_, ctrl_) ((unsigned)__builtin_amdgcn_update_dpp(0, (int)(v_), ctrl_, 0xF, 0xF, true))
    v += DPPU(v, 0x111); v += DPPU(v, 0x112); v += DPPU(v, 0x114); v += DPPU(v, 0x118);
    const unsigned t0 = (unsigned)__builtin_amdgcn_readlane((int)v, 15), t1 = (unsigned)__builtin_amdgcn_readlane((int)v, 31), t2 = (unsigned)__builtin_amdgcn_readlane((int)v, 47);
    const int r = lane >> 4; return v + (r == 0 ? 0u : (r == 1 ? t0 : (r == 2 ? t0 + t1 : t0 + t1 + t2)));
#undef DPPU
}
__device__ __forceinline__ unsigned fkey(float f) { const unsigned u = __builtin_bit_cast(unsigned, f); return (u & 0x80000000u) ? ~u : (u | 0x80000000u); }
__device__ __forceinline__ int srow_addr(int k) { return (k >> 8) * 256 + (k & 63) * 4 + ((k >> 6) & 3); }
typedef _Float16 srow_t;
__device__ __forceinline__ void select_row_slow(const LAS srow_t* row, int nch, LAS unsigned long long* mw64, int lane) {
    unsigned tau = 0u; bool exact = false;
    for (int bit = 31; bit >= 0; --bit) { const unsigned cand = tau | (1u << bit); int cnt = 0;
        for (int c = 0; c < nch; ++c) cnt += __builtin_popcountll(__ballot(fkey((float)row[(c >> 2) * 256 + lane * 4 + (c & 3)]) >= cand));
        if (cnt >= 256) { tau = cand; if (cnt == 256) { exact = true; break; } } }
    int rem = 0;
    if (!exact) { int cgt = 0; for (int c = 0; c < nch; ++c) cgt += __builtin_popcountll(__ballot(fkey((float)row[(c >> 2) * 256 + lane * 4 + (c & 3)]) > tau)); rem = 256 - cgt; }
    for (int c = 0; c < 64; ++c) { unsigned long long sel = 0ull;
        if (c < nch) { const unsigned k = fkey((float)row[(c >> 2) * 256 + lane * 4 + (c & 3)]);
            if (exact) sel = __ballot(k >= tau);
            else { sel = __ballot(k > tau); unsigned long long eq = __ballot(k == tau);
                while (eq != 0ull && rem > 0) { const unsigned long long low = eq & (0ull - eq); sel |= low; eq ^= low; --rem; } } }
        if (lane == 0) mw64[c] = sel; }
}
#define SEL_B(BODY, i) BODY(i, 0) if (nch == 4 * (i) + 1) break; BODY(i, 1) if (nch == 4 * (i) + 2) break; BODY(i, 2) if (nch == 4 * (i) + 3) break; BODY(i, 3) if (nch == 4 * (i) + 4) break;
#define SEL_CHUNKS(BODY) do { SEL_B(BODY, 0) SEL_B(BODY, 1) SEL_B(BODY, 2) SEL_B(BODY, 3) SEL_B(BODY, 4) SEL_B(BODY, 5) SEL_B(BODY, 6) SEL_B(BODY, 7) SEL_B(BODY, 8) SEL_B(BODY, 9) SEL_B(BODY, 10) SEL_B(BODY, 11) SEL_B(BODY, 12) SEL_B(BODY, 13) SEL_B(BODY, 14) SEL_B(BODY, 15) } while (0)
__device__ __forceinline__ void select_row(const LAS srow_t* row, int nch_, LAS unsigned* hist, LAS unsigned short* clist, LAS unsigned long long* mw64, int lane, unsigned long long* mrow) {
    int nch = nch_; asm volatile("" : "+s"(nch));
    const int nb = (nch + 3) >> 2;
    float e[16][4];
#pragma unroll
    for (int i = 0; i < 16; ++i) if (i < nb) { typedef _Float16 h4_t __attribute__((ext_vector_type(4))); const h4_t v = *(const LAS h4_t*)(row + i * 256 + lane * 4); e[i][0] = (float)v[0]; e[i][1] = (float)v[1]; e[i][2] = (float)v[2]; e[i][3] = (float)v[3]; }
    float mn = INFINITY, mx = -INFINITY;
    do {
#define BODY_A(i) { mn = __builtin_amdgcn_fmed3f(mn, e[i][0], -INFINITY); mx = __builtin_amdgcn_fmed3f(mx, e[i][0], INFINITY); } if (nch <= 4 * (i) + 4) break;
        BODY_A(0) BODY_A(1) BODY_A(2) BODY_A(3) BODY_A(4) BODY_A(5) BODY_A(6) BODY_A(7) BODY_A(8) BODY_A(9) BODY_A(10) BODY_A(11) BODY_A(12) BODY_A(13) BODY_A(14) BODY_A(15)
#undef BODY_A
    } while (0);
    mn = wave_min_dpp(mn); mx = wave_max_dpp(mx);
    const float scale = (mx - mn > 1e-30f) ? 256.0f / (mx - mn) : 0.f, off = -mn * scale;
    *(LAS v4u*)(hist + 4 * lane) = (v4u){0u, 0u, 0u, 0u};
#define BODY_B(i, j) { const float t = __builtin_fmaf(e[i][j], scale, off); e[i][j] = t; const unsigned bn = (unsigned)__builtin_amdgcn_fmed3f(t, 0.f, 255.f); \
        (void)__hip_atomic_fetch_add(hist + bn, 1u, __ATOMIC_RELAXED, __HIP_MEMORY_SCOPE_WORKGROUP); }
    SEL_CHUNKS(BODY_B);
#undef BODY_B
    asm volatile("s_waitcnt lgkmcnt(0)" ::: "memory");
    const v4u h = *(const LAS v4u*)(hist + 4 * lane);
    const unsigned s4 = h.x + h.y + h.z + h.w; const unsigned suf = wave_suffix_sum_dpp(s4, lane);
    const unsigned long long bm = __ballot(suf >= 256u);
    const int lstar = 63 - __builtin_clzll(bm);
    unsigned run = suf - s4, bl, ab, cn;
    if (run + h.w >= 256u) { bl = 3; ab = run; cn = h.w; } else { run += h.w;
        if (run + h.z >= 256u) { bl = 2; ab = run; cn = h.z; } else { run += h.z;
            if (run + h.y >= 256u) { bl = 1; ab = run; cn = h.y; } else { run += h.y; bl = 0; ab = run; cn = h.x; } } }
    const int bstar = 4 * lstar + __builtin_amdgcn_readlane((int)bl, lstar);
    const int above = __builtin_amdgcn_readlane((int)ab, lstar), cntb = __builtin_amdgcn_readlane((int)cn, lstar);
    const float T0 = bstar == 0 ? -INFINITY : (float)bstar, T1 = bstar == 255 ? INFINITY : (float)(bstar + 1);
    unsigned wlo = 0u, whi = 0u, clo = 0u, chi = 0u;
#define BODY_C(i, j) { const float t = e[i][j]; const unsigned long long sel = __ballot(t >= T1), cand = __ballot(t >= T0) & ~sel; \
        asm volatile("s_nop 1\n\tv_writelane_b32 %0, %2, %4\n\tv_writelane_b32 %1, %3, %4" : "+v"(wlo), "+v"(whi) : "s"((unsigned)sel), "s"((unsigned)(sel >> 32)), "n"(4 * (i) + (j)));     \
        asm volatile("v_writelane_b32 %0, %2, %4\n\tv_writelane_b32 %1, %3, %4" : "+v"(clo), "+v"(chi) : "s"((unsigned)cand), "s"((unsigned)(cand >> 32)), "n"(4 * (i) + (j))); }
    SEL_CHUNKS(BODY_C);
#undef BODY_C
    { unsigned long long cw = ((unsigned long long)chi << 32) | clo;
        const int npc = __builtin_popcountll(cw); int base = (int)wave_prefix_sum_dpp((unsigned)npc, lane) - npc;
        while (__ballot(cw != 0ull) != 0ull) {
            if (cw != 0ull) { const int bit = __builtin_ctzll(cw); if (base < 256) clist[base] = (unsigned short)(64 * lane + bit); cw &= cw - 1ull; ++base; } } }
    mw64[lane] = ((unsigned long long)whi << 32) | wlo;
    asm volatile("s_waitcnt lgkmcnt(0)" ::: "memory");
    const int need2 = 256 - above;
    LAS unsigned* mw32 = (LAS unsigned*)mw64;
    if (cntb > 256) { select_row_slow(row, nch, mw64, lane); }
    else if (cntb <= 64) {
        const bool valid = lane < cntb; const int idx = valid ? (int)clist[lane] : 0; const unsigned key = valid ? fkey((float)row[srow_addr(idx)]) : 0u;
        bool take = valid;
        if (cntb != need2) { int rank = 0;
            for (int i = 0; i < cntb; ++i) { const unsigned ki = (unsigned)__builtin_amdgcn_readlane((int)key, i); rank += (ki > key || (ki == key && i < lane)) ? 1 : 0; }
            take = valid && rank < need2; }
        if (take) (void)__hip_atomic_fetch_or(mw32 + (idx >> 5), 1u << (idx & 31), __ATOMIC_RELAXED, __HIP_MEMORY_SCOPE_WORKGROUP);
    }
    else {
        unsigned key[4]; int idx[4]; bool take[4];
#pragma unroll
        for (int s = 0; s < 4; ++s) { const int jj = lane + 64 * s; const bool valid = jj < cntb; idx[s] = valid ? (int)clist[jj] : 0; key[s] = valid ? fkey((float)row[srow_addr(idx[s])]) : 0u; take[s] = valid; }
        if (cntb != need2) {
            unsigned tau = 0u; bool exact = false;
            for (int bit = 31; bit >= 0; --bit) { const unsigned cand = tau | (1u << bit); int cnt = 0;
#pragma unroll
                for (int s = 0; s < 4; ++s) cnt += __builtin_popcountll(__ballot(key[s] >= cand));
                if (cnt >= need2) { tau = cand; if (cnt == need2) { exact = true; break; } } }
            if (exact) {
#pragma unroll
                for (int s = 0; s < 4; ++s) take[s] = key[s] >= tau; }
            else { int cgt = 0;
#pragma unroll
                for (int s = 0; s < 4; ++s) cgt += __builtin_popcountll(__ballot(key[s] > tau));
                int rem = need2 - cgt;
#pragma unroll
                for (int s = 0; s < 4; ++s) { const bool iseq = key[s] == tau; const unsigned long long eq = __ballot(iseq);
                    const int rk = (int)__builtin_amdgcn_mbcnt_hi((unsigned)(eq >> 32), __builtin_amdgcn_mbcnt_lo((unsigned)eq, 0u));
                    take[s] = (key[s] > tau) || (iseq && rk < rem); const int ne = __builtin_popcountll(eq); rem = rem > ne ? rem - ne : 0; } }
        }
#pragma unroll
        for (int s = 0; s < 4; ++s) if (take[s]) (void)__hip_atomic_fetch_or(mw32 + (idx[s] >> 5), 1u << (idx[s] & 31), __ATOMIC_RELAXED, __HIP_MEMORY_SCOPE_WORKGROUP);
    }
    asm volatile("s_waitcnt lgkmcnt(0)" ::: "memory");
    mrow[lane] = mw64[lane];
}
__device__ __forceinline__ void indexer_scores(const bf16* QI, const bf16* KI, const float* WI, int b, int tb, int g, int ntile, LAS srow_t* Sd, int wv, int lane) {
    const int c32 = lane & 31, hl = lane >> 5;
    bf16x8 qa[2][4]; float wq[2][16];
#pragma unroll
    for (int rt = 0; rt < 2; ++rt) {
        const int quad = c32 >> 2, qq = ((quad >> 2) << 1) | (quad & 1), head = ((quad >> 1) & 1) * 4 + (c32 & 3);
        const bf16* qp = QI + (size_t)(tb + 8 * g + 4 * rt + qq) * 512 + head * 64 + 8 * hl;
#pragma unroll
        for (int ks = 0; ks < 4; ++ks) qa[rt][ks] = *(const GAS bf16x8*)(qp + 16 * ks);
        const float* w0 = WI + (size_t)(tb + 8 * g + 4 * rt + hl) * 8; const float* w1 = w0 + 16;
#pragma unroll
        for (int h = 0; h < 8; ++h) { wq[rt][h] = w0[h]; wq[rt][8 + h] = w1[h]; }
    }
    const bf16* kbase = KI + (size_t)(b * SEQ) * 64 + lane * 8;
    const int ntw = (ntile - wv + NWAVES - 1) / NWAVES;
    bf16x8 k0[4], k1[4], k2[4];
#define IDX_LOAD(dst, pi_) do { const int pc_ = (pi_) < ntw ? (pi_) : ntw - 1; const bf16* kp_ = kbase + (size_t)(wv + NWAVES * pc_) * 2048; \
        _Pragma("unroll") for (int ks = 0; ks < 4; ++ks) dst[ks] = *(const GAS bf16x8*)(kp_ + 512 * ks); } while (0)
#define IDX_TILE(kt_, kb_) do { const int sa = ((kt_) >> 3) * 256 + (32 * ((kt_) & 1) + c32) * 4 + (((kt_) >> 1) & 3); \
        _Pragma("unroll") for (int rt = 0; rt < 2; ++rt) { f32x16 acc = {}; \
            _Pragma("unroll") for (int ks = 0; ks < 4; ++ks) acc = mfma32(qa[rt][ks], kb_[ks], acc); \
            float s0 = 0.f, s1 = 0.f; \
            _Pragma("unroll") for (int h = 0; h < 8; ++h) { s0 = __builtin_fmaf(wq[rt][h], __builtin_amdgcn_fmed3f(acc[h], 0.f, 3.0e38f), s0); s1 = __builtin_fmaf(wq[rt][8 + h], __builtin_amdgcn_fmed3f(acc[8 + h], 0.f, 3.0e38f), s1); } \
            Sd[(4 * rt + hl) * 4096 + sa] = (srow_t)__builtin_amdgcn_fmed3f(s0, -65504.f, 65504.f); Sd[(4 * rt + 2 + hl) * 4096 + sa] = (srow_t)__builtin_amdgcn_fmed3f(s1, -65504.f, 65504.f); } } while (0)
    IDX_LOAD(k0, 0); IDX_LOAD(k1, 1);
    int p0 = 0;
#pragma unroll 1
    for (; p0 + 3 <= ntw; p0 += 3) {
        IDX_LOAD(k2, p0 + 2); IDX_TILE(wv + NWAVES * p0, k0);
        IDX_LOAD(k0, p0 + 3); IDX_TILE(wv + NWAVES * (p0 + 1), k1);
        IDX_LOAD(k1, p0 + 4); IDX_TILE(wv + NWAVES * (p0 + 2), k2);
    }
    if (p0 < ntw) { IDX_TILE(wv + NWAVES * p0, k0); if (p0 + 1 < ntw) IDX_TILE(wv + NWAVES * (p0 + 1), k1); }
#undef IDX_LOAD
#undef IDX_TILE
}
__device__ __forceinline__ void indexer_unit(Frame& F, int b, int nA, int nB) {
    const bf16* QI = wsp<bf16>(F, WS_QI); const bf16* KI = wsp<bf16>(F, WS_KI); const float* WI = wsp<float>(F, WS_WI);
    unsigned long long* MASK = wsp<unsigned long long>(F, WS_MASK);
    int lane; asm volatile("v_mbcnt_lo_u32_b32 %0, -1, 0\n\tv_mbcnt_hi_u32_b32 %0, -1, %0" : "=v"(lane));
    const int wv = F.wave, tid = wv * 64 + lane;
#pragma unroll 1
    for (int k = 0; k < 2; ++k) { const int n = k ? nB : nA; if (n < 4) {
            const int tb = b * SEQ + 64 * n, nw = n + 1;
            for (int i = tid; i < 64 * 4; i += NWAVES * 64) { const int q = i >> 2, wd = i & 3; MASK[(size_t)(tb + q) * 64 + wd] = wd < nw ? ~0ull : 0ull; } } }
    if (nA < 4) return;
    const int nG = nB >= 4 ? 16 : 8;
    LAS srow_t* S = (LAS srow_t*)F.lds;
    LAS unsigned* hist = (LAS unsigned*)(F.lds + 131072) + wv * 256;
    LAS unsigned short* clist = (LAS unsigned short*)(F.lds + 131072 + 8192) + wv * 256;
    LAS unsigned long long* mw64 = (LAS unsigned long long*)(F.lds + 131072 + 8192 + 4096) + wv * 64;
    indexer_scores(QI, KI, WI, b, b * SEQ + 64 * nA, 0, 2 * (nA + 1), S, wv, lane);
    WG_SYNC();
#pragma unroll 1
    for (int G = 0; G < nG; ++G) {
        const int nc = G < 8 ? nA : nB, tbc = b * SEQ + 64 * nc, gc = G & 7;
        const int G1 = G + 1, nn = G1 < 8 ? nA : nB, tbn = b * SEQ + 64 * nn, gn = G1 & 7;
        LAS srow_t* Sc = S + (G & 1) * (8 * 4096); LAS srow_t* Sn = S + (G1 & 1) * (8 * 4096);
#pragma unroll 1
        for (int ph = 0; ph < 3; ++ph) {
            if (ph == 1) select_row(Sc + wv * 4096, nc + 1, hist, clist, mw64, lane, MASK + (size_t)(tbc + 8 * gc + wv) * 64);
            else if ((ph == 0) == (wv < 4) && G1 < nG) indexer_scores(QI, KI, WI, b, tbn, gn, 2 * (nn + 1), Sn, wv, lane); }
        asm volatile("s_waitcnt lgkmcnt(0)" ::: "memory"); __builtin_amdgcn_s_barrier(); asm volatile("" ::: "memory");
    }
}
__device__ __forceinline__ void indexer_phase(Frame& F) {
    for (int u = F.vcu; u < NBATCH * 32; u += F.G) { const int b = u >> 5, j = u & 31; indexer_unit(F, b, 63 - j, j); }
}

__device__ __forceinline__ void xattn_phase(Frame& F) {
    const bf16* QX = wsp<bf16>(F, WS_K); const bf16* KX = wsp<bf16>(F, WS_KX); const bf16* VT = wsp<bf16>(F, WS_VT); bf16* OX = wsp<bf16>(F, WS_QI);
    const int wv = F.wave;
    LAS float* wsf = (LAS float*)(F.lds + 131072) + wv * 64;
    for (int ui = 0; ui < 2; ++ui) {
        int lane; asm volatile("v_mbcnt_lo_u32_b32 %0, -1, 0\n\tv_mbcnt_hi_u32_b32 %0, -1, %0" : "=v"(lane)); const int tid = wv * 64 + lane, r32 = lane & 31, hi = lane >> 5;
        const int u = F.vcu * 2 + ui; if (u >= NBATCH * 4 * 16) break;
        const int bh = u >> 4, qb = u & 15, b = bh >> 2, h = bh & 3;
        const int tok = b * SEQ + qb * 256 + wv * 32 + r32;
        const bf16* qp = QX + (size_t)tok * 1024 + h * 256 + 8 * hi;
        f32x16 O[8];
#pragma unroll
        for (int i = 0; i < 8; ++i) O[i] = f32x16{};
        float mrun = -INFINITY, lrun = 0.f;
        v4u preg[4];
#define XA_LOADK(t_) do { _Pragma("unroll") for (int i = 0; i < 4; ++i) { const int ci = tid + 512 * i, r = ci >> 5, c = ci & 31; preg[i] = *(const GAS v4u*)(KX + (size_t)(b * 256 + 64 * (t_) + r) * 1024 + h * 256 + c * 8); } } while (0)
#define XA_LOADV(t_) do { _Pragma("unroll") for (int i = 0; i < 4; ++i) { const int ci = tid + 512 * i, dv = ci >> 3, c = ci & 7; preg[i] = *(const GAS v4u*)(VT + ((size_t)(b * 4 + h) * 256 + dv) * 256 + 64 * (t_) + c * 8); } } while (0)
#define XA_STOREK(buf_) do { _Pragma("unroll") for (int i = 0; i < 4; ++i) { const int ci = tid + 512 * i, r = ci >> 5, c = ci & 31; *(LAS v4u*)(F.lds + (buf_) * 65536 + r * 512 + ((c ^ (r & 15)) << 4)) = preg[i]; } } while (0)
#define XA_STOREV(buf_) do { _Pragma("unroll") for (int i = 0; i < 4; ++i) { const int ci = tid + 512 * i, dv = ci >> 3, c = ci & 7; *(LAS v4u*)(F.lds + (buf_) * 65536 + 32768 + dv * 128 + ((c ^ (dv & 7)) << 4)) = preg[i]; } } while (0)
        WG_SYNC();
        XA_LOADK(0); XA_STOREK(0); XA_LOADV(0); XA_STOREV(0);
        WG_SYNC();
        for (int t = 0; t < 4; ++t) {
            LAS unsigned char* Kt = F.lds + (t & 1) * 65536; LAS unsigned char* Vt = Kt + 32768;
            if (t < 3) XA_LOADK(t + 1);
            f32x16 p0 = f32x16{}, p1 = f32x16{};
#pragma unroll 4
            for (int ks = 0; ks < 16; ++ks) { const bf16x8 qf = *(const GAS bf16x8*)(qp + 16 * ks);
                const int c = 2 * ks + hi;
                const bf16x8 k0 = *(const LAS bf16x8*)(Kt + r32 * 512 + ((c ^ (r32 & 15)) << 4));
                const bf16x8 k1 = *(const LAS bf16x8*)(Kt + (32 + r32) * 512 + ((c ^ (r32 & 15)) << 4));
                p0 = mfma32(k0, qf, p0); p1 = mfma32(k1, qf, p1); }
            if (t < 3) { XA_STOREK((t + 1) & 1); XA_LOADV(t + 1); }
            float rm = p0[0];
#pragma unroll
            for (int r = 1; r < 16; ++r) rm = fmaxf(rm, p0[r]);
#pragma unroll
            for (int r = 0; r < 16; ++r) rm = fmaxf(rm, p1[r]);
            rm = fmaxf(rm, __shfl_xor(rm, 32));
            const float mnew = fmaxf(mrun, rm), alpha = __builtin_amdgcn_exp2f(mrun - mnew); mrun = mnew;
            float ps = 0.f;
#pragma unroll
            for (int r = 0; r < 16; ++r) { p0[r] = __builtin_amdgcn_exp2f(p0[r] - mnew); p1[r] = __builtin_amdgcn_exp2f(p1[r] - mnew); ps += p0[r] + p1[r]; }
            lrun = lrun * alpha + ps;
            if (hi == 0) wsf[r32] = alpha;
            asm volatile("s_waitcnt lgkmcnt(0)" ::: "memory");
#pragma unroll
            for (int r = 0; r < 16; ++r) { const float a = wsf[crow32(r, hi)];
#pragma unroll
                for (int i = 0; i < 8; ++i) O[i][r] *= a; }
            pg8::u32x4 pw[4];
            pw[0] = pg8::pack8((f32x4){p0[0], p0[1], p0[2], p0[3]}, (f32x4){p0[4], p0[5], p0[6], p0[7]});
            pw[1] = pg8::pack8((f32x4){p0[8], p0[9], p0[10], p0[11]}, (f32x4){p0[12], p0[13], p0[14], p0[15]});
            pw[2] = pg8::pack8((f32x4){p1[0], p1[1], p1[2], p1[3]}, (f32x4){p1[4], p1[5], p1[6], p1[7]});
            pw[3] = pg8::pack8((f32x4){p1[8], p1[9], p1[10], p1[11]}, (f32x4){p1[12], p1[13], p1[14], p1[15]});
#pragma unroll
            for (int blk = 0; blk < 8; ++blk) { const int dv = 32 * blk + r32;
#pragma unroll
                for (int s = 0; s < 4; ++s) { const int c = 2 * s + hi;
                    const bf16x8 vf = *(const LAS bf16x8*)(Vt + dv * 128 + ((c ^ (dv & 7)) << 4));
                    O[blk] = mfma32(__builtin_bit_cast(bf16x8, pw[s]), vf, O[blk]); } }
            if (t < 3) XA_STOREV((t + 1) & 1);
            WG_SYNC();
        }
#undef XA_LOADK
#undef XA_LOADV
#undef XA_STOREK
#undef XA_STOREV
        lrun += __shfl_xor(lrun, 32);
        asm volatile("s_waitcnt lgkmcnt(0)" ::: "memory");
        if (hi == 0) wsf[r32] = 1.0f / lrun;
        asm volatile("s_waitcnt lgkmcnt(0)" ::: "memory");
        bf16* ob = OX + (size_t)(b * SEQ + qb * 256 + wv * 32) * 1024 + h * 256 + r32;
#pragma unroll
        for (int r = 0; r < 16; ++r) { const int q = crow32(r, hi); const float a = wsf[q];
#pragma unroll
            for (int i = 0; i < 8; ++i) ob[(size_t)q * 1024 + 32 * i] = (bf16)f2bf(O[i][r] * a);
            if (r & 1) asm volatile("" ::: "memory"); }
    }
    WG_SYNC();
}

__device__ __forceinline__ void router_phase(Frame& F) {
    const bf16* XB = wsp<bf16>(F, WS_Q); const bf16* RT = wsp<bf16>(F, W_RT);
    const float* rowsq = (const float*)(F.ctl + CW_ROWSQ2); const float* brg = F.in[19]; const float* bre = F.in[21];
    gu32* cnt = F.ctl + CW_CNT; int* list = wsp<int>(F, WS_LIST); float* cE = wsp<float>(F, WS_CE); unsigned* tokpos = wsp<unsigned>(F, WS_TOKC);
    const int lane = F.lane, wv = F.wave, fr = lane & 15, fq = lane >> 4;
    LAS unsigned char* WL = F.lds;
    LAS float* lg = (LAS float*)(F.lds + 98304) + wv * (16 * 48);
    LAS unsigned* lcnt = (LAS unsigned*)(F.lds + 122880); LAS unsigned* gbase = lcnt + 32;
    if (F.tid < 32) lcnt[F.tid] = 0u;
    { v4u wv_[12];
#pragma unroll
      for (int j = 0; j < 12; ++j) { const int i = F.tid + 512 * j, r = i >> 7, ch = i & 127; wv_[j] = *(const GAS v4u*)(RT + (size_t)r * 1024 + ch * 8); }
#pragma unroll
      for (int j = 0; j < 12; ++j) { const int i = F.tid + 512 * j, r = i >> 7, ch = i & 127; *(LAS v4u*)(WL + r * 2048 + ((ch ^ (r & 15)) << 4)) = wv_[j]; } }
    WG_SYNC();
    for (int unit = F.vcu; unit < T / 128; unit += F.G) {
        const int tok0 = unit * 128 + wv * 16;
        const bf16* ap = XB + (size_t)(tok0 + fr) * 1024 + 8 * fq;
        bf16x8 af[32];
#pragma unroll
        for (int ks = 0; ks < 32; ++ks) af[ks] = *(const GAS bf16x8*)(ap + 32 * ks);
        f32x4 acc[3] = {f32x4{}, f32x4{}, f32x4{}};
#pragma unroll
        for (int ks = 0; ks < 32; ++ks) { const int ch = 4 * ks + fq;
#pragma unroll
            for (int ct = 0; ct < 3; ++ct) { const int r = 16 * ct + fr; const bf16x8 bb = *(const LAS bf16x8*)(WL + r * 2048 + ((ch ^ (r & 15)) << 4)); acc[ct] = mfma16(af[ks], bb, acc[ct]); } }
        float rq_tok = 0.f;
        {
          typedef unsigned short us2_t __attribute__((ext_vector_type(2)));
          us2_t mm2 = {0, 0};
#pragma unroll
          for (int ks = 0; ks < 32; ++ks) { const pg8::u32x4 w = __builtin_bit_cast(pg8::u32x4, af[ks]);
#pragma unroll
              for (int d = 0; d < 4; ++d) mm2 = __builtin_elementwise_max(mm2, __builtin_bit_cast(us2_t, w[d] & 0x7FFF7FFFu)); }
          unsigned mb = mm2[0] > mm2[1] ? mm2[0] : mm2[1];
          { const unsigned o1 = (unsigned)__shfl_xor((int)mb, 16); mb = mb > o1 ? mb : o1; const unsigned o2 = (unsigned)__shfl_xor((int)mb, 32); mb = mb > o2 ? mb : o2; }
          const float am = __builtin_bit_cast(float, mb << 16), inv = am > 0.f ? 127.0f / am : 0.f;
          signed char* qrow = wsp<signed char>(F, WS_X8) + (size_t)(tok0 + fr) * 1024 + 8 * fq;
#pragma unroll
          for (int ks = 0; ks < 32; ++ks) { const pg8::u32x4 w = __builtin_bit_cast(pg8::u32x4, af[ks]); unsigned o2_[2];
#pragma unroll
              for (int h = 0; h < 2; ++h) { unsigned pk = 0u;
#pragma unroll
                  for (int j = 0; j < 4; ++j) { const unsigned w2 = w[2 * h + (j >> 1)]; const float f = __builtin_bit_cast(float, (j & 1) ? (w2 & 0xFFFF0000u) : (w2 << 16));
                      pk |= (unsigned)((int)__builtin_rintf(f * inv) & 255) << (8 * j); }
                  o2_[h] = pk; }
              *(GAS unsigned long long*)(qrow + 32 * ks) = (unsigned long long)o2_[0] | ((unsigned long long)o2_[1] << 32); }
          rq_tok = __builtin_amdgcn_rsqf(rowsq[tok0 + fr] * (1.0f / 1024.0f) + EPS) * (am * (1.0f / 127.0f)); }
#pragma unroll
        for (int ct = 0; ct < 3; ++ct)
#pragma unroll
            for (int r = 0; r < 4; ++r) lg[(4 * fq + r) * 48 + 16 * ct + fr] = acc[ct][r];
        asm volatile("s_waitcnt lgkmcnt(0)" ::: "memory");
        int e0 = 0, e1 = 0, r0 = 0, r1 = 0; float c0 = 0.f, c1 = 0.f;
        if (lane < 16) { const int tok = tok0 + lane; const LAS float* l = lg + lane * 48;
            const float rs = __builtin_amdgcn_rsqf(rowsq[tok] * (1.0f / 1024.0f) + EPS);
            float gl[4]; int gs = 0; float gm;
#pragma unroll
            for (int g = 0; g < 4; ++g) gl[g] = l[g] * rs + brg[g];
            gm = gl[0];
#pragma unroll
            for (int g = 1; g < 4; ++g) if (gl[g] > gm) { gm = gl[g]; gs = g; }
            float den = 0.f;
#pragma unroll
            for (int g = 0; g < 4; ++g) den += __expf(gl[g] - gm);
            const float ggate = 1.0f / den;
            float v1 = -INFINITY, v2 = -INFINITY; int i1 = 0, i2 = 0;
            for (int e = 0; e < 8; ++e) { const float v = l[4 + 8 * gs + e] * rs + bre[gs * 8 + e];
                if (v > v1) { v2 = v1; i2 = i1; v1 = v; i1 = e; } else if (v > v2) { v2 = v; i2 = e; } }
            const float e21 = __expf(v2 - v1), w1 = ggate / (1.0f + e21), w2 = ggate * e21 / (1.0f + e21);
            const int lo = i1 < i2 ? i1 : i2, hi_ = i1 < i2 ? i2 : i1; const float clo = i1 < i2 ? w1 : w2, chi = i1 < i2 ? w2 : w1;
            e0 = gs * 8 + lo; e1 = gs * 8 + hi_; c0 = clo; c1 = chi;
            r0 = (int)__hip_atomic_fetch_add(lcnt + e0, 1u, __ATOMIC_RELAXED, __HIP_MEMORY_SCOPE_WORKGROUP); r1 = (int)__hip_atomic_fetch_add(lcnt + e1, 1u, __ATOMIC_RELAXED, __HIP_MEMORY_SCOPE_WORKGROUP); }
        LDS_SYNC();
        if (F.tid < 32) { const unsigned n = lcnt[F.tid]; gbase[F.tid] = n ? __hip_atomic_fetch_add(cnt + 64 * F.tid, n, RLX_AGENT) : 0u; lcnt[F.tid] = 0u; }
        LDS_SYNC();
        if (lane < 16) { const int tok = tok0 + lane; const unsigned s0 = gbase[e0] + (unsigned)r0, s1 = gbase[e1] + (unsigned)r1;
            list[(size_t)e0 * T + s0] = tok; cE[(size_t)e0 * T + s0] = c0; list[(size_t)e1 * T + s1] = tok; cE[(size_t)e1 * T + s1] = c1;
            { float* cR = wsp<float>(F, WS_CR); cR[(size_t)e0 * T + s0] = rq_tok; cR[(size_t)e1 * T + s1] = rq_tok; }
            tokpos[2 * tok] = ((unsigned)e0 << 16) | s0; tokpos[2 * tok + 1] = ((unsigned)e1 << 16) | s1; }
        asm volatile("s_waitcnt lgkmcnt(0)" ::: "memory");
    }
    WG_SYNC();
}

#define FRESH_LANE(l_) asm volatile("v_mbcnt_lo_u32_b32 %0, -1, 0\n\tv_mbcnt_hi_u32_b32 %0, -1, %0" : "=v"(l_))
__device__ __forceinline__ void final_phase(Frame& F) {
    const bf16* XB = wsp<bf16>(F, WS_Q); const bf16* YS = wsp<bf16>(F, WS_YS); const unsigned* tokpos = wsp<unsigned>(F, WS_TOKC); const float* gfin = F.in[25]; float* out = F.out;
    LAS int* pre = (LAS int*)(F.lds + 131072);
    if (F.wave == 0) {
        const int c = F.lane; const int n = c < 32 ? (int)__hip_atomic_load(F.ctl + CW_CNT + 64 * (c & 31), RLX_AGENT) : 0; const int nt_ = (n + 255) >> 8; int incl = nt_;
#pragma unroll
        for (int d = 1; d < 32; d <<= 1) { const int o = __shfl_up(incl, d); if (c >= d) incl += o; }
        if (c < 32) pre[c] = incl - nt_; if (c == 31) pre[32] = incl; }
    WG_SYNC();
    const int lane = F.lane, gw = F.vcu * NWAVES + F.wave, NGW = F.G * NWAVES;
    f32x4 g[4];
#pragma unroll
    for (int j = 0; j < 4; ++j) g[j] = *(const f32x4*)(gfin + 256 * j + 4 * lane);
    typedef unsigned u32x2_t __attribute__((ext_vector_type(2)));
    unsigned tp[8];
#pragma unroll
    for (int q = 0; q < 8; ++q) tp[q] = gw * 4 < T ? tokpos[2 * (gw * 4) + q] : 0u;
    for (int m0 = gw * 4; m0 < T; m0 += NGW * 4) {
        f32x4 v[4][4]; float s[4]; size_t r0[4], r1[4];
#pragma unroll
        for (int q = 0; q < 4; ++q) { const unsigned p0 = tp[2 * q], p1 = tp[2 * q + 1];
            r0[q] = (size_t)pre[p0 >> 16] * 256 + (p0 & 0xffffu); r1[q] = (size_t)pre[p1 >> 16] * 256 + (p1 & 0xffffu); }
        { const int mn_ = m0 + NGW * 4 < T ? m0 + NGW * 4 : m0;
#pragma unroll
          for (int q = 0; q < 8; ++q) tp[q] = tokpos[2 * mn_ + q]; }
#pragma unroll
        for (int q = 0; q < 4; ++q) { const int tok = m0 + q; s[q] = 0.f;
#pragma unroll
            for (int j = 0; j < 4; ++j) { const int col = 256 * j + 4 * lane;
                const u32x2_t xa = *(const GAS u32x2_t*)(XB + (size_t)tok * 1024 + col), ya = *(const GAS u32x2_t*)(YS + r0[q] * 1024 + col), za = *(const GAS u32x2_t*)(YS + r1[q] * 1024 + col);
                f32x4 t;
                t[0] = __builtin_bit_cast(float, xa.x << 16) + (__builtin_bit_cast(float, ya.x << 16) + __builtin_bit_cast(float, za.x << 16));
                t[1] = __builtin_bit_cast(float, xa.x & 0xffff0000u) + (__builtin_bit_cast(float, ya.x & 0xffff0000u) + __builtin_bit_cast(float, za.x & 0xffff0000u));
                t[2] = __builtin_bit_cast(float, xa.y << 16) + (__builtin_bit_cast(float, ya.y << 16) + __builtin_bit_cast(float, za.y << 16));
                t[3] = __builtin_bit_cast(float, xa.y & 0xffff0000u) + (__builtin_bit_cast(float, ya.y & 0xffff0000u) + __builtin_bit_cast(float, za.y & 0xffff0000u));
                v[q][j] = t; s[q] += (t[0] * t[0] + t[1] * t[1]) + (t[2] * t[2] + t[3] * t[3]); } }
#pragma unroll
        for (int o = 1; o < 64; o <<= 1) { s[0] += __shfl_xor(s[0], o); s[1] += __shfl_xor(s[1], o); s[2] += __shfl_xor(s[2], o); s[3] += __shfl_xor(s[3], o); }
#pragma unroll
        for (int q = 0; q < 4; ++q) { const float rs = __builtin_amdgcn_rsqf(s[q] * (1.0f / 1024.0f) + EPS); float* op = out + (size_t)(m0 + q) * 1024 + 4 * lane;
#pragma unroll
            for (int j = 0; j < 4; ++j) *(GAS f32x4*)(op + 256 * j) = v[q][j] * rs * g[j]; }
    }
}

struct Args { const float* in[26]; float* out; unsigned char* ws; int ph_lo, ph_hi; };
__global__ void __launch_bounds__(NWAVES * 64, 2) fwd_kernel(Args args) {
    extern __shared__ __attribute__((aligned(16))) unsigned char lds[];
    Frame F;
    F.lds = (LAS unsigned char*)lds;
    F.MISC = (volatile LAS unsigned*)(F.lds + MISC_OFF);
    F.tid = threadIdx.x; F.lane = F.tid & 63; F.wave = __builtin_amdgcn_readfirstlane(F.tid >> 6);
    F.G = gridDim.x; { const int bx = blockIdx.x; F.vcu = (F.G % 8 == 0) ? (bx % 8) * (F.G / 8) + bx / 8 : bx; }
    F.ws = args.ws; F.ctl = (gu32*)(args.ws + WS_CTL); F.out = args.out;
    F.in = args.in;
    for (int u = F.tid; u < (LDS_BYTES - LDSCTL_OFF) / 4; u += NWAVES * 64) ((LAS unsigned*)(F.lds + LDSCTL_OFF))[u] = 0u;
    __syncthreads();
    const bool one = (args.ph_hi - args.ph_lo) > 1;
    XcdBarrier bar; bar.bar = (unsigned*)(F.ctl + CW_BAR); bar.x = 0; bar.st = nullptr; bar.wave = F.wave;
    if (one) bar = xcd_barrier_post((unsigned*)(F.ctl + CW_BAR), F.MISC + 8, F.wave);
    const int lo = args.ph_lo, hi = args.ph_hi;
#define REFRESH() do { int l_; asm volatile("v_mbcnt_lo_u32_b32 %0, -1, 0\n\tv_mbcnt_hi_u32_b32 %0, -1, %0" : "=v"(l_)); F.lane = l_; F.tid = F.wave * 64 + l_; } while (0)
#ifndef MK_REPEAT_MASK
#define MK_REPEAT_MASK 0
#endif
#define REP(k) ((MK_REPEAT_MASK >> (k)) & 1)
#ifndef MK_PHASE_MASK
#define MK_PHASE_MASK 0x3FFF
#endif
#define IN(k) (((MK_PHASE_MASK >> (k)) & 1) && lo <= (k) && (k) < hi)
#ifndef MK_PROBE_BLK
#define MK_PROBE_BLK 0
#endif
#ifndef MK_STAMP_A
#define MK_STAMP_A -1
#endif
#ifndef MK_STAMP_B
#define MK_STAMP_B -1
#endif
#define SEAM(k) do { if (IN(k) && IN((k) + 1)) xcd_barrier(bar); if (MK_STAMP_A >= 0 && blockIdx.x == MK_PROBE_BLK && F.tid == 0) { const unsigned long long t_ = rt(); F.MISC[32 + 2 * (k)] = (unsigned)t_; } } while (0)
    const float* rstd0 = wsp<float>(F, WS_RSTD0);
    const float* rope = wsp<float>(F, WS_ROPE);
    const int bx = (int)blockIdx.x;

    if (MK_STAMP_A >= 0 && blockIdx.x == MK_PROBE_BLK && F.tid == 0) F.MISC[30] = (unsigned)rt();
    if (IN(0)) { REFRESH(); p0_prologue(F); xcd_barrier(bar); REFRESH(); p0_rest(F); } SEAM(0);

    if (IN(1)) for (int rep1_ = 0; rep1_ < 1 + REP(1); ++rep1_) { REFRESH();
        const pg8::bf16_t* XB = wsp<pg8::bf16_t>(F, WS_XB);
        { static_assert(W_V == W_R + 1536 * 2048 && W_G == W_V + 512 * 2048 && W_X == W_G + 1024 * 2048 && WS_K - WS_Q == WS_QI - WS_K, "in-proj weight rows contiguous; Q, K, QI equally spaced");
          pg8::Gemm g{wsp<pg8::bf16_t>(F, WS_X8), wsp<pg8::bf16_t>(F, WS_W8), T, 3328, 512}; pg8::StaticOrder S; S.init(T, 3328, F.G, bx);
          pg8::EpiInProj E{pg8::EpiRope{wsp<pg8::bf16_t>(F, WS_Q), (size_t)(WS_K - WS_Q) / 2, rstd0, rope}, pg8::EpiScale{wsp<pg8::bf16_t>(F, WS_V), 512, rstd0, nullptr, EPS},
                           pg8::EpiGlu{wsp<pg8::bf16_t>(F, WS_U), rstd0}, pg8::EpiKiWi{wsp<pg8::bf16_t>(F, WS_KI), wsp<float>(F, WS_WI), rstd0, rope}};
          pg8::gemm_phase<pg8::EpiInProj, pg8::StaticOrder, PG8_ALIGN, PG8_SP2, false, true>(F.lds, g, S, E, F.wave, wsp<float>(F, WS_CS)); }
        { pg8::Gemm g{wsp<pg8::bf16_t>(F, WS_M8), wsp<pg8::bf16_t>(F, WS_W8 + (size_t)5376 * 1024), NBATCH * NMEM, 2048, 512}; pg8::StaticOrder S; S.init(NBATCH * NMEM, 2048, F.G, (bx + 128) % F.G);
          pg8::EpiMemKV E{wsp<pg8::bf16_t>(F, WS_KXH), wsp<pg8::bf16_t>(F, WS_VH), wsp<float>(F, WS_RSTDM)};
          pg8::gemm_phase<pg8::EpiMemKV, pg8::StaticOrder, PG8_ALIGN, PG8_SP2, false, true>(F.lds, g, S, E, F.wave, wsp<float>(F, WS_CS) + 5376); }
    } SEAM(1);

    if (IN(2)) { REFRESH(); indexer_phase(F); if (REP(2)) indexer_phase(F);
        if (MK_STAMP_A >= 0 && blockIdx.x == MK_PROBE_BLK && F.tid == 0) { const unsigned t_ = (unsigned)rt(); F.MISC[30 + 2 * 51] = t_; F.MISC[32 + 2 * 50] = t_; F.MISC[30 + 2 * 50] = F.MISC[32 + 2 * 1]; }
        conv_phase(F); if (REP(12)) conv_phase(F);
        if (MK_STAMP_A >= 0 && blockIdx.x == MK_PROBE_BLK && F.tid == 0) F.MISC[32 + 2 * 51] = (unsigned)rt();
        REFRESH();
        { pg8::Gemm g{wsp<pg8::bf16_t>(F, WS_KXH), wsp<pg8::bf16_t>(F, W_QH), 0, 0, 256}; pg8::WkOrder S{F.G, F.vcu};
          pg8::EpiWk E{wsp<pg8::bf16_t>(F, WS_WK)};
          pg8::gemm_phase<pg8::EpiWk, pg8::WkOrder, PG8_ALIGN, PG8_SP2>(F.lds, g, S, E, F.wave); }
        { pg8::Gemm g{wsp<pg8::bf16_t>(F, W_OH), wsp<pg8::bf16_t>(F, WS_VH), 0, 0, 256}; pg8::VwOrder S{F.G, (F.vcu + 128) % F.G};
          pg8::EpiVw E{wsp<pg8::bf16_t>(F, WS_VWT)};
          pg8::gemm_phase<pg8::EpiVw, pg8::VwOrder, PG8_ALIGN, PG8_SP2>(F.lds, g, S, E, F.wave); }
    } SEAM(2);

    if (IN(3)) { REFRESH();
        const attn_body::AttnTensors AT{(const attn_body::bf16*)wsp<bf16>(F, WS_Q), (const attn_body::bf16*)wsp<bf16>(F, WS_K), (const attn_body::bf16*)wsp<bf16>(F, WS_V), (attn_body::bf16*)wsp<bf16>(F, WS_Q), wsp<uint2>(F, WS_MASK)};
        const attn_body::StaticOrder S((int)F.G, bx);
        if (REP(3)) attn_body::attn_phase<attn_body::StaticOrder>((char*)lds, AT, S, F.wave, true);
        attn_body::attn_phase<attn_body::StaticOrder>((char*)lds, AT, S, F.wave);
    } SEAM(3);

    if (IN(4)) for (int rep4_ = 0; rep4_ < 1 + REP(4); ++rep4_) { REFRESH();
        { pg8::Gemm g{wsp<pg8::bf16_t>(F, WS_Q), wsp<pg8::bf16_t>(F, W_OA), T, 1024, 512}; pg8::StaticOrder S; S.init(T, 1024, F.G, bx);
          pg8::EpiScale E{wsp<pg8::bf16_t>(F, WS_K), 1024, nullptr, nullptr, EPS, wsp<unsigned>(F, WS_RMAXA)};
          pg8::gemm_phase<pg8::EpiScale, pg8::StaticOrder, PG8_ALIGN, PG8_SP2>(F.lds, g, S, E, F.wave); }
        { pg8::Gemm g{wsp<pg8::bf16_t>(F, WS_CA8), wsp<pg8::bf16_t>(F, WS_WCO8), T, 1024, 256}; pg8::StaticOrder S; S.init(T, 1024, F.G, bx);
          pg8::EpiScale E{wsp<pg8::bf16_t>(F, WS_QI), 1024, wsp<float>(F, WS_CAS), nullptr, EPS, wsp<unsigned>(F, WS_RMAXC)};
          pg8::gemm_phase<pg8::EpiScale, pg8::StaticOrder, PG8_ALIGN, PG8_SP2, false, true>(F.lds, g, S, E, F.wave, wsp<float>(F, WS_CS) + NW8); }
    } SEAM(4);

    if (MK_STAMP_A >= 0 && blockIdx.x == MK_PROBE_BLK && F.tid == 0) F.MISC[250] = (unsigned)rt();
    if (IN(5)) for (int rep5_ = 0; rep5_ < 1 + REP(5); ++rep5_) { REFRESH();
        pg8::Gemm g{wsp<pg8::bf16_t>(F, WS_X8), wsp<pg8::bf16_t>(F, WS_W8 + (size_t)3328 * 1024), T, 2048, 512}; pg8::StaticOrder S; S.init(T, 2048, F.G, bx);
        pg8::EpiMerge E{wsp<pg8::bf16_t>(F, WS_K), wsp<pg8::bf16_t>(F, WS_QI), wsp<signed char>(F, WS_Q), rstd0, wsp<float>(F, WS_RMAXA), wsp<float>(F, WS_RMAXC)};
        pg8::gemm_phase<pg8::EpiMerge, pg8::StaticOrder, PG8_ALIGN, PG8_SP2, false, true>(F.lds, g, S, E, F.wave, wsp<float>(F, WS_CS) + 3328);
    }
    if (MK_STAMP_A >= 0 && blockIdx.x == MK_PROBE_BLK && F.tid == 0) F.MISC[252] = (unsigned)rt();
    SEAM(5);

    if (IN(6)) { REFRESH();
        pg8::Gemm g{wsp<pg8::bf16_t>(F, WS_Q), wsp<pg8::bf16_t>(F, WS_W8 + (size_t)7424 * 1024), T, 1024, 512}; pg8::StaticOrder S; S.init(T, 1024, F.G, bx);
        pg8::EpiResidX E{F.in[0], wsp<pg8::bf16_t>(F, WS_XB), (float*)(F.ctl + CW_ROWSQ1), wsp<float>(F, WS_RMAXA), wsp<float>(F, WS_RMAXC)};
        pg8::gemm_phase<pg8::EpiResidX, pg8::StaticOrder, PG8_ALIGN, PG8_SP2, false, true>(F.lds, g, S, E, F.wave, wsp<float>(F, WS_CS) + 7424);
    } SEAM(6);

    if (IN(7)) { REFRESH();
        static_assert(PG8_ALIGN, "EpiSoftmax takes workgroup barriers inside the epilogue: both half-workgroups must run it together");
        pg8::Gemm g{wsp<pg8::bf16_t>(F, WS_XB), wsp<pg8::bf16_t>(F, WS_WK), T, 1024, 1024}; pg8::BatchOrder S; S.init(T, 1024, F.G, bx);
        pg8::EpiSoftmax E{wsp<pg8::bf16_t>(F, WS_K), (const float*)(F.ctl + CW_ROWSQ1), EPS, (PG8_LAS float*)(F.lds + 131072 + 4096)};
        pg8::gemm_phase<pg8::EpiSoftmax, pg8::BatchOrder, PG8_ALIGN, PG8_SP2>(F.lds, g, S, E, F.wave);
    } SEAM(7);


    if (IN(9)) { REFRESH();
        pg8::Gemm g{wsp<pg8::bf16_t>(F, WS_K), wsp<pg8::bf16_t>(F, WS_VWT), T, 1024, 1024}; pg8::BatchOrder S; S.init(T, 1024, F.G, bx);
        pg8::EpiResid E{wsp<pg8::bf16_t>(F, WS_XB), wsp<pg8::bf16_t>(F, WS_Q), (float*)(F.ctl + CW_ROWSQ2)};
        pg8::gemm_phase<pg8::EpiResid, pg8::BatchOrder, PG8_ALIGN, PG8_SP2>(F.lds, g, S, E, F.wave);
    } SEAM(9);

    if (IN(10)) { REFRESH(); router_phase(F); } SEAM(10);

    if (IN(11) || IN(12)) {
        REFRESH();
        LAS int* pre = (LAS int*)(F.lds + 131072); LAS int* cntl = pre + 64; LAS unsigned char* t2e = (LAS unsigned char*)(pre + 128);
        int acc_w = 0;
        if (F.wave == 0) {
            const int c = F.lane; const int n = c < 32 ? (int)__hip_atomic_load(F.ctl + CW_CNT + 64 * (c & 31), RLX_AGENT) : 0; const int nt_ = (n + 255) >> 8; int incl = nt_;
#pragma unroll
            for (int d = 1; d < 32; d <<= 1) { const int o = __shfl_up(incl, d); if (c >= d) incl += o; }
            if (c < 32) { pre[c] = incl - nt_; cntl[c] = n; for (int q = 0; q < nt_; ++q) t2e[incl - nt_ + q] = (unsigned char)c; }
            if (c == 31) pre[32] = incl;
            acc_w = __shfl(incl, 31); }
        if (F.tid == 0) { const int acc = acc_w;
            const int G_ = F.G, U1 = 2 * acc, U2 = 4 * acc, al = U1 / G_, H = U1 % G_;
            int Tt = 15 * al + 3 * (U2 / G_), nl = 0, nh = 0, f = 0;
            for (;; ++Tt) { nl = (Tt - 15 * al) / 3; nh = (Tt - 15 * (al + 1)) / 3; nl = nl > 0 ? nl : 0; nh = nh > 0 ? nh : 0; f = H * nh + (G_ - H) * nl; if (f >= U2) break; }
            const int X = f - U2, Xl = nl > 0 ? (X < G_ - H ? X : G_ - H) : 0, Xh = X - Xl;
            const int g0 = (F.vcu >> 5) << 5, g1 = g0 + 32 < G_ ? g0 + 32 : G_;
            int se[2];
            for (int q = 0; q < 2; ++q) { const int c_ = q ? g1 : g0;
                if (c_ <= H) { const int d = c_ - (H - Xh); se[q] = c_ * nh - (d > 0 ? d : 0); }
                else { const int d = c_ - (G_ - Xl); se[q] = H * nh - Xh + (c_ - H) * nl - (d > 0 ? d : 0); } }
            pre[96] = se[0]; pre[97] = se[1]; pre[98] = (int)0xFFFE0000u; pre[99] = F.vcu - g0; pre[100] = g1 - g0; }
        WG_SYNC();
        if (MK_STAMP_A >= 0 && blockIdx.x == MK_PROBE_BLK && F.tid == 0) F.MISC[230] = (unsigned)rt();
        if (IN(11)) {
            const int U1_ = 2 * pre[32], al_ = U1_ / (int)F.G;
#pragma unroll 1
            for (int call = 0; call < 2; ++call) { const int r0 = call ? al_ : 0, r1 = call ? al_ + 1 : al_;
                REFRESH();
                pg8::MoeOrderT<1> S{pre, cntl, t2e, wsp<int>(F, WS_LIST), F.G, F.vcu, T, r0, r1};
                pg8::Gemm g{wsp<pg8::bf16_t>(F, WS_X8), wsp<pg8::bf16_t>(F, WS_W8E), 0, 0, 512};
                pg8::EpiMoeH E{wsp<pg8::bf16_t>(F, WS_HS), wsp<float>(F, WS_CR), wsp<float>(F, WS_CE), EPS, S};
                pg8::gemm_phase<pg8::EpiMoeH, pg8::MoeOrderT<1>, PG8_ALIGN, PG8_SP2, true, true>(F.lds, g, S, E, F.wave, wsp<float>(F, WS_CS) + QE0);
                if (r0 * (int)F.G + F.vcu >= U1_ || r0 >= r1) { if (MK_STAMP_A >= 0 && blockIdx.x == MK_PROBE_BLK && F.tid == 0) F.MISC[232 + 2 * call] = (unsigned)rt(); continue; }
                asm volatile("s_waitcnt vmcnt(0)" ::: "memory"); WG_SYNC(); REFRESH();
                if (F.tid == 0) { __builtin_amdgcn_fence(__ATOMIC_RELEASE, "agent"); asm volatile("s_waitcnt vmcnt(0)" ::: "memory");
                    unsigned n_ = 0u;
                    for (int r = r0; r < r1; ++r) { const int L = r * (int)F.G + F.vcu; if (L < U1_) { (void)__hip_atomic_fetch_add(F.ctl + CW_RDY + 64 * (L >> 1), 1u, RLX_AGENT); ++n_; } }
                    (void)__hip_atomic_fetch_add(F.ctl + CW_RDYTOT + 64 * call, n_, RLX_AGENT); }
                if (MK_STAMP_A >= 0 && blockIdx.x == MK_PROBE_BLK && F.tid == 0) F.MISC[232 + 2 * call] = (unsigned)rt();
            }
        }
        if (MK_STAMP_A >= 0 && blockIdx.x == MK_PROBE_BLK && F.tid == 0) { const unsigned long long t_ = rt(); F.MISC[32 + 2 * 11] = (unsigned)t_; }
#ifdef MK_DEP_BARRIER
        xcd_barrier(bar);
#endif
        if (IN(12)) {
            WG_SYNC();
            REFRESH();
            const int U1_ = 2 * pre[32], fu_ = (U1_ / (int)F.G) * (int)F.G;
            pg8::MoeOrder2 S{pre, t2e, (LAS unsigned*)(pre + 98), F.ctl + CW_RDY, F.ctl + CW_RDYTOT, pre[96], pre[97], pre[99], pre[100], F.wave, fu_ >> 1, (unsigned)fu_, (unsigned)U1_};
            pg8::Gemm g{wsp<pg8::bf16_t>(F, WS_HS), wsp<pg8::bf16_t>(F, W_E2), 0, 0, 256};
            pg8::EpiMoeY E{wsp<pg8::bf16_t>(F, WS_YS)};
            pg8::gemm_phase<pg8::EpiMoeY, pg8::MoeOrder2, PG8_ALIGN, PG8_SP2, false>(F.lds, g, S, E, F.wave);
            if (MK_STAMP_A >= 0 && blockIdx.x == MK_PROBE_BLK && F.tid == 0) F.MISC[236] = (unsigned)rt();
        }
    } SEAM(12);
    if (MK_STAMP_A >= 0 && blockIdx.x == MK_PROBE_BLK && F.tid == 0) { const unsigned t_ = (unsigned)rt(); F.MISC[238] = t_; F.MISC[242] = t_; F.MISC[240] = F.MISC[230]; }

    if (IN(13)) { REFRESH(); final_phase(F); if (REP(14)) final_phase(F); }
    if (MK_STAMP_A >= 0) {
        xcd_barrier(bar);
        if (blockIdx.x == MK_PROBE_BLK) { if (F.tid == 0) { F.MISC[32 + 2 * 13] = (unsigned)rt();
                const unsigned a0_ = F.MISC[30 + 2 * MK_STAMP_A], a1_ = F.MISC[32 + 2 * MK_STAMP_A]; F.out[0] = (float)(a1_ - a0_) * 0.01f * (MK_STAMP_A >= 100 ? 1.0f : 0.25f);
                const unsigned b0_ = F.MISC[30 + 2 * (MK_STAMP_B < 0 ? 0 : MK_STAMP_B)], b1_ = F.MISC[32 + 2 * (MK_STAMP_B < 0 ? 0 : MK_STAMP_B)]; F.MISC[29] = __builtin_bit_cast(unsigned, (MK_STAMP_B >= 100 ? 0.032f : 0.008f) * sqrtf((float)(b1_ - b0_) * 0.01f)); }
            __syncthreads();
            if (MK_STAMP_B >= 0) { const float dd_ = __builtin_bit_cast(float, (unsigned)F.MISC[29]); for (int i = F.tid; i < (1 << 20); i += 512) F.out[(1 << 20) + i] += dd_; } }
    }
#undef IN
#undef SEAM
#undef REFRESH
}

constexpr int N_PHASES = 14;
#ifndef MK_ONE_LAUNCH
#define MK_ONE_LAUNCH 1
#endif
extern "C" void kernel_launch(void* const* d_in, const int* in_sizes, int n_in, void* d_out, int out_size, void* d_ws, size_t ws_size, hipStream_t stream) {
    static int grid = 0;
    if (grid == 0) {
        if (n_in != 26 || in_sizes[0] != T * DM || out_size != T * DM || ws_size < WS_END) { fprintf(stderr, "kernel_launch: unexpected shapes (n_in %d, in0 %d, out %d, ws %zu); nothing launched\n", n_in, n_in > 0 ? in_sizes[0] : -1, out_size, ws_size); grid = -1; return; }
        int dev = 0, cus = 0, per_cu = 0;
        if (hipGetDevice(&dev) != hipSuccess || hipDeviceGetAttribute(&cus, hipDeviceAttributeMultiprocessorCount, dev) != hipSuccess) { grid = -1; return; }
        if (hipFuncSetAttribute((const void*)fwd_kernel, hipFuncAttributeMaxDynamicSharedMemorySize, LDS_BYTES) != hipSuccess) { fprintf(stderr, "kernel_launch: hipFuncSetAttribute failed\n"); grid = -1; return; }
        if (hipOccupancyMaxActiveBlocksPerMultiprocessor(&per_cu, (const void*)fwd_kernel, NWAVES * 64, LDS_BYTES) != hipSuccess || per_cu < 1) { fprintf(stderr, "kernel_launch: occupancy query says %d blocks per CU\n", per_cu); }
        (void)hipGetLastError();
        grid = cus;
    }
    if (grid < 0) return;
    if (hipMemsetAsync((char*)d_ws + WS_CTL, 0, CTL_ZERO_BYTES, stream) != hipSuccess) return;
    Args a{};
    for (int i = 0; i < 26; ++i) a.in[i] = (const float*)d_in[i];
    a.out = (float*)d_out; a.ws = (unsigned char*)d_ws;
#if MK_ONE_LAUNCH
    a.ph_lo = 0; a.ph_hi = N_PHASES;
    hipLaunchKernelGGL(fwd_kernel, dim3(grid), dim3(NWAVES * 64), LDS_BYTES, stream, a);
#else
    for (int p = 0; p < N_PHASES; ++p) { a.ph_lo = p; a.ph_hi = p + 1; hipLaunchKernelGGL(fwd_kernel, dim3(grid), dim3(NWAVES * 64), LDS_BYTES, stream, a); }
#endif
}
```
